# Optimizing an MI355X kernel written in HIP

```python
import math
import jax, jax.numpy as jnp
from jax import lax
import numpy as np

D_MODEL = 1024
BATCH = 16
SEQ = 2048
DEPTH = 1

PLE_DIM = 256
ATTN_WIDTH = D_MODEL // 2
DIFF_HEADS = 4
DIFF_HEAD_DIM = ATTN_WIDTH // DIFF_HEADS // 2
CONV_WIDTH = D_MODEL // 2
CONV_KERNEL = 31
N_EXPERTS = 32
TOP_K = 4
EXPERT_FF = D_MODEL
SWIGLU_ALPHA = 1.702
SWIGLU_LIMIT = 7.0
Q_BLOCK = 128
MOE_BLOCK = 128
EPS = 1e-5
IN_COLS = 3 * ATTN_WIDTH + 2 * CONV_WIDTH + 2 * D_MODEL

kernel_name = "hybrid_diffattn_conformer_moe_ple"


def rms_norm(x, g):
    x32 = x.astype(jnp.float32)
    y = x32 * lax.rsqrt(jnp.mean(x32 * x32, axis=-1, keepdims=True) + EPS)
    return (y * g.astype(jnp.float32)).astype(x.dtype)


def layer_norm(x, g, b):
    x32 = x.astype(jnp.float32)
    mu = jnp.mean(x32, axis=-1, keepdims=True)
    xc = x32 - mu
    y = xc * lax.rsqrt(jnp.mean(xc * xc, axis=-1, keepdims=True) + EPS)
    return (y * g.astype(jnp.float32) + b.astype(jnp.float32)).astype(x.dtype)


def diff_attention(q, k, v, lam, lam_init, g_subln):
    B, S, _ = q.shape
    H, d = DIFF_HEADS, DIFF_HEAD_DIM
    q32 = q.reshape(B, S, H, 2, d).astype(jnp.float32)
    k32 = k.reshape(B, S, H, 2, d).astype(jnp.float32)
    v = v.reshape(B, S, H, 2 * d)
    scale = d ** -0.5
    kpos = jnp.arange(S)

    def block(i):
        q0 = i * Q_BLOCK
        qb = lax.dynamic_slice_in_dim(q32, q0, Q_BLOCK, axis=1)
        s = jnp.einsum('bqhcd,bkhcd->bhcqk', qb, k32) * scale
        qpos = q0 + jnp.arange(Q_BLOCK)
        s = jnp.where(qpos[:, None] >= kpos[None, :], s, -jnp.inf)
        pr = jax.nn.softmax(s, axis=-1)
        attn = pr[:, :, 0] - lam * pr[:, :, 1]
        return jnp.einsum('bhqk,bkhe->bqhe', attn.astype(v.dtype), v)

    o = lax.map(block, jnp.arange(S // Q_BLOCK))
    o = jnp.transpose(o, (1, 0, 2, 3, 4)).reshape(B, S, H, 2 * d)
    o = rms_norm(o, g_subln) * (1.0 - lam_init)
    return o.reshape(B, S, H * 2 * d)


def conformer_conv(c, w_dw, b_dw, g_ln, b_ln):
    z = c[..., :CONV_WIDTH] * jax.nn.sigmoid(c[..., CONV_WIDTH:])
    z = lax.conv_general_dilated(
        z, w_dw[:, None, :], window_strides=(1,),
        padding=[(CONV_KERNEL - 1, 0)],
        dimension_numbers=('NWC', 'WIO', 'NWC'),
        feature_group_count=CONV_WIDTH) + b_dw
    z = layer_norm(z, g_ln, b_ln)
    return jax.nn.silu(z)


def moe(u, w_router, b_router, w_gu, b_gu, w_down, b_down):
    B, S, D = u.shape
    N = B * S
    A = N * TOP_K
    xt = u.reshape(N, D)
    logits = (xt @ w_router + b_router).astype(jnp.float32)
    top_val, top_idx = lax.top_k(logits, TOP_K)
    gates = jax.nn.softmax(top_val, axis=-1).astype(xt.dtype)

    e_flat = top_idx.reshape(A)
    order = jnp.argsort(e_flat)
    e_sorted = e_flat[order]
    tok_sorted = order // TOP_K
    g_sorted = gates.reshape(A)[order]
    counts = jnp.bincount(e_flat, length=N_EXPERTS)
    start = jnp.cumsum(counts) - counts
    padded = (counts + MOE_BLOCK - 1) // MOE_BLOCK * MOE_BLOCK
    pend = jnp.cumsum(padded)
    pstart = pend - padded
    pos_sorted = pstart[e_sorted] + (jnp.arange(A) - start[e_sorted])

    n_blocks = -(-A // MOE_BLOCK) + N_EXPERTS
    R = n_blocks * MOE_BLOCK
    row_tok = jnp.zeros((R,), jnp.int32).at[pos_sorted].set(tok_sorted.astype(jnp.int32))
    row_gate = jnp.zeros((R,), xt.dtype).at[pos_sorted].set(g_sorted)
    block_expert = jnp.clip(
        jnp.searchsorted(pend, jnp.arange(n_blocks) * MOE_BLOCK, side='right'),
        0, N_EXPERTS - 1)

    def expert_block(args):
        e, rows = args
        xb = xt[rows]
        gu = xb @ w_gu[e] + b_gu[e]
        gate = jnp.minimum(gu[:, ::2], SWIGLU_LIMIT)
        lin = jnp.clip(gu[:, 1::2], -SWIGLU_LIMIT, SWIGLU_LIMIT)
        glu = gate * jax.nn.sigmoid(gate * SWIGLU_ALPHA)
        return ((lin + 1.0) * glu) @ w_down[e] + b_down[e]

    y = lax.map(expert_block, (block_expert, row_tok.reshape(n_blocks, MOE_BLOCK)))
    y = y.reshape(R, D) * row_gate[:, None]
    out = jnp.zeros((N, D), xt.dtype).at[row_tok].add(y)
    return out.reshape(B, S, D)


def setup_inputs(seed: int = 0) -> dict:
    key = jax.random.key(seed)
    ks = iter(jax.random.split(key, 32))

    def nrm(shape, fan_in):
        return jax.random.normal(next(ks), shape, jnp.float32) * (fan_in ** -0.5)

    def gain(shape):
        return 1.0 + 0.02 * jax.random.normal(next(ks), shape, jnp.float32)

    def small(shape, s=0.02):
        return s * jax.random.normal(next(ks), shape, jnp.float32)

    L, D, E, F = DEPTH, D_MODEL, N_EXPERTS, EXPERT_FF
    return {
        "x": jax.random.normal(next(ks), (BATCH, SEQ, D), jnp.float32),
        "p": jax.random.normal(next(ks), (DEPTH, BATCH, SEQ, PLE_DIM), jnp.float32),
        "g_mix": gain((L, D)),
        "w_in": nrm((L, D, IN_COLS), D),
        "lambda_q1": small((L, DIFF_HEAD_DIM), 0.1),
        "lambda_k1": small((L, DIFF_HEAD_DIM), 0.1),
        "lambda_q2": small((L, DIFF_HEAD_DIM), 0.1),
        "lambda_k2": small((L, DIFF_HEAD_DIM), 0.1),
        "g_subln": gain((L, 2 * DIFF_HEAD_DIM)),
        "w_attn_out": nrm((L, ATTN_WIDTH, D), ATTN_WIDTH),
        "w_dw": nrm((L, CONV_KERNEL, CONV_WIDTH), CONV_KERNEL),
        "b_dw": small((L, CONV_WIDTH)),
        "g_conv_ln": gain((L, CONV_WIDTH)),
        "b_conv_ln": small((L, CONV_WIDTH)),
        "w_conv_out": nrm((L, CONV_WIDTH, D), CONV_WIDTH),
        "w_o": nrm((L, D, D), D),
        "g_ffn": gain((L, D)),
        "w_router": nrm((L, D, E), D),
        "b_router": small((L, E), 0.01),
        "w_gate_up": nrm((L, E, D, 2 * F), D),
        "b_gate_up": small((L, E, 2 * F)),
        "w_down": nrm((L, E, F, D), F),
        "b_down": small((L, E, D)),
        "w_ple": nrm((L, PLE_DIM, D), PLE_DIM),
        "g_ple": gain((L, D)),
        "w_ple_gate": nrm((L, D, D), D),
        "g_final": gain((D,)),
    }


def reference(x, p, g_mix, w_in, lambda_q1, lambda_k1, lambda_q2, lambda_k2, g_subln,
              w_attn_out, w_dw, b_dw, g_conv_ln, b_conv_ln, w_conv_out, w_o, g_ffn,
              w_router, b_router, w_gate_up, b_gate_up, w_down, b_down,
              w_ple, g_ple, w_ple_gate, g_final):
    h = x
    splits = np.cumsum([ATTN_WIDTH, ATTN_WIDTH, ATTN_WIDTH, 2 * CONV_WIDTH, D_MODEL]).tolist()
    for i in range(DEPTH):
        u = rms_norm(h, g_mix[i])
        proj = u @ w_in[i]
        q, k, v, c_in, gate_a, gate_b = jnp.split(proj, splits, axis=-1)

        lam_init = 0.8 - 0.6 * math.exp(-0.3 * i)
        lam = (jnp.exp(jnp.sum(lambda_q1[i] * lambda_k1[i]).astype(jnp.float32))
               - jnp.exp(jnp.sum(lambda_q2[i] * lambda_k2[i]).astype(jnp.float32))
               + lam_init)
        a = diff_attention(q, k, v, lam, lam_init, g_subln[i]) @ w_attn_out[i]
        b = conformer_conv(c_in, w_dw[i], b_dw[i], g_conv_ln[i], b_conv_ln[i]) @ w_conv_out[i]
        m = jax.nn.sigmoid(gate_a) * a + jax.nn.sigmoid(gate_b) * b
        h = h + m @ w_o[i]

        h = h + moe(rms_norm(h, g_ffn[i]), w_router[i], b_router[i],
                    w_gate_up[i], b_gate_up[i], w_down[i], b_down[i])

        h = h + (p[i] @ w_ple[i]) * jax.nn.sigmoid(rms_norm(h, g_ple[i]) @ w_ple_gate[i])
    return rms_norm(h, g_final)
```

```cpp
#include <hip/hip_runtime.h>
#include <cstdio>
#include <cstdint>

typedef unsigned short bf16_t;
typedef float f32x4 __attribute__((ext_vector_type(4)));
typedef unsigned u32x4 __attribute__((ext_vector_type(4)));
typedef unsigned u32x2 __attribute__((ext_vector_type(2)));

constexpr int BATCH = 16, SEQ = 2048, D = 1024, M = BATCH * SEQ;
constexpr int AW = 512, CW = 512, NH = 4, HD = 64, KC = 31, NE = 32, TOPK = 4, FF = 1024, PLE = 256;
constexpr int INC = 3 * AW + 2 * CW + 2 * D;
constexpr float EPS = 1e-5f;
constexpr float C2 = 0.125f * 1.4426950408889634f;
constexpr float LAM_INIT = 0.2f;
constexpr int LIST_CAP = M;
constexpr int ACT_ROWS = M * TOPK + NE * 256;

constexpr size_t MiB = 1u << 20;
constexpr size_t WS_CTL = 0, CTL_ZERO_BYTES = 1 * MiB;
constexpr size_t WS_TOPK_E = 1 * MiB;
constexpr size_t WS_TOPK_G = 2 * MiB;
constexpr size_t WS_LIST = 4 * MiB;
constexpr size_t WS_WSM = 8 * MiB;
constexpr size_t WS_WIN = 16 * MiB;
constexpr size_t WS_WGU = 32 * MiB;
constexpr size_t WS_WDN = 160 * MiB;
constexpr size_t WS_PP = 224 * MiB;
constexpr size_t WS_H = 240 * MiB;
constexpr size_t WS_XN = 368 * MiB;
constexpr size_t WS_Q = 432 * MiB, WS_K = 464 * MiB, WS_V = 496 * MiB;
constexpr size_t WS_Z = 528 * MiB;
constexpr size_t WS_SGA = 560 * MiB, WS_SGB = 624 * MiB;
constexpr size_t WS_O1 = 688 * MiB, WS_O2 = 720 * MiB;
constexpr size_t WS_AC = 752 * MiB;
constexpr size_t WS_T = 816 * MiB;
constexpr size_t WS_M1 = 880 * MiB;
constexpr size_t WS_END = 944 * MiB;
constexpr size_t WS_Y = 368 * MiB;
constexpr size_t WS_ACT = 624 * MiB;
constexpr size_t WS_U3 = 624 * MiB;
constexpr size_t WS_E1 = 688 * MiB;
static_assert(WS_ACT + (size_t)ACT_ROWS * FF * 2 <= WS_END, "ACT overlay");
constexpr int CW_GCNT = 64;
constexpr int CW_EBASE = 128;

__device__ __forceinline__ float bf2f(bf16_t v) { return __uint_as_float((unsigned)v << 16); }
__device__ __forceinline__ unsigned f2bf(float f) { unsigned u = __float_as_uint(f); return (u + 0x7fffu + ((u >> 16) & 1u)) >> 16; }
__device__ __forceinline__ unsigned pk2(float lo, float hi) { return f2bf(lo) | (f2bf(hi) << 16); }
__device__ __forceinline__ float sigmoidf_(float x) { return 1.f / (1.f + __expf(-x)); }
__device__ __forceinline__ float wave_sum(float v) {
#pragma unroll
    for (int o = 1; o < 64; o <<= 1) v += __shfl_xor(v, o);
    return v;
}

__global__ __launch_bounds__(256) void k_rmsnorm_bf16(const float* __restrict__ X, const float* __restrict__ g, bf16_t* __restrict__ O) {
    const int lane = threadIdx.x & 63, gw = (blockIdx.x * blockDim.x + threadIdx.x) >> 6, ngw = (gridDim.x * blockDim.x) >> 6;
    for (int m = gw; m < M; m += ngw) {
        const f32x4* xr = (const f32x4*)(X + (size_t)m * D) + lane; f32x4 v[4]; float s = 0.f;
#pragma unroll
        for (int j = 0; j < 4; ++j) { v[j] = xr[64 * j]; s += v[j].x * v[j].x + v[j].y * v[j].y + v[j].z * v[j].z + v[j].w * v[j].w; }
        const float rstd = rsqrtf(wave_sum(s) * (1.f / D) + EPS);
        u32x2* o8 = (u32x2*)(O + (size_t)m * D) + lane;
#pragma unroll
        for (int j = 0; j < 4; ++j) { const f32x4 gg = ((const f32x4*)g)[lane + 64 * j]; u32x2 w; w.x = pk2(v[j].x * rstd * gg.x, v[j].y * rstd * gg.y); w.y = pk2(v[j].z * rstd * gg.z, v[j].w * rstd * gg.w); o8[64 * j] = w; }
    }
}
__global__ __launch_bounds__(256) void k_cvt_bf16(const float* __restrict__ X, bf16_t* __restrict__ O, size_t n4) {
    for (size_t i = (size_t)blockIdx.x * blockDim.x + threadIdx.x; i < n4; i += (size_t)gridDim.x * blockDim.x) {
        const f32x4 v = ((const f32x4*)X)[i]; u32x2 w; w.x = pk2(v.x, v.y); w.y = pk2(v.z, v.w); ((u32x2*)O)[i] = w; }
}
__global__ __launch_bounds__(256) void k_final(const float* __restrict__ X, const float* __restrict__ g, float* __restrict__ O) {
    const int lane = threadIdx.x & 63, gw = (blockIdx.x * blockDim.x + threadIdx.x) >> 6, ngw = (gridDim.x * blockDim.x) >> 6;
    for (int m = gw; m < M; m += ngw) {
        const f32x4* xr = (const f32x4*)(X + (size_t)m * D) + lane; f32x4 v[4]; float s = 0.f;
#pragma unroll
        for (int j = 0; j < 4; ++j) { v[j] = xr[64 * j]; s += v[j].x * v[j].x + v[j].y * v[j].y + v[j].z * v[j].z + v[j].w * v[j].w; }
        const float rstd = rsqrtf(wave_sum(s) * (1.f / D) + EPS);
        f32x4* o = (f32x4*)(O + (size_t)m * D) + lane;
#pragma unroll
        for (int j = 0; j < 4; ++j) { const f32x4 gg = ((const f32x4*)g)[lane + 64 * j]; o[64 * j] = v[j] * rstd * gg; }
    }
}
__global__ __launch_bounds__(256) void k_combine_conv(const bf16_t* __restrict__ O1, const bf16_t* __restrict__ O2, const bf16_t* __restrict__ Z,
        const float* lq1, const float* lk1, const float* lq2, const float* lk2, const float* g_subln,
        const float* w_dw, const float* b_dw, const float* g_ln, const float* b_ln, bf16_t* __restrict__ AC) {
    const int lane = threadIdx.x & 63, gw = (blockIdx.x * blockDim.x + threadIdx.x) >> 6, ngw = (gridDim.x * blockDim.x) >> 6;
    const float lam = __expf(wave_sum(lq1[lane] * lk1[lane])) - __expf(wave_sum(lq2[lane] * lk2[lane])) + LAM_INIT;
    const int c0 = lane * 8;
    for (int m = gw; m < M; m += ngw) {
        { const u32x4 a = *(const u32x4*)(O1 + (size_t)m * AW + c0), b = *(const u32x4*)(O2 + (size_t)m * AW + c0);
          float d[8]; float ss = 0.f;
#pragma unroll
          for (int i = 0; i < 4; ++i) { const unsigned ua = a[i], ub = b[i];
              d[2 * i] = __uint_as_float(ua << 16) - lam * __uint_as_float(ub << 16); d[2 * i + 1] = __uint_as_float(ua & 0xffff0000u) - lam * __uint_as_float(ub & 0xffff0000u);
              ss += d[2 * i] * d[2 * i] + d[2 * i + 1] * d[2 * i + 1]; }
          ss += __shfl_xor(ss, 1); ss += __shfl_xor(ss, 2); ss += __shfl_xor(ss, 4); ss += __shfl_xor(ss, 8);
          const float rstd = rsqrtf(ss * (1.f / 128.f) + EPS) * (1.f - LAM_INIT);
          const int e0 = c0 & 127; u32x4 w;
#pragma unroll
          for (int i = 0; i < 4; ++i) w[i] = pk2(d[2 * i] * rstd * g_subln[e0 + 2 * i], d[2 * i + 1] * rstd * g_subln[e0 + 2 * i + 1]);
          *(u32x4*)(AC + (size_t)m * D + c0) = w; }
        { const int t = m % SEQ; float y[8];
#pragma unroll
          for (int i = 0; i < 8; ++i) y[i] = b_dw[c0 + i];
          for (int k = 0; k < KC; ++k) { const int tt = t - (KC - 1) + k; if (tt < 0) continue;
              const u32x4 zz = *(const u32x4*)(Z + (size_t)(m - (KC - 1) + k) * CW + c0); const f32x4 w0 = *(const f32x4*)(w_dw + k * CW + c0), w1 = *(const f32x4*)(w_dw + k * CW + c0 + 4);
              y[0] += w0.x * __uint_as_float(zz.x << 16); y[1] += w0.y * __uint_as_float(zz.x & 0xffff0000u); y[2] += w0.z * __uint_as_float(zz.y << 16); y[3] += w0.w * __uint_as_float(zz.y & 0xffff0000u);
              y[4] += w1.x * __uint_as_float(zz.z << 16); y[5] += w1.y * __uint_as_float(zz.z & 0xffff0000u); y[6] += w1.z * __uint_as_float(zz.w << 16); y[7] += w1.w * __uint_as_float(zz.w & 0xffff0000u); }
          float s = 0.f;
#pragma unroll
          for (int i = 0; i < 8; ++i) s += y[i];
          const float mu = wave_sum(s) * (1.f / CW); float q = 0.f;
#pragma unroll
          for (int i = 0; i < 8; ++i) { y[i] -= mu; q += y[i] * y[i]; }
          const float rstd = rsqrtf(wave_sum(q) * (1.f / CW) + EPS); u32x4 w;
#pragma unroll
          for (int i = 0; i < 4; ++i) { float a = y[2 * i] * rstd * g_ln[c0 + 2 * i] + b_ln[c0 + 2 * i], b = y[2 * i + 1] * rstd * g_ln[c0 + 2 * i + 1] + b_ln[c0 + 2 * i + 1];
              a = a * sigmoidf_(a); b = b * sigmoidf_(b); w[i] = pk2(a, b); }
          *(u32x4*)(AC + (size_t)m * D + AW + c0) = w; }
    }
}
__global__ __launch_bounds__(256) void k_moe_combine(float* __restrict__ H, const bf16_t* __restrict__ Y, const float* __restrict__ g, bf16_t* __restrict__ U3) {
    const int lane = threadIdx.x & 63, gw = (blockIdx.x * blockDim.x + threadIdx.x) >> 6, ngw = (gridDim.x * blockDim.x) >> 6;
    for (int m = gw; m < M; m += ngw) {
        f32x4* xr = (f32x4*)(H + (size_t)m * D) + lane; f32x4 v[4]; float s = 0.f;
#pragma unroll
        for (int j = 0; j < 4; ++j) { v[j] = xr[64 * j];
#pragma unroll
            for (int k = 0; k < TOPK; ++k) { const u32x2 y = ((const u32x2*)(Y + ((size_t)m * TOPK + k) * D))[lane + 64 * j];
                v[j].x += __uint_as_float(y.x << 16); v[j].y += __uint_as_float(y.x & 0xffff0000u); v[j].z += __uint_as_float(y.y << 16); v[j].w += __uint_as_float(y.y & 0xffff0000u); }
            xr[64 * j] = v[j]; s += v[j].x * v[j].x + v[j].y * v[j].y + v[j].z * v[j].z + v[j].w * v[j].w; }
        const float rstd = rsqrtf(wave_sum(s) * (1.f / D) + EPS);
        u32x2* o8 = (u32x2*)(U3 + (size_t)m * D) + lane;
#pragma unroll
        for (int j = 0; j < 4; ++j) { const f32x4 gg = ((const f32x4*)g)[lane + 64 * j]; u32x2 w; w.x = pk2(v[j].x * rstd * gg.x, v[j].y * rstd * gg.y); w.y = pk2(v[j].z * rstd * gg.z, v[j].w * rstd * gg.w); o8[64 * j] = w; }
    }
}

template <int N> __device__ __forceinline__ void fold(float (&v)[32], bool up, int mask) {
#pragma unroll
    for (int i = 0; i < N / 2; ++i) { const float mine = up ? v[i + N / 2] : v[i], other = up ? v[i] : v[i + N / 2]; v[i] = mine + __shfl_xor(other, mask); }
}
__device__ __forceinline__ unsigned long long wave_max_u64(unsigned long long k) {
#pragma unroll
    for (int o = 1; o < 64; o <<= 1) { const unsigned lo = __shfl_xor((unsigned)k, o), hi = __shfl_xor((unsigned)(k >> 32), o); const unsigned long long other = ((unsigned long long)hi << 32) | lo; k = other > k ? other : k; }
    return k;
}
constexpr int ROUTER_LDS = NE * D * 4 + 8192;
__global__ __launch_bounds__(512) void k_router(const float* __restrict__ H, const float* __restrict__ g_ffn, const float* __restrict__ w_router, const float* __restrict__ b_router,
        bf16_t* __restrict__ U2, int* __restrict__ topk_e, float* __restrict__ topk_g, int* __restrict__ list, unsigned* __restrict__ gcnt) {
    extern __shared__ __attribute__((aligned(16))) unsigned char lds[];
    float* wT = (float*)lds; int* lcnt = (int*)(lds + NE * D * 4); int* lbase = lcnt + 32; int* sl_e = lbase + 32; int* sl_r = sl_e + 512;
    const int tid = threadIdx.x, lane = tid & 63, wave = tid >> 6;
    for (int i = tid; i < NE * D; i += 512) { const int k = i >> 5, e = i & 31; wT[e * D + k] = w_router[i]; }
    if (tid < 32) lcnt[tid] = 0;
    __syncthreads();
    f32x4 gg[4];
#pragma unroll
    for (int j = 0; j < 4; ++j) gg[j] = ((const f32x4*)g_ffn)[lane + 64 * j];
    const int my_e = (lane >> 1) & 31; const float my_b = b_router[my_e];
    for (int t0 = blockIdx.x * 128; t0 < M; t0 += gridDim.x * 128) {
        for (int pr = 0; pr < 8; ++pr) {
            const int tl = wave * 16 + pr * 2, m0 = t0 + tl;
            f32x4 u0[4], u1[4]; float s0 = 0.f, s1 = 0.f;
#pragma unroll
            for (int j = 0; j < 4; ++j) { u0[j] = ((const f32x4*)(H + (size_t)m0 * D))[lane + 64 * j]; u1[j] = ((const f32x4*)(H + (size_t)(m0 + 1) * D))[lane + 64 * j];
                s0 += u0[j].x * u0[j].x + u0[j].y * u0[j].y + u0[j].z * u0[j].z + u0[j].w * u0[j].w; s1 += u1[j].x * u1[j].x + u1[j].y * u1[j].y + u1[j].z * u1[j].z + u1[j].w * u1[j].w; }
            const float r0 = rsqrtf(wave_sum(s0) * (1.f / D) + EPS), r1 = rsqrtf(wave_sum(s1) * (1.f / D) + EPS);
#pragma unroll
            for (int j = 0; j < 4; ++j) { u0[j] = u0[j] * r0 * gg[j]; u1[j] = u1[j] * r1 * gg[j];
                u32x2 w; w.x = pk2(u0[j].x, u0[j].y); w.y = pk2(u0[j].z, u0[j].w); ((u32x2*)(U2 + (size_t)m0 * D))[lane + 64 * j] = w;
                w.x = pk2(u1[j].x, u1[j].y); w.y = pk2(u1[j].z, u1[j].w); ((u32x2*)(U2 + (size_t)(m0 + 1) * D))[lane + 64 * j] = w; }
            float p0[32], p1[32];
#pragma unroll
            for (int e = 0; e < 32; ++e) { float a0 = 0.f, a1 = 0.f;
#pragma unroll
                for (int j = 0; j < 4; ++j) { const f32x4 w4 = *(const f32x4*)(wT + e * D + 256 * j + 4 * lane);
                    a0 += u0[j].x * w4.x + u0[j].y * w4.y + u0[j].z * w4.z + u0[j].w * w4.w; a1 += u1[j].x * w4.x + u1[j].y * w4.y + u1[j].z * w4.z + u1[j].w * w4.w; }
                p0[e] = a0; p1[e] = a1; }
            fold<32>(p0, lane & 32, 32); fold<32>(p1, lane & 32, 32);
            fold<16>(p0, lane & 16, 16); fold<16>(p1, lane & 16, 16);
            fold<8>(p0, lane & 8, 8); fold<8>(p1, lane & 8, 8);
            fold<4>(p0, lane & 4, 4); fold<4>(p1, lane & 4, 4);
            fold<2>(p0, lane & 2, 2); fold<2>(p1, lane & 2, 2);
            float lg[2]; lg[0] = p0[0] + __shfl_xor(p0[0], 1) + my_b; lg[1] = p1[0] + __shfl_xor(p1[0], 1) + my_b;
#pragma unroll
            for (int q = 0; q < 2; ++q) {
                unsigned ub = __float_as_uint(lg[q]); ub = (ub & 0x80000000u) ? ~ub : (ub | 0x80000000u);
                unsigned long long key = ((unsigned long long)ub << 32) | (unsigned)(31 - my_e);
                int te[4]; float tv[4];
#pragma unroll
                for (int k = 0; k < 4; ++k) { const unsigned long long w = wave_max_u64(key); const int we = 31 - (int)(w & 63u); unsigned vb = (unsigned)(w >> 32); vb = (vb & 0x80000000u) ? (vb & 0x7fffffffu) : ~vb;
                    te[k] = we; tv[k] = __uint_as_float(vb); if (my_e == we) key = 0ull; }
                const float e1 = __expf(tv[1] - tv[0]), e2 = __expf(tv[2] - tv[0]), e3 = __expf(tv[3] - tv[0]), inv = 1.f / (1.f + e1 + e2 + e3);
                const int m = m0 + q;
                if (lane < 4) { const int e = lane == 0 ? te[0] : lane == 1 ? te[1] : lane == 2 ? te[2] : te[3]; const float gv = (lane == 0 ? 1.f : lane == 1 ? e1 : lane == 2 ? e2 : e3) * inv;
                    topk_e[m * 4 + lane] = e; topk_g[m * 4 + lane] = gv;
                    const int r = atomicAdd(&lcnt[e], 1); sl_e[(tl + q) * 4 + lane] = e; sl_r[(tl + q) * 4 + lane] = r; }
            }
        }
        __syncthreads();
        if (tid < 32) { lbase[tid] = (int)atomicAdd(&gcnt[tid], (unsigned)lcnt[tid]); }
        __syncthreads();
        { const int e = sl_e[tid], pos = lbase[e] + sl_r[tid]; list[e * LIST_CAP + pos] = t0 * 4 + tid; }
        __syncthreads();
        if (tid < 32) lcnt[tid] = 0;
        __syncthreads();
    }
}
__global__ void k_ebase(const unsigned* gcnt, unsigned* ebase) {
    if (threadIdx.x == 0) { unsigned a = 0; for (int e = 0; e < NE; ++e) { ebase[e] = a; a += (gcnt[e] + 255u) / 256u * 256u; } ebase[NE] = a; }
}

__global__ __launch_bounds__(256) void k_attn_naive(const bf16_t* __restrict__ Q, const bf16_t* __restrict__ K, const bf16_t* __restrict__ V, bf16_t* __restrict__ O1, bf16_t* __restrict__ O2) {
    __shared__ float qs[2][16][64]; __shared__ float ks[2][32][65]; __shared__ float vs[32][128]; __shared__ float ps[2][16][32];
    const int tid = threadIdx.x, r = tid >> 4, j = tid & 15;
    const int qt = blockIdx.x % (SEQ / 16), bh = blockIdx.x / (SEQ / 16), h = bh % NH, b = bh / NH;
    const int q0 = qt * 16; const size_t rowb = (size_t)b * SEQ;
    for (int i = tid; i < 2 * 16 * 64; i += 256) { const int c = i >> 10, rr = (i >> 6) & 15, d = i & 63; qs[c][rr][d] = bf2f(Q[(rowb + q0 + rr) * AW + h * 128 + c * 64 + d]); }
    float mx0 = -INFINITY, mx1 = -INFINITY, l0 = 0.f, l1 = 0.f; float o0[8], o1[8];
#pragma unroll
    for (int i = 0; i < 8; ++i) { o0[i] = 0.f; o1[i] = 0.f; }
    const int nt = q0 / 32 + 1;
    for (int kt = 0; kt < nt; ++kt) {
        __syncthreads();
        for (int i = tid; i < 2 * 32 * 64; i += 256) { const int c = i >> 11, kk = (i >> 6) & 31, d = i & 63; ks[c][kk][d] = bf2f(K[(rowb + kt * 32 + kk) * AW + h * 128 + c * 64 + d]); }
        for (int i = tid; i < 32 * 128; i += 256) { const int kk = i >> 7, d = i & 127; vs[kk][d] = bf2f(V[(rowb + kt * 32 + kk) * AW + h * 128 + d]); }
        __syncthreads();
        float al0, al1;
        { float sa = 0.f, sb = 0.f;
          for (int d = 0; d < 64; ++d) { const float qv = qs[0][r][d]; sa += qv * ks[0][j][d]; sb += qv * ks[0][j + 16][d]; }
          if (kt * 32 + j > q0 + r) sa = -INFINITY; if (kt * 32 + j + 16 > q0 + r) sb = -INFINITY;
          float tm = fmaxf(sa, sb); tm = fmaxf(tm, __shfl_xor(tm, 1)); tm = fmaxf(tm, __shfl_xor(tm, 2)); tm = fmaxf(tm, __shfl_xor(tm, 4)); tm = fmaxf(tm, __shfl_xor(tm, 8));
          const float mn = fmaxf(mx0, tm); al0 = exp2f(mx0 - mn); mx0 = mn; const float pa = exp2f(sa - mn), pb = exp2f(sb - mn); ps[0][r][j] = pa; ps[0][r][j + 16] = pb;
          float sum = pa + pb; sum += __shfl_xor(sum, 1); sum += __shfl_xor(sum, 2); sum += __shfl_xor(sum, 4); sum += __shfl_xor(sum, 8); l0 = l0 * al0 + sum; }
        { float sa = 0.f, sb = 0.f;
          for (int d = 0; d < 64; ++d) { const float qv = qs[1][r][d]; sa += qv * ks[1][j][d]; sb += qv * ks[1][j + 16][d]; }
          if (kt * 32 + j > q0 + r) sa = -INFINITY; if (kt * 32 + j + 16 > q0 + r) sb = -INFINITY;
          float tm = fmaxf(sa, sb); tm = fmaxf(tm, __shfl_xor(tm, 1)); tm = fmaxf(tm, __shfl_xor(tm, 2)); tm = fmaxf(tm, __shfl_xor(tm, 4)); tm = fmaxf(tm, __shfl_xor(tm, 8));
          const float mn = fmaxf(mx1, tm); al1 = exp2f(mx1 - mn); mx1 = mn; const float pa = exp2f(sa - mn), pb = exp2f(sb - mn); ps[1][r][j] = pa; ps[1][r][j + 16] = pb;
          float sum = pa + pb; sum += __shfl_xor(sum, 1); sum += __shfl_xor(sum, 2); sum += __shfl_xor(sum, 4); sum += __shfl_xor(sum, 8); l1 = l1 * al1 + sum; }
        __syncthreads();
#pragma unroll
        for (int i = 0; i < 8; ++i) { o0[i] *= al0; o1[i] *= al1; }
        for (int kk = 0; kk < 32; ++kk) { const float pa = ps[0][r][kk], pb = ps[1][r][kk];
#pragma unroll
            for (int i = 0; i < 8; ++i) { const float vv = vs[kk][j * 8 + i]; o0[i] += pa * vv; o1[i] += pb * vv; } }
    }
    const size_t orow = (rowb + q0 + r) * AW + h * 128 + j * 8;
    { const float il = 1.f / l0; u32x4 w; w.x = pk2(o0[0] * il, o0[1] * il); w.y = pk2(o0[2] * il, o0[3] * il); w.z = pk2(o0[4] * il, o0[5] * il); w.w = pk2(o0[6] * il, o0[7] * il); *(u32x4*)(O1 + orow) = w; }
    { const float il = 1.f / l1; u32x4 w; w.x = pk2(o1[0] * il, o1[1] * il); w.y = pk2(o1[2] * il, o1[3] * il); w.z = pk2(o1[4] * il, o1[5] * il); w.w = pk2(o1[6] * il, o1[7] * il); *(u32x4*)(O2 + orow) = w; }
}

template <class P> __global__ __launch_bounds__(256) void k_ngemm(P p) {
    __shared__ float As[16][68]; __shared__ float Bs0[16][64]; __shared__ float Bs1[P::DUAL ? 16 : 1][64];
    const int tid = threadIdx.x, tx = tid & 15, ty = tid >> 4, mt = blockIdx.y, n0 = blockIdx.x * 64;
    if (!p.tile_ok(mt)) return;
    const int ctx = p.tile_ctx(mt);
    float a0[4][4], a1[4][4];
#pragma unroll
    for (int i = 0; i < 4; ++i)
#pragma unroll
        for (int jn = 0; jn < 4; ++jn) { a0[i][jn] = 0.f; a1[i][jn] = 0.f; }
    const int ar = tid >> 2, ak = (tid & 3) * 4; const bf16_t* arow = p.arow(mt, ar);
    const int bk = tid >> 4, bn = (tid & 15) * 4;
    for (int k0 = 0; k0 < p.K; k0 += 16) {
        const u32x2 av = *(const u32x2*)(arow + k0 + ak);
        f32x4 b0, b1; p.loadB(ctx, k0 + bk, n0 + bn, b0, b1);
        __syncthreads();
        As[ak + 0][ar] = __uint_as_float(av.x << 16); As[ak + 1][ar] = __uint_as_float(av.x & 0xffff0000u); As[ak + 2][ar] = __uint_as_float(av.y << 16); As[ak + 3][ar] = __uint_as_float(av.y & 0xffff0000u);
        *(f32x4*)&Bs0[bk][bn] = b0; if (P::DUAL) *(f32x4*)&Bs1[bk][bn] = b1;
        __syncthreads();
#pragma unroll
        for (int kk = 0; kk < 16; ++kk) {
            const f32x4 a = *(const f32x4*)&As[kk][ty * 4], x0 = *(const f32x4*)&Bs0[kk][tx * 4]; f32x4 x1 = x0; if (P::DUAL) x1 = *(const f32x4*)&Bs1[kk][tx * 4];
#pragma unroll
            for (int i = 0; i < 4; ++i)
#pragma unroll
                for (int jn = 0; jn < 4; ++jn) { a0[i][jn] += a[i] * x0[jn]; if (P::DUAL) a1[i][jn] += a[i] * x1[jn]; }
        }
    }
#pragma unroll
    for (int i = 0; i < 4; ++i) p.store(mt, ty * 4 + i, n0 + tx * 4, a0[i], a1[i]);
}
__device__ __forceinline__ void st_bf16x4(bf16_t* p, float a, float b, float c, float d) { u32x2 w; w.x = pk2(a, b); w.y = pk2(c, d); *(u32x2*)p = w; }

struct PInA { static constexpr bool DUAL = false; int K, pad; const bf16_t* XN; const float* W; bf16_t *Q, *Kb, *V, *SGA, *SGB;
    __device__ bool tile_ok(int) const { return true; }
    __device__ int tile_ctx(int) const { return 0; }
    __device__ const bf16_t* arow(int mt, int r) const { return XN + (size_t)(mt * 64 + r) * D; }
    __device__ void loadB(int, int k, int n, f32x4& b0, f32x4& b1) const { const int raw = n < 1536 ? n : n + 1024; b0 = *(const f32x4*)(W + (size_t)k * INC + raw); b1 = b0; }
    __device__ void store(int mt, int r, int n, const float (&a)[4], const float (&)[4]) const { const size_t m = (size_t)mt * 64 + r;
        if (n < 512) st_bf16x4(Q + m * AW + n, a[0] * C2, a[1] * C2, a[2] * C2, a[3] * C2);
        else if (n < 1024) st_bf16x4(Kb + m * AW + n - 512, a[0], a[1], a[2], a[3]);
        else if (n < 1536) st_bf16x4(V + m * AW + n - 1024, a[0], a[1], a[2], a[3]);
        else if (n < 2560) st_bf16x4(SGA + m * D + n - 1536, sigmoidf_(a[0]), sigmoidf_(a[1]), sigmoidf_(a[2]), sigmoidf_(a[3]));
        else st_bf16x4(SGB + m * D + n - 2560, sigmoidf_(a[0]), sigmoidf_(a[1]), sigmoidf_(a[2]), sigmoidf_(a[3])); } };
struct PInZ { static constexpr bool DUAL = true; int K, pad; const bf16_t* XN; const float* W; bf16_t* Z;
    __device__ bool tile_ok(int) const { return true; }
    __device__ int tile_ctx(int) const { return 0; }
    __device__ const bf16_t* arow(int mt, int r) const { return XN + (size_t)(mt * 64 + r) * D; }
    __device__ void loadB(int, int k, int n, f32x4& b0, f32x4& b1) const { b0 = *(const f32x4*)(W + (size_t)k * INC + 1536 + n); b1 = *(const f32x4*)(W + (size_t)k * INC + 2048 + n); }
    __device__ void store(int mt, int r, int n, const float (&a)[4], const float (&g)[4]) const { const size_t m = (size_t)mt * 64 + r;
        st_bf16x4(Z + m * CW + n, a[0] * sigmoidf_(g[0]), a[1] * sigmoidf_(g[1]), a[2] * sigmoidf_(g[2]), a[3] * sigmoidf_(g[3])); } };
struct PMixA { static constexpr bool DUAL = false; int K, pad; const bf16_t* AC; const float* W; const bf16_t* SG; bf16_t* T;
    __device__ bool tile_ok(int) const { return true; }
    __device__ int tile_ctx(int) const { return 0; }
    __device__ const bf16_t* arow(int mt, int r) const { return AC + (size_t)(mt * 64 + r) * D; }
    __device__ void loadB(int, int k, int n, f32x4& b0, f32x4& b1) const { b0 = *(const f32x4*)(W + (size_t)k * D + n); b1 = b0; }
    __device__ void store(int mt, int r, int n, const float (&a)[4], const float (&)[4]) const { const size_t o = ((size_t)mt * 64 + r) * D + n;
        st_bf16x4(T + o, a[0] * bf2f(SG[o]), a[1] * bf2f(SG[o + 1]), a[2] * bf2f(SG[o + 2]), a[3] * bf2f(SG[o + 3])); } };
struct PMixB { static constexpr bool DUAL = false; int K, pad; const bf16_t* AC; const float* W; const bf16_t* SG; const bf16_t* T; bf16_t* M1;
    __device__ bool tile_ok(int) const { return true; }
    __device__ int tile_ctx(int) const { return 0; }
    __device__ const bf16_t* arow(int mt, int r) const { return AC + (size_t)(mt * 64 + r) * D + AW; }
    __device__ void loadB(int, int k, int n, f32x4& b0, f32x4& b1) const { b0 = *(const f32x4*)(W + (size_t)k * D + n); b1 = b0; }
    __device__ void store(int mt, int r, int n, const float (&a)[4], const float (&)[4]) const { const size_t o = ((size_t)mt * 64 + r) * D + n;
        st_bf16x4(M1 + o, bf2f(T[o]) + a[0] * bf2f(SG[o]), bf2f(T[o + 1]) + a[1] * bf2f(SG[o + 1]), bf2f(T[o + 2]) + a[2] * bf2f(SG[o + 2]), bf2f(T[o + 3]) + a[3] * bf2f(SG[o + 3])); } };
struct PWo { static constexpr bool DUAL = false; int K, pad; const bf16_t* A; const float* W; const float* X; float* H;
    __device__ bool tile_ok(int) const { return true; }
    __device__ int tile_ctx(int) const { return 0; }
    __device__ const bf16_t* arow(int mt, int r) const { return A + (size_t)(mt * 64 + r) * D; }
    __device__ void loadB(int, int k, int n, f32x4& b0, f32x4& b1) const { b0 = *(const f32x4*)(W + (size_t)k * D + n); b1 = b0; }
    __device__ void store(int mt, int r, int n, const float (&a)[4], const float (&)[4]) const { const size_t o = ((size_t)mt * 64 + r) * D + n;
        const f32x4 x = *(const f32x4*)(X + o); *(f32x4*)(H + o) = (f32x4){x.x + a[0], x.y + a[1], x.z + a[2], x.w + a[3]}; } };
struct MoeTab { const unsigned* gcnt; const unsigned* ebase; const int* list;
    __device__ int expert_of(unsigned grow) const { int e = 0; for (int i = 1; i < NE; ++i) if (ebase[i] <= grow) e = i; return e; } };
struct PGateUp { static constexpr bool DUAL = true; int K, pad; MoeTab tb; const bf16_t* U2; const float* W; const float* bias; bf16_t* ACT;
    __device__ bool tile_ok(int mt) const { const unsigned g0 = (unsigned)mt * 64u; if (g0 >= tb.ebase[NE]) return false; const int e = tb.expert_of(g0); return g0 - tb.ebase[e] < tb.gcnt[e]; }
    __device__ const bf16_t* arow(int mt, int r) const { const unsigned g = (unsigned)mt * 64u + r; const int e = tb.expert_of(g); const unsigned pos = g - tb.ebase[e];
        const int tok = pos < tb.gcnt[e] ? (tb.list[e * LIST_CAP + pos] >> 2) : 0; return U2 + (size_t)tok * D; }
    __device__ int tile_ctx(int mt) const { return tb.expert_of((unsigned)mt * 64u); }
    __device__ void loadB(int e, int k, int n, f32x4& b0, f32x4& b1) const { const float* w = W + ((size_t)e * D + k) * (2 * FF) + 2 * n;
        const f32x4 x = *(const f32x4*)w, y = *(const f32x4*)(w + 4); b0 = (f32x4){x.x, x.z, y.x, y.z}; b1 = (f32x4){x.y, x.w, y.y, y.w}; }
    __device__ void store(int mt, int r, int n, const float (&a)[4], const float (&c)[4]) const { const unsigned g = (unsigned)mt * 64u + r; const int e = tb.expert_of(g);
        if (g - tb.ebase[e] >= tb.gcnt[e]) return; float o[4];
#pragma unroll
        for (int i = 0; i < 4; ++i) { const float gate = fminf(a[i] + bias[e * 2 * FF + 2 * (n + i)], 7.f), lin = fminf(fmaxf(c[i] + bias[e * 2 * FF + 2 * (n + i) + 1], -7.f), 7.f);
            o[i] = (lin + 1.f) * gate * sigmoidf_(1.702f * gate); }
        st_bf16x4(ACT + (size_t)g * FF + n, o[0], o[1], o[2], o[3]); } };
struct PDown { static constexpr bool DUAL = false; int K, pad; MoeTab tb; const bf16_t* ACT; const float* W; const float* bias; const float* topk_g; bf16_t* Y;
    __device__ bool tile_ok(int mt) const { const unsigned g0 = (unsigned)mt * 64u; if (g0 >= tb.ebase[NE]) return false; const int e = tb.expert_of(g0); return g0 - tb.ebase[e] < tb.gcnt[e]; }
    __device__ const bf16_t* arow(int mt, int r) const { const unsigned g = (unsigned)mt * 64u + r; const int e = tb.expert_of(g); const unsigned pos = g - tb.ebase[e];
        return ACT + (size_t)(pos < tb.gcnt[e] ? g : tb.ebase[e]) * FF; }
    __device__ int tile_ctx(int mt) const { return tb.expert_of((unsigned)mt * 64u); }
    __device__ void loadB(int e, int k, int n, f32x4& b0, f32x4& b1) const { b0 = *(const f32x4*)(W + ((size_t)e * FF + k) * D + n); b1 = b0; }
    __device__ void store(int mt, int r, int n, const float (&a)[4], const float (&)[4]) const { const unsigned g = (unsigned)mt * 64u + r; const int e = tb.expert_of(g); const unsigned pos = g - tb.ebase[e];
        if (pos >= tb.gcnt[e]) return; const int slot = tb.list[e * LIST_CAP + pos]; const float gv = topk_g[slot]; const float* bb = bias + e * D + n;
        st_bf16x4(Y + (size_t)slot * D + n, (a[0] + bb[0]) * gv, (a[1] + bb[1]) * gv, (a[2] + bb[2]) * gv, (a[3] + bb[3]) * gv); } };
struct PPle1 { static constexpr bool DUAL = false; int K, pad; const bf16_t* PP; const float* W; bf16_t* E1;
    __device__ bool tile_ok(int) const { return true; }
    __device__ int tile_ctx(int) const { return 0; }
    __device__ const bf16_t* arow(int mt, int r) const { return PP + (size_t)(mt * 64 + r) * PLE; }
    __device__ void loadB(int, int k, int n, f32x4& b0, f32x4& b1) const { b0 = *(const f32x4*)(W + (size_t)k * D + n); b1 = b0; }
    __device__ void store(int mt, int r, int n, const float (&a)[4], const float (&)[4]) const { st_bf16x4(E1 + ((size_t)mt * 64 + r) * D + n, a[0], a[1], a[2], a[3]); } };
struct PPle2 { static constexpr bool DUAL = false; int K, pad; const bf16_t* U3; const float* W; const bf16_t* E1; float* H;
    __device__ bool tile_ok(int) const { return true; }
    __device__ int tile_ctx(int) const { return 0; }
    __device__ const bf16_t* arow(int mt, int r) const { return U3 + (size_t)(mt * 64 + r) * D; }
    __device__ void loadB(int, int k, int n, f32x4& b0, f32x4& b1) const { b0 = *(const f32x4*)(W + (size_t)k * D + n); b1 = b0; }
    __device__ void store(int mt, int r, int n, const float (&a)[4], const float (&)[4]) const { const size_t o = ((size_t)mt * 64 + r) * D + n; f32x4 h = *(const f32x4*)(H + o);
        h.x += bf2f(E1[o]) * sigmoidf_(a[0]); h.y += bf2f(E1[o + 1]) * sigmoidf_(a[1]); h.z += bf2f(E1[o + 2]) * sigmoidf_(a[2]); h.w += bf2f(E1[o + 3]) * sigmoidf_(a[3]); *(f32x4*)(H + o) = h; } };

extern "C" void kernel_launch(void* const* d_in, const int* in_sizes, int n_in, void* d_out, int out_size, void* d_ws, size_t ws_size, hipStream_t stream) {
    if (n_in != 27 || in_sizes[0] != M * D || out_size != M * D || ws_size < WS_END) { fprintf(stderr, "kernel_launch: unexpected shapes (n_in %d, in0 %d, out %d, ws %zu)\n", n_in, n_in > 0 ? in_sizes[0] : -1, out_size, ws_size); return; }
    static bool attr = false;
    if (!attr) { (void)hipFuncSetAttribute((const void*)k_router, hipFuncAttributeMaxDynamicSharedMemorySize, ROUTER_LDS); attr = true; }
    const float* const* in = (const float* const*)d_in;
    const float *x = in[0], *p = in[1], *g_mix = in[2], *w_in = in[3], *lq1 = in[4], *lk1 = in[5], *lq2 = in[6], *lk2 = in[7], *g_subln = in[8], *w_ao = in[9], *w_dw = in[10], *b_dw = in[11],
                *g_cln = in[12], *b_cln = in[13], *w_co = in[14], *w_o = in[15], *g_ffn = in[16], *w_router = in[17], *b_router = in[18], *w_gu = in[19], *b_gu = in[20], *w_dn = in[21], *b_dn = in[22],
                *w_ple = in[23], *g_ple = in[24], *w_pg = in[25], *g_final = in[26];
    unsigned char* ws = (unsigned char*)d_ws; float* out = (float*)d_out;
    unsigned* ctl = (unsigned*)(ws + WS_CTL); int* topk_e = (int*)(ws + WS_TOPK_E); float* topk_g = (float*)(ws + WS_TOPK_G); int* list = (int*)(ws + WS_LIST);
    bf16_t *PP = (bf16_t*)(ws + WS_PP), *XN = (bf16_t*)(ws + WS_XN), *Q = (bf16_t*)(ws + WS_Q), *Kb = (bf16_t*)(ws + WS_K), *V = (bf16_t*)(ws + WS_V), *Z = (bf16_t*)(ws + WS_Z),
           *SGA = (bf16_t*)(ws + WS_SGA), *SGB = (bf16_t*)(ws + WS_SGB), *O1 = (bf16_t*)(ws + WS_O1), *O2 = (bf16_t*)(ws + WS_O2), *AC = (bf16_t*)(ws + WS_AC), *T = (bf16_t*)(ws + WS_T),
           *M1 = (bf16_t*)(ws + WS_M1), *Y = (bf16_t*)(ws + WS_Y), *ACT = (bf16_t*)(ws + WS_ACT), *U3 = (bf16_t*)(ws + WS_U3), *E1 = (bf16_t*)(ws + WS_E1);
    float* H = (float*)(ws + WS_H);
    (void)hipMemsetAsync(ws + WS_CTL, 0, CTL_ZERO_BYTES, stream);
    const dim3 b256(256);
    k_rmsnorm_bf16<<<2048, b256, 0, stream>>>(x, g_mix, XN);
    k_cvt_bf16<<<2048, b256, 0, stream>>>(p, PP, (size_t)M * PLE / 4);
    { PInA P{D, 0, XN, w_in, Q, Kb, V, SGA, SGB}; k_ngemm<PInA><<<dim3(3584 / 64, M / 64), b256, 0, stream>>>(P); }
    { PInZ P{D, 0, XN, w_in, Z}; k_ngemm<PInZ><<<dim3(CW / 64, M / 64), b256, 0, stream>>>(P); }
    k_attn_naive<<<BATCH * NH * (SEQ / 16), b256, 0, stream>>>(Q, Kb, V, O1, O2);
    k_combine_conv<<<2048, b256, 0, stream>>>(O1, O2, Z, lq1, lk1, lq2, lk2, g_subln, w_dw, b_dw, g_cln, b_cln, AC);
    { PMixA P{AW, 0, AC, w_ao, SGA, T}; k_ngemm<PMixA><<<dim3(D / 64, M / 64), b256, 0, stream>>>(P); }
    { PMixB P{CW, 0, AC, w_co, SGB, T, M1}; k_ngemm<PMixB><<<dim3(D / 64, M / 64), b256, 0, stream>>>(P); }
    { PWo P{D, 0, M1, w_o, x, H}; k_ngemm<PWo><<<dim3(D / 64, M / 64), b256, 0, stream>>>(P); }
    k_router<<<256, 512, ROUTER_LDS, stream>>>(H, g_ffn, w_router, b_router, XN, topk_e, topk_g, list, ctl + CW_GCNT);
    k_ebase<<<1, 64, 0, stream>>>(ctl + CW_GCNT, ctl + CW_EBASE);
    MoeTab tb{ctl + CW_GCNT, ctl + CW_EBASE, list};
    { PGateUp P{D, 0, tb, XN, w_gu, b_gu, ACT}; k_ngemm<PGateUp><<<dim3(FF / 64, ACT_ROWS / 64), b256, 0, stream>>>(P); }
    { PDown P{FF, 0, tb, ACT, w_dn, b_dn, topk_g, Y}; k_ngemm<PDown><<<dim3(D / 64, ACT_ROWS / 64), b256, 0, stream>>>(P); }
    k_moe_combine<<<2048, b256, 0, stream>>>(H, Y, g_ple, U3);
    { PPle1 P{PLE, 0, PP, w_ple, E1}; k_ngemm<PPle1><<<dim3(D / 64, M / 64), b256, 0, stream>>>(P); }
    { PPle2 P{D, 0, U3, w_pg, E1, H}; k_ngemm<PPle2><<<dim3(D / 64, M / 64), b256, 0, stream>>>(P); }
    k_final<<<2048, b256, 0, stream>>>(H, g_final, out);
}
```

```cpp
#include <hip/hip_runtime.h>
#include <cstdio>
#include <cstdint>
#include <hip/hip_bf16.h>
#include <cmath>
#define ONE_LAUNCH 1
#define DUP_MASK 0
#define KREP 1
#define EREP 1
#define HDUP_MASK 0

typedef unsigned short bf16_t;
typedef float f32x4 __attribute__((ext_vector_type(4)));
typedef unsigned u32x4 __attribute__((ext_vector_type(4)));
typedef unsigned u32x2 __attribute__((ext_vector_type(2)));
typedef float f32x2 __attribute__((ext_vector_type(2)));

constexpr int BATCH = 16, SEQ = 2048, D = 1024, M = BATCH * SEQ;
constexpr int AW = 512, CW = 512, NH = 4, HD = 64, KC = 31, NE = 32, TOPK = 4, FF = 1024, PLE = 256;
constexpr int INC = 3 * AW + 2 * CW + 2 * D;
constexpr float EPS = 1e-5f;
constexpr float C2 = 0.125f * 1.4426950408889634f;
constexpr float LAM_INIT = 0.2f;
constexpr int LIST_CAP = M;
constexpr int ACT_ROWS = M * TOPK + NE * 256;
constexpr int UCW = PLE + D;

constexpr size_t MiB = 1u << 20;
constexpr size_t WS_CTL = 0, CTL_ZERO_BYTES = 1 * MiB;
constexpr size_t WS_TOPK_E = 1 * MiB;
constexpr size_t WS_TOPK_G = 2 * MiB;
constexpr size_t WS_TRASH = 3 * MiB;
constexpr size_t WS_LIST = 4 * MiB;
constexpr size_t WS_GLIST = 528 * MiB, GLIST_DELTA = WS_GLIST - 4 * MiB;
constexpr size_t WS_WSM = 8 * MiB;
constexpr size_t WS_WIN = 16 * MiB;
constexpr size_t WS_WGU = 32 * MiB;
constexpr size_t WS_WDN = 160 * MiB;
constexpr size_t WS_UC = 224 * MiB;
constexpr size_t WS_H = 304 * MiB;
constexpr size_t WS_XN = 368 * MiB;
constexpr size_t WS_Q = 432 * MiB, WS_K = 464 * MiB, WS_V = 496 * MiB;
constexpr size_t WS_Z = 528 * MiB;
constexpr size_t WS_SGA = 560 * MiB, WS_SGB = 624 * MiB;
constexpr size_t WS_O1 = 688 * MiB, WS_O2 = 720 * MiB;
constexpr size_t WS_AC = 752 * MiB;
constexpr size_t WS_M1 = 880 * MiB;
constexpr size_t WS_END = 944 * MiB;
constexpr size_t WS_Y = 368 * MiB;
constexpr size_t WS_ACT = 624 * MiB;
constexpr size_t WS_E1 = 688 * MiB;
static_assert(WS_ACT + (size_t)ACT_ROWS * FF <= WS_END && WS_Y + (size_t)M * TOPK * D <= WS_ACT, "overlays");
static_assert(WS_V - WS_K == WS_K - WS_Q, "Q | K | V equally spaced");
constexpr int CW_GCNT = 64;

__device__ __forceinline__ unsigned f2bf(float f) { unsigned u = __float_as_uint(f); return (u + 0x7fffu + ((u >> 16) & 1u)) >> 16; }
__device__ __forceinline__ unsigned pk2(float lo, float hi) { return f2bf(lo) | (f2bf(hi) << 16); }
constexpr float S_U2 = 16.f, S_W8 = 512.f, S_ACT = 4.f, S_Y = 32.f, S_P = 16.f, S_WPLE = 256.f;
__device__ __forceinline__ float clamp448(float x) { return __builtin_fminf(__builtin_fmaxf(x, -448.f), 448.f); }
__device__ __forceinline__ unsigned pk4_fp8(float a, float b, float c, float d) { int w = 0; w = __builtin_amdgcn_cvt_pk_fp8_f32(clamp448(a), clamp448(b), w, false); w = __builtin_amdgcn_cvt_pk_fp8_f32(clamp448(c), clamp448(d), w, true); return (unsigned)w; }
__device__ __forceinline__ void unpk4_fp8(unsigned w, float& a, float& b, float& c, float& d) { const f32x2 lo = __builtin_amdgcn_cvt_pk_f32_fp8((int)w, false), hi = __builtin_amdgcn_cvt_pk_f32_fp8((int)w, true); a = lo.x; b = lo.y; c = hi.x; d = hi.y; }
__device__ __forceinline__ int fresh_lane() { int l; asm volatile("v_mbcnt_lo_u32_b32 %0, -1, 0\n\tv_mbcnt_hi_u32_b32 %0, -1, %0" : "=v"(l)); return l; }
__device__ __forceinline__ float wave_sum(float v) {
#pragma unroll
    for (int o = 1; o < 64; o <<= 1) v += __shfl_xor(v, o);
    return v;
}

namespace pg8 {
#define PG8_LAS __attribute__((address_space(3)))
typedef short bf16x8 __attribute__((ext_vector_type(8)));
typedef int i32x4 __attribute__((ext_vector_type(4)));
constexpr int BM = 256, BK = 64, HALF = 128, HTB = HALF * BK * 2  , STAGE_BYTES = 8 * HTB, NXCD = 8, WGM = 8;

__host__ __device__ __forceinline__ int lds_byte(int r, int c) { const int st = (r >> 4) * 2 + (c >> 5), rr = r & 15, cc = c & 31, ob = rr * 64 + cc * 2; return st * 1024 + (ob ^ (((ob >> 9) & 1) << 5)); }
__host__ __device__ __forceinline__ void stage_rc(int b, int& R, int& C) { const int st = b / 1024, sb = b % 1024, swz = sb ^ (((sb >> 9) & 1) << 5); R = (st >> 1) * 16 + swz / 64; C = (st & 1) * 32 + (swz % 64) / 2; }
__host__ __device__ __forceinline__ int perm32(int rho) { const int n = rho >> 4, i = rho & 15; return 8 * (i >> 2) + 4 * n + (i & 3); }

struct Unit { int pm, pn, e, nv, p0; };
struct Gemm { const bf16_t* A; const bf16_t* Bt; int K, lda; size_t b_estride; };

struct StaticOrder {
    static constexpr bool GATHER = false;
    int nM, nN, nwg, G, c;
    __device__ void init(int M_, int N_, int G_, int c_) { nM = M_ / BM; nN = N_ / BM; nwg = nM * nN; G = G_; c = c_; }
    __device__ bool next(int i, Unit& u) const {
        const long L = (long)i * G + c; if (L >= nwg) return false;
        int wgid = (int)L; { const int q = nwg / NXCD, r = nwg % NXCD, xcd = wgid % NXCD, off = wgid / NXCD; wgid = (xcd < r ? xcd * (q + 1) : r * (q + 1) + (xcd - r) * q) + off; }
        const int nig = WGM * nN, gid = wgid / nig, fm = gid * WGM, gsz = (nM - fm) < WGM ? (nM - fm) : WGM;
        u.pm = fm + ((wgid % nig) % gsz); u.pn = (wgid % nig) / gsz; u.e = 0; u.nv = 256; u.p0 = 0; return true;
    }
    __device__ __forceinline__ unsigned row_off(const Unit&, int) const { return 0u; }
    __device__ __forceinline__ unsigned row_fin(int) const { return 0u; }
    __device__ __forceinline__ const int* idx_src(const Unit&) const { return nullptr; }
    __device__ __forceinline__ void a_ready(const Unit&) const {}
    __device__ __forceinline__ void done(const Unit&) const {}
};
struct InProjOrder {
    static constexpr bool GATHER = false;
    StaticOrder so; int x, j; bool custom;
    __device__ void init(int M_, int N_, int G_, int c_) { so.init(M_, N_, G_, c_); custom = (G_ == 256 && M_ / BM == 128 && N_ / BM == 18); x = c_ % NXCD; j = c_ / NXCD; }
    __device__ bool next(int i, Unit& u) const {
        if (!custom) return so.next(i, u);
        if (i >= 9) return false;
        int pm, pn;
        if (i == 2) { pm = j & 15; pn = 4 + (j >> 4); }
        else { const int k = i < 2 ? i : i - 3;        const int half = i < 2 ? i : (k & 1), grp = i < 2 ? 0 : 6 + 4 * (k >> 1); pm = 8 * half + (j & 7); pn = grp + (j >> 3); }
        u.pm = 16 * x + pm; u.pn = pn; u.e = 0; u.nv = 256; u.p0 = 0; return true;
    }
    __device__ __forceinline__ unsigned row_off(const Unit&, int) const { return 0u; }
    __device__ __forceinline__ unsigned row_fin(int) const { return 0u; }
    __device__ __forceinline__ const int* idx_src(const Unit&) const { return nullptr; }
    __device__ __forceinline__ void a_ready(const Unit&) const {}
    __device__ __forceinline__ void done(const Unit&) const {}
};
template <bool GATHER_> struct MoeOrder {
    static constexpr bool GATHER = GATHER_;
    const PG8_LAS unsigned short* ent; const PG8_LAS int* cnt; const int* list; int nN, G, vcu, TU, ld;
    __device__ bool next(int i, Unit& u) const {
        int mt, pn;
        if (G % (8 * nN) == 0) { const int mpr = G / nN, mpx = mpr / 8, x = vcu / (G / 8), j = vcu % (G / 8); mt = i * mpr + x * mpx + (j % mpx); pn = j / mpx; }
        else { const int L = i * G + vcu; mt = L / nN; pn = L % nN; }
        if (mt >= TU) return false;
        const int v = __builtin_amdgcn_readfirstlane((int)ent[mt]), e = v & 31;
        u.pm = mt; u.pn = pn; u.e = e; u.p0 = 256 * (v >> 5); const int rem = __builtin_amdgcn_readfirstlane(cnt[e]) - u.p0; u.nv = rem < 256 ? rem : 256; return true;
    }
    __device__ __forceinline__ unsigned row_off(const Unit& u, int rl) const { const int r = rl < u.nv ? rl : u.nv - 1; const int tok = list[u.e * LIST_CAP + u.p0 + r] >> 2; return (unsigned)tok * (unsigned)ld; }
    __device__ __forceinline__ unsigned row_fin(int raw) const { return (unsigned)(raw >> 2) * (unsigned)ld; }
    __device__ __forceinline__ const int* idx_src(const Unit& u) const { return list + u.e * LIST_CAP + u.p0; }
    __device__ __forceinline__ void a_ready(const Unit&) const {}
    __device__ __forceinline__ void done(const Unit&) const {}
};

__device__ __forceinline__ unsigned cvt_pk_bf16(float lo, float hi) { unsigned r; asm volatile("v_cvt_pk_bf16_f32 %0, %1, %2" : "=v"(r) : "v"(lo), "v"(hi)); return r; }
__device__ __forceinline__ float fsig(float x) { return __builtin_amdgcn_rcpf(1.f + __builtin_amdgcn_exp2f(-1.4426950408889634f * x)); }
__device__ __forceinline__ u32x4 pack8(const f32x4 a, const f32x4 b) { u32x4 w; w.x = cvt_pk_bf16(a[0], a[1]); w.y = cvt_pk_bf16(a[2], a[3]); w.z = cvt_pk_bf16(b[0], b[1]); w.w = cvt_pk_bf16(b[2], b[3]); return w; }
__device__ __forceinline__ void unpack8(const u32x4 w, f32x4& a, f32x4& b) {
    a[0] = __uint_as_float(w.x << 16); a[1] = __uint_as_float(w.x & 0xffff0000u); a[2] = __uint_as_float(w.y << 16); a[3] = __uint_as_float(w.y & 0xffff0000u);
    b[0] = __uint_as_float(w.z << 16); b[1] = __uint_as_float(w.z & 0xffff0000u); b[2] = __uint_as_float(w.w << 16); b[3] = __uint_as_float(w.w & 0xffff0000u); }

__device__ __forceinline__ u32x4 widen16(u32x2 A, u32x2 B) {
    const auto r0 = __builtin_amdgcn_permlane16_swap(A.x, B.x, false, false), r1 = __builtin_amdgcn_permlane16_swap(A.y, B.y, false, false);
    return (u32x4){r0[0], r1[0], r0[1], r1[1]};
}
struct EpiIn { static constexpr bool PERM = true, AFTER_DRAIN = false, IDEMPOTENT = true, MIDK = false; bf16_t *Q, *K, *V, *Z, *SGA, *SGB;
    __device__ __forceinline__ void operator()(const f32x4 (&acc)[2][2][4][2], const Unit& u, int wr, int wc, int fr, int fq) const {
        const int pn = u.pn, row0 = u.pm * BM + wr * 64 + fr;
        if (pn >= 6 && pn < 10) {
            bf16_t* base = Z + (pn - 6) * 128 + wc * 32 + 8 * fq;
#pragma unroll
            for (int ai = 0; ai < 2; ++ai)
#pragma unroll
                for (int m = 0; m < 4; ++m) { f32x4 o0, o1;
#pragma unroll
                    for (int i = 0; i < 4; ++i) { o0[i] = acc[ai][0][m][0][i] * fsig(acc[ai][1][m][0][i]); o1[i] = acc[ai][0][m][1][i] * fsig(acc[ai][1][m][1][i]); }
                    *(u32x4*)(base + (size_t)(row0 + ai * HALF + m * 16) * CW) = pack8(o0, o1); }
        } else if (pn >= 10) {
            unsigned char* base = (unsigned char*)SGA + (size_t)((pn - 10) >> 2) * (WS_SGB - WS_SGA) + ((pn - 10) & 3) * 256 + wc * 32 + 8 * fq;
#pragma unroll
            for (int ai = 0; ai < 2; ++ai)
#pragma unroll
                for (int m = 0; m < 4; ++m) { unsigned char* rowp = base + (size_t)(row0 + ai * HALF + m * 16) * D;
                    u32x2 w[2];
#pragma unroll
                    for (int bj = 0; bj < 2; ++bj)
#pragma unroll
                        for (int n = 0; n < 2; ++n) { unsigned q[4];
#pragma unroll
                            for (int i = 0; i < 4; ++i) q[i] = (unsigned)__builtin_fmaxf(fsig(acc[ai][bj][m][n][i]) * 255.f + 0.5f, 1.f);
                            w[bj][n] = q[0] | (q[1] << 8) | (q[2] << 16) | (q[3] << 24); }
                    *(u32x4*)(rowp + (fq & 1) * (HALF - 8)) = widen16(w[0], w[1]); }
        } else {
            const float sc = pn < 2 ? C2 : 1.f;
            bf16_t* base = Q + (size_t)(pn >> 1) * ((WS_K - WS_Q) / 2) + (pn & 1) * 256 + wc * 32 + 8 * fq;
#pragma unroll
            for (int ai = 0; ai < 2; ++ai)
#pragma unroll
                for (int m = 0; m < 4; ++m) { bf16_t* rowp = base + (size_t)(row0 + ai * HALF + m * 16) * AW;
#pragma unroll
                    for (int bj = 0; bj < 2; ++bj) *(u32x4*)(rowp + bj * HALF) = pack8(acc[ai][bj][m][0] * sc, acc[ai][bj][m][1] * sc); }
        }
    }
};
struct EpiMixF { static constexpr bool PERM = true, AFTER_DRAIN = false, IDEMPOTENT = true, MIDK = true; static constexpr int MIDT = 8; const unsigned char* SGA; const unsigned char* SGB; bf16_t* Out;
    static __device__ __forceinline__ void ub4(unsigned w, f32x4& o) { o[0] = (float)(w & 0xffu); o[1] = (float)((w >> 8) & 0xffu); o[2] = (float)((w >> 16) & 0xffu); o[3] = (float)(w >> 24); }
    __device__ __forceinline__ void mid(f32x4 (&acc)[2][2][4][2], const Unit& u, int wr, int wc, int fr, int fq) const {
        const int row0 = u.pm * BM + wr * 64 + fr, col0 = u.pn * BM + wc * 32 + 8 * fq;
        u32x2 ra[2][4][2], rb[2][4][2];
#pragma unroll
        for (int ai = 0; ai < 2; ++ai)
#pragma unroll
            for (int m = 0; m < 4; ++m)
#pragma unroll
                for (int bj = 0; bj < 2; ++bj) { const size_t off = (size_t)(row0 + ai * HALF + m * 16) * D + col0 + bj * HALF; ra[ai][m][bj] = *(const u32x2*)(SGA + off); rb[ai][m][bj] = *(const u32x2*)(SGB + off); }
#pragma unroll
        for (int ai = 0; ai < 2; ++ai)
#pragma unroll
            for (int m = 0; m < 4; ++m)
#pragma unroll
                for (int bj = 0; bj < 2; ++bj)
#pragma unroll
                    for (int n = 0; n < 2; ++n) { f32x4 a, b; ub4(ra[ai][m][bj][n], a); ub4(rb[ai][m][bj][n], b);
#pragma unroll
                        for (int i = 0; i < 4; ++i) acc[ai][bj][m][n][i] *= a[i] * __builtin_amdgcn_rcpf(b[i]); }
    }
    __device__ __forceinline__ void operator()(const f32x4 (&acc)[2][2][4][2], const Unit& u, int wr, int wc, int fr, int fq) const {
        const int row0 = u.pm * BM + wr * 64 + fr, col0 = u.pn * BM + wc * 32 + 8 * fq;
        u32x2 rb[2][4][2];
#pragma unroll
        for (int ai = 0; ai < 2; ++ai)
#pragma unroll
            for (int m = 0; m < 4; ++m)
#pragma unroll
                for (int bj = 0; bj < 2; ++bj) rb[ai][m][bj] = *(const u32x2*)(SGB + (size_t)(row0 + ai * HALF + m * 16) * D + col0 + bj * HALF);
#pragma unroll
        for (int ai = 0; ai < 2; ++ai)
#pragma unroll
            for (int m = 0; m < 4; ++m)
#pragma unroll
                for (int bj = 0; bj < 2; ++bj) { const size_t off = (size_t)(row0 + ai * HALF + m * 16) * D + col0 + bj * HALF;
                    f32x4 s0, s1; ub4(rb[ai][m][bj][0], s0); ub4(rb[ai][m][bj][1], s1); *(u32x4*)(Out + off) = pack8(acc[ai][bj][m][0] * (s0 * (1.f / 255.f)), acc[ai][bj][m][1] * (s1 * (1.f / 255.f))); }
    }
};
struct EpiWo { static constexpr bool PERM = true, AFTER_DRAIN = false, IDEMPOTENT = true, MIDK = false; const float* X; bf16_t* H;
    __device__ __forceinline__ void operator()(const f32x4 (&acc)[2][2][4][2], const Unit& u, int wr, int wc, int fr, int fq) const {
        const int row0 = u.pm * BM + wr * 64 + fr, col0 = u.pn * BM + wc * 32 + 8 * fq;
#pragma unroll
        for (int ai = 0; ai < 2; ++ai)
#pragma unroll
            for (int m = 0; m < 4; ++m) { const size_t off = (size_t)(row0 + ai * HALF + m * 16) * D + col0;
#pragma unroll
                for (int bj = 0; bj < 2; ++bj) *(u32x4*)(H + off + bj * HALF) = pack8(*(const f32x4*)(X + off + bj * HALF) + acc[ai][bj][m][0], *(const f32x4*)(X + off + bj * HALF + 4) + acc[ai][bj][m][1]); }
    }
};
struct EpiGateUp { static constexpr bool PERM = true, AFTER_DRAIN = false, IDEMPOTENT = true, MIDK = true; static constexpr int MIDT = 2; const float* bias; unsigned char* ACT; PG8_LAS float* stg;
    __device__ __forceinline__ void mid(f32x4 (&acc)[2][2][4][2], const Unit& u, int wr, int wc, int fr, int fq) const {
        if (wr * 4 + wc == 0) { const char* src = (const char*)(bias + (size_t)u.e * (2 * FF) + 2 * u.pn * 128); unsigned off = (unsigned)(fq * 16 + fr) * 16u; asm volatile("" : "+s"(src), "+v"(off));
            __builtin_amdgcn_global_load_lds((const unsigned*)(src + off), (PG8_LAS unsigned*)stg, 16, 0, 0); }
    }
    __device__ __forceinline__ void operator()(const f32x4 (&acc)[2][2][4][2], const Unit& u, int wr, int wc, int fr, int fq) const {
        const int jb = u.pn * 128 + wc * 32 + 8 * fq; const PG8_LAS float* bp0 = stg + 2 * (wc * 32 + 8 * fq);
        const int row0 = u.pm * BM + wr * 64 + fr; constexpr float isc = 1.f / (S_U2 * S_W8);
        f32x4 bg[2], bl[2];
#pragma unroll
        for (int n = 0; n < 2; ++n) { const f32x4 b0 = *(const PG8_LAS f32x4*)(bp0 + 8 * n), b1 = *(const PG8_LAS f32x4*)(bp0 + 8 * n + 4); bg[n] = (f32x4){b0[0], b0[2], b1[0], b1[2]}; bl[n] = (f32x4){b0[1], b0[3], b1[1], b1[3]}; }
        unsigned char* const base = ACT + (size_t)(row0 + (fq & 1) * 16) * FF + jb - 8 * (fq & 1);
#pragma unroll
        for (int ai = 0; ai < 2; ++ai)
#pragma unroll
            for (int mp = 0; mp < 4; mp += 2) { u32x2 w[2];
#pragma unroll
                for (int mm = 0; mm < 2; ++mm) { const int m = mp + mm;
#pragma unroll
                    for (int n = 0; n < 2; ++n) { f32x4 o;
#pragma unroll
                        for (int i = 0; i < 4; ++i) { const float gate = fminf(acc[ai][0][m][n][i] * isc + bg[n][i], 7.f), lin = fminf(fmaxf(acc[ai][1][m][n][i] * isc + bl[n][i], -7.f), 7.f);
                            o[i] = (lin * gate + gate) * __builtin_amdgcn_rcpf(0.25f + 0.25f * __builtin_amdgcn_exp2f(-1.702f * 1.4426950408889634f * gate)); }
                        int q = 0; q = __builtin_amdgcn_cvt_pk_fp8_f32(o[0], o[1], q, false); q = __builtin_amdgcn_cvt_pk_fp8_f32(o[2], o[3], q, true); w[mm][n] = (unsigned)q; } }
                *(u32x4*)(base + (size_t)(ai * HALF + mp * 16) * FF) = widen16(w[0], w[1]); }
    }
};
struct EpiDown { static constexpr bool PERM = true, AFTER_DRAIN = false, IDEMPOTENT = true, MIDK = true; static constexpr int MIDT = 2; const float* bias; const int* list; unsigned char* Y; unsigned char* trash; PG8_LAS unsigned* stg;
    __device__ __forceinline__ void mid(f32x4 (&acc)[2][2][4][2], const Unit& u, int wr, int wc, int fr, int fq) const {
        const int w = wr * 4 + wc;
        const char* src = (const char*)(list + u.e * LIST_CAP + u.p0 + (w & 3) * 64) + (size_t)(w >> 2) * GLIST_DELTA; unsigned off = (unsigned)(fq * 16 + fr) * 4u; asm volatile("" : "+s"(src), "+v"(off));
        __builtin_amdgcn_global_load_lds((const unsigned*)(src + off), stg + w * 64, 4, 0, 0);
        if (w == 0) { const char* sb = (const char*)(bias + (size_t)u.e * D + u.pn * BM); unsigned ob = (unsigned)(fq * 16 + fr) * 16u; asm volatile("" : "+s"(sb), "+v"(ob));
            __builtin_amdgcn_global_load_lds((const unsigned*)(sb + ob), stg + 512, 16, 0, 0); }
    }
    __device__ __forceinline__ void operator()(const f32x4 (&acc)[2][2][4][2], const Unit& u, int wr, int wc, int fr, int fq) const {
        const int col0 = u.pn * BM + wc * 32 + 8 * fq; const PG8_LAS float* bp = (const PG8_LAS float*)(stg + 512) + wc * 32 + 8 * fq; constexpr float isc = 1.f / (S_ACT * S_W8);
        f32x4 bv[2][2];
#pragma unroll
        for (int bj = 0; bj < 2; ++bj)
#pragma unroll
            for (int n = 0; n < 2; ++n) bv[bj][n] = *(const PG8_LAS f32x4*)(bp + bj * HALF + 4 * n);
        int slot[8]; float gv[8];
#pragma unroll
        for (int q = 0; q < 8; ++q) { const int rl = (q >> 2) * HALF + wr * 64 + (q & 3) * 16 + fr; slot[q] = (int)stg[rl]; gv[q] = __uint_as_float(stg[256 + rl]) * S_Y; }
#pragma unroll
        for (int ai = 0; ai < 2; ++ai)
#pragma unroll
            for (int m = 0; m < 4; ++m) { const int q = ai * 4 + m, rl = ai * HALF + wr * 64 + m * 16 + fr; unsigned char* rowp = (rl < u.nv ? Y + (size_t)slot[q] * D : trash) + col0;
                u32x2 w[2];
#pragma unroll
                for (int bj = 0; bj < 2; ++bj) { const f32x4 v0 = (acc[ai][bj][m][0] * isc + bv[bj][0]) * gv[q], v1 = (acc[ai][bj][m][1] * isc + bv[bj][1]) * gv[q]; w[bj].x = pk4_fp8(v0[0], v0[1], v0[2], v0[3]); w[bj].y = pk4_fp8(v1[0], v1[1], v1[2], v1[3]); }
                *(u32x4*)(rowp + (fq & 1) * (HALF - 8)) = widen16(w[0], w[1]); }
    }
};
struct EpiPlain { static constexpr bool PERM = true, AFTER_DRAIN = false, IDEMPOTENT = true, MIDK = false; bf16_t* O;
    __device__ __forceinline__ void operator()(const f32x4 (&acc)[2][2][4][2], const Unit& u, int wr, int wc, int fr, int fq) const {
        const int row0 = u.pm * BM + wr * 64 + fr, col0 = u.pn * BM + wc * 32 + 8 * fq;
#pragma unroll
        for (int ai = 0; ai < 2; ++ai)
#pragma unroll
            for (int m = 0; m < 4; ++m)
#pragma unroll
                for (int bj = 0; bj < 2; ++bj) *(u32x4*)(O + (size_t)(row0 + ai * HALF + m * 16) * D + col0 + bj * HALF) = pack8(acc[ai][bj][m][0], acc[ai][bj][m][1]);
    }
};
struct EpiPleF { static constexpr bool PERM = true, AFTER_DRAIN = false, IDEMPOTENT = false, MIDK = true; static constexpr int MIDT = 2;     bf16_t* E1; bf16_t* H;
    __device__ __forceinline__ void mid(f32x4 (&acc)[2][2][4][2], const Unit& u, int wr, int wc, int fr, int fq) const {
        const int row0 = u.pm * BM + wr * 64 + fr, col0 = u.pn * BM + wc * 32 + 8 * fq;
#pragma unroll
        for (int ai = 0; ai < 2; ++ai)
#pragma unroll
            for (int m = 0; m < 4; ++m)
#pragma unroll
                for (int bj = 0; bj < 2; ++bj) { *(u32x4*)(E1 + (size_t)(row0 + ai * HALF + m * 16) * D + col0 + bj * HALF) = pack8(acc[ai][bj][m][0] * (1.f / (S_P * S_WPLE)), acc[ai][bj][m][1] * (1.f / (S_P * S_WPLE)));
                    acc[ai][bj][m][0] = (f32x4){0.f, 0.f, 0.f, 0.f}; acc[ai][bj][m][1] = (f32x4){0.f, 0.f, 0.f, 0.f}; }
        asm volatile("s_waitcnt vmcnt(0)" ::: "memory");
    }
    __device__ __forceinline__ void operator()(const f32x4 (&acc)[2][2][4][2], const Unit& u, int wr, int wc, int fr, int fq) const {
        const int row0 = u.pm * BM + wr * 64 + fr, col0 = u.pn * BM + wc * 32 + 8 * fq;
#pragma unroll
        for (int ai = 0; ai < 2; ++ai)
#pragma unroll
            for (int m = 0; m < 4; ++m)
#pragma unroll
                for (int bj = 0; bj < 2; ++bj) { const size_t o = (size_t)(row0 + ai * HALF + m * 16) * D + col0 + bj * HALF; f32x4 e0, e1, h0, h1; unpack8(*(const u32x4*)(E1 + o), e0, e1); unpack8(*(const u32x4*)(H + o), h0, h1);
                    const f32x4 a0 = acc[ai][bj][m][0] * (1.f / (S_U2 * S_W8)), a1 = acc[ai][bj][m][1] * (1.f / (S_U2 * S_W8));
#pragma unroll
                    for (int i = 0; i < 4; ++i) { h0[i] += e0[i] * fsig(a0[i]); h1[i] += e1[i] * fsig(a1[i]); }
                    *(u32x4*)(H + o) = pack8(h0, h1); }
    }
};

template <class Epi, class Sched, bool ALIGN_EPI, bool FP8 = false>
__device__ __forceinline__ void gemm_phase(PG8_LAS unsigned char* lds, int wave_s, const Gemm g, const Sched& S, const Epi& E, unsigned skew_ticks = 0u) {
    if (skew_ticks) { const unsigned xc = (unsigned)__builtin_amdgcn_s_getreg((3 << 11) | 20) & 0xFu, x = (skew_ticks >> 31) ? (xc & 1u) : xc;
        const unsigned long long t0 = __builtin_amdgcn_s_memrealtime(), dt = (unsigned long long)x * (skew_ticks & 0x7fffffffu);
        while (__builtin_amdgcn_s_memrealtime() - t0 < dt) __builtin_amdgcn_s_sleep(8); }
    const int wid = wave_s, lane = fresh_lane(), tid = wid * 64 + lane;
    const int wr = wid >> 2, wc = wid & 3, fr = lane & 15, fq = lane >> 4;
    const int K = g.K, nt = K / BK, lda = g.lda;
    unsigned voffA[2], voffB[2];
#pragma unroll
    for (int i = 0; i < 2; ++i) { int R, C; stage_rc(tid * 16 + i * 8192, R, C); const int Rb = Epi::PERM ? ((R & ~31) + perm32(R & 31)) : R;
        voffA[i] = (unsigned)(R * lda + C) * 2u; voffB[i] = (unsigned)(Rb * K + C) * 2u; }
    const size_t kstep = (size_t)(BK * 2);
    const size_t hstepA = (size_t)HALF * lda * 2, tstepA = 2 * hstepA, hstepB = (size_t)HALF * K * 2, tstepB = 2 * hstepB;
    const unsigned ldsw = (unsigned)wid * 1024u;
    const int aoff = lds_byte(wr * 64 + fr, fq * 8), boff = lds_byte(wc * 32 + fr, fq * 8);
#define PG8_SA(b, h) (((b) * 2 + (h)) * HTB)
#define PG8_SB(b, h) ((4 + (b) * 2 + (h)) * HTB)
#define PG8_DMA(bufoff, ptr, o0, o1) do { const char* _p = (const char*)(ptr); unsigned _q0 = (o0), _q1 = (o1); asm volatile("" : "+s"(_p), "+v"(_q0), "+v"(_q1));     \
        __builtin_amdgcn_global_load_lds((const unsigned*)(_p + _q0), (PG8_LAS unsigned*)(lds + (bufoff) + ldsw), 16, 0, 0); \
        __builtin_amdgcn_global_load_lds((const unsigned*)(_p + _q1), (PG8_LAS unsigned*)(lds + (bufoff) + ldsw + 8192), 16, 0, 0); } while (0)
#define PG8_STA(bufoff, h, koff, NX) do { if constexpr (Sched::GATHER) { \
        PG8_DMA(bufoff, (const char*)g.A + (koff), (h) ? cG1[0] : cG0[0], (h) ? cG1[1] : cG0[1]);     \
    } else { PG8_DMA(bufoff, ((NX) ? nA : cA) + (size_t)(h) * hstepA + (koff), voffA[0], voffA[1]); } } while (0)
#define PG8_STB(bufoff, h, koff, NX) PG8_DMA(bufoff, ((NX) ? nB : cB) + (size_t)(h) * hstepB + (koff), voffB[0], voffB[1])
#define PG8_LDA(dst, b, h) do { _Pragma("unroll") for (int m = 0; m < 4; ++m) _Pragma("unroll") for (int k = 0; k < 2; ++k) dst[m][k] = *(const PG8_LAS bf16x8*)(lds + PG8_SA(b, h) + aoff + m * 2048 + k * 1024); } while (0)
#define PG8_LDB(dst, b, h) do { _Pragma("unroll") for (int n = 0; n < 2; ++n) _Pragma("unroll") for (int k = 0; k < 2; ++k) dst[n][k] = *(const PG8_LAS bf16x8*)(lds + PG8_SB(b, h) + boff + n * 2048 + k * 1024); } while (0)
#define PG8_CAT(x) __builtin_shufflevector(__builtin_bit_cast(i32x4, x[0]), __builtin_bit_cast(i32x4, x[1]), 0, 1, 2, 3, 4, 5, 6, 7)
#define PG8_MMA(ai, bj, At, Bt) do { __builtin_amdgcn_s_setprio(1); _Pragma("unroll") for (int m = 0; m < 4; ++m) _Pragma("unroll") for (int n = 0; n < 2; ++n) { \
        if constexpr (FP8) acc[ai][bj][m][n] = __builtin_amdgcn_mfma_scale_f32_16x16x128_f8f6f4(PG8_CAT(Bt[n]), PG8_CAT(At[m]), acc[ai][bj][m][n], 0, 0, 0, 0x7f7f7f7f, 0, 0x7f7f7f7f); \
        else { _Pragma("unroll") for (int k = 0; k < 2; ++k) acc[ai][bj][m][n] = __builtin_amdgcn_mfma_f32_16x16x32_bf16(Bt[n][k], At[m][k], acc[ai][bj][m][n], 0, 0, 0); } } \
        __builtin_amdgcn_s_setprio(0); } while (0)
#define PG8_WAIT_V(n) asm volatile("s_waitcnt vmcnt(" #n ")" ::: "memory")
#define PG8_WAIT_L(n) asm volatile("s_waitcnt lgkmcnt(" #n ")" ::: "memory")
#define PG8_BAR __builtin_amdgcn_s_barrier()
#define PG8_SCHED __builtin_amdgcn_sched_barrier(0)
    Unit cur, nxt; int ui = 0;
    if (!S.next(0, cur)) return;
    f32x4 acc[2][2][4][2];
#pragma unroll
    for (int a = 0; a < 2; ++a)
#pragma unroll
        for (int b = 0; b < 2; ++b)
#pragma unroll
            for (int m = 0; m < 4; ++m)
#pragma unroll
                for (int n = 0; n < 2; ++n) acc[a][b][m][n] = (f32x4){0.f, 0.f, 0.f, 0.f};
    bf16x8 At[4][2], B0[2][2], B1[2][2];
    const char* cA = (const char*)g.A + (Sched::GATHER ? (size_t)0 : (size_t)cur.pm * tstepA);
    const char* cB = (const char*)g.Bt + (size_t)cur.e * g.b_estride * 2 + (size_t)cur.pn * tstepB;
    const char* nA = cA; const char* nB = cB;
    unsigned cG0[2] = {0u, 0u}, cG1[2] = {0u, 0u};
    const PG8_LAS int* const gidx = (const PG8_LAS int*)(lds + STAGE_BYTES + 512 + 1024);
    PG8_LAS u32x4* const park = (PG8_LAS u32x4*)(lds + STAGE_BYTES + 8192) + tid;
    if constexpr (Sched::GATHER) {
#pragma unroll
        for (int i = 0; i < 2; ++i) { int R, C; stage_rc((wid * 64 + fresh_lane()) * 16 + i * 8192, R, C); cG0[i] = (S.row_off(cur, R) + (unsigned)C) * 2u; cG1[i] = (S.row_off(cur, HALF + R) + (unsigned)C) * 2u; } }
    S.a_ready(cur);
    PG8_STB(PG8_SB(0, 0), 0, 0, false); PG8_STB(PG8_SB(0, 1), 1, 0, false); PG8_STA(PG8_SA(0, 0), 0, 0, false); PG8_STA(PG8_SA(0, 1), 1, 0, false);
    if (wr == 1) PG8_BAR;
    PG8_WAIT_V(2); PG8_BAR;
    PG8_STB(PG8_SB(1, 0), 0, kstep, false); PG8_STA(PG8_SA(1, 0), 0, kstep, false); PG8_STB(PG8_SB(1, 1), 1, kstep, false);
    PG8_WAIT_V(6); PG8_BAR;
    bool has_next = S.next(1, nxt);
    if constexpr (!Sched::GATHER) nA = has_next ? (const char*)g.A + (size_t)nxt.pm * tstepA : cA;
    nB = has_next ? (const char*)g.Bt + (size_t)nxt.e * g.b_estride * 2 + (size_t)nxt.pn * tstepB : cB;
    if constexpr (Sched::GATHER) {
        u32x4 pk; pk.x = cG0[0]; pk.y = cG0[1]; pk.z = cG1[0]; pk.w = cG1[1];
        if (has_next) {
            int R0, C0, R1, C1; stage_rc((wid * 64 + fresh_lane()) * 16, R0, C0); stage_rc((wid * 64 + fresh_lane()) * 16 + 8192, R1, C1);
            pk.x = (S.row_off(nxt, R0) + (unsigned)C0) * 2u; pk.y = (S.row_off(nxt, R1) + (unsigned)C1) * 2u; pk.z = (S.row_off(nxt, HALF + R0) + (unsigned)C0) * 2u; pk.w = (S.row_off(nxt, HALF + R1) + (unsigned)C1) * 2u; }
        *park = pk;
    }
    for (;;) {
#ifndef KREP
#define KREP 1
#endif
        for (int pass_ = 0; pass_ < KREP; ++pass_) {
        if (KREP > 1 && pass_ > 0) {
#pragma unroll
            for (int a = 0; a < 2; ++a)
#pragma unroll
                for (int b = 0; b < 2; ++b)
#pragma unroll
                    for (int m = 0; m < 4; ++m)
#pragma unroll
                        for (int n = 0; n < 2; ++n) acc[a][b][m][n] = (f32x4){0.f, 0.f, 0.f, 0.f}; }
#pragma unroll 1
        for (int t = 0; t < nt; t += 2) {
            const bool lastk = (t == nt - 2), last = lastk && (pass_ == KREP - 1);
            const size_t k1 = (size_t)(t + 1) * kstep, k2 = lastk ? (size_t)0 : (size_t)(t + 2) * kstep, k3 = k2 + kstep;
            if (last && has_next) S.a_ready(nxt);
            if constexpr (Sched::GATHER) { if (t == 2 && pass_ == KREP - 1 && has_next) { Unit n2;
                    if (S.next(ui + 2, n2) && wid < 4) { const char* src = (const char*)S.idx_src(n2) + wid * 256; unsigned off = (unsigned)fresh_lane() * 4u; asm volatile("" : "+s"(src), "+v"(off));
                        __builtin_amdgcn_global_load_lds((const unsigned*)(src + off), (PG8_LAS unsigned*)(lds + STAGE_BYTES + 512 + 1024) + wid * 64, 4, 0, 0); } } }
            if constexpr (Epi::MIDK) { if (t == Epi::MIDT && pass_ == KREP - 1) { const int el = fresh_lane(); E.mid(acc, cur, wr, wc, el & 15, el >> 4); } }
            PG8_LDB(B0, 0, 0); PG8_LDB(B1, 0, 1); PG8_SCHED; PG8_LDA(At, 0, 0); PG8_STA(PG8_SA(1, 1), 1, k1, false);
            if constexpr (Sched::GATHER) { if (last) { const u32x4 pk = *park; cG0[0] = pk.x; cG0[1] = pk.y; cG1[0] = pk.z; cG1[1] = pk.w; } }
            PG8_WAIT_V(8); PG8_WAIT_L(0); PG8_BAR; PG8_MMA(0, 0, At, B0); PG8_MMA(0, 1, At, B1); PG8_BAR; PG8_SCHED;
            PG8_LDA(At, 0, 1); PG8_STB(PG8_SB(0, 0), 0, k2, last); PG8_STB(PG8_SB(0, 1), 1, k2, last); PG8_STA(PG8_SA(0, 0), 0, k2, last);
            PG8_WAIT_V(8); PG8_WAIT_L(0); PG8_BAR; PG8_MMA(1, 0, At, B0); PG8_MMA(1, 1, At, B1); PG8_BAR; PG8_SCHED;
            PG8_LDB(B0, 1, 0); PG8_LDB(B1, 1, 1); PG8_SCHED; PG8_LDA(At, 1, 0); PG8_STA(PG8_SA(0, 1), 1, k2, last);
            PG8_WAIT_V(8); PG8_WAIT_L(0); PG8_BAR; PG8_MMA(0, 0, At, B0); PG8_MMA(0, 1, At, B1); PG8_BAR; PG8_SCHED;
            PG8_LDA(At, 1, 1); PG8_STB(PG8_SB(1, 0), 0, k3, last); PG8_STB(PG8_SB(1, 1), 1, k3, last); PG8_STA(PG8_SA(1, 0), 0, k3, last);
            PG8_WAIT_V(8); PG8_WAIT_L(0); PG8_BAR; PG8_MMA(1, 0, At, B0); PG8_MMA(1, 1, At, B1); PG8_BAR; PG8_SCHED;
        }
        }
        Unit nn; const bool has_nn = has_next && S.next(ui + 2, nn);
        u32x4 pkn = {0u, 0u, 0u, 0u};
        if constexpr (ALIGN_EPI) { if (wr == 0) PG8_BAR; }
#ifndef EREP
#define EREP 1
#endif
        { const int el = fresh_lane(); E(acc, cur, wr, wc, el & 15, el >> 4); }
        if constexpr (EREP > 1 && Epi::IDEMPOTENT) { asm volatile("s_waitcnt vmcnt(0)" ::: "memory"); const int el = fresh_lane(); E(acc, cur, wr, wc, el & 15, el >> 4); }
        S.done(cur);
        if (!has_next) break;
#pragma unroll
        for (int a = 0; a < 2; ++a)
#pragma unroll
            for (int b = 0; b < 2; ++b)
#pragma unroll
                for (int m = 0; m < 4; ++m)
#pragma unroll
                    for (int n = 0; n < 2; ++n) acc[a][b][m][n] = (f32x4){0.f, 0.f, 0.f, 0.f};
        cur = nxt; cA = nA; cB = nB; ++ui;
        nxt = nn; has_next = has_nn;
        if constexpr (!Sched::GATHER) nA = has_next ? (const char*)g.A + (size_t)nxt.pm * tstepA : cA;
        nB = has_next ? (const char*)g.Bt + (size_t)nxt.e * g.b_estride * 2 + (size_t)nxt.pn * tstepB : cB;
        if constexpr (Sched::GATHER) { int R0, C0, R1, C1; stage_rc((wid * 64 + fresh_lane()) * 16, R0, C0); stage_rc((wid * 64 + fresh_lane()) * 16 + 8192, R1, C1);
            const int nvm = (has_nn ? nn.nv : 1) - 1;
            const int q0 = R0 < nvm ? R0 : nvm, q1 = R1 < nvm ? R1 : nvm, q2 = HALF + R0 < nvm ? HALF + R0 : nvm, q3 = HALF + R1 < nvm ? HALF + R1 : nvm;
            pkn.x = (S.row_fin(gidx[q0]) + (unsigned)C0) * 2u; pkn.y = (S.row_fin(gidx[q1]) + (unsigned)C1) * 2u; pkn.z = (S.row_fin(gidx[q2]) + (unsigned)C0) * 2u; pkn.w = (S.row_fin(gidx[q3]) + (unsigned)C1) * 2u;
            if (!has_next) { pkn.x = cG0[0]; pkn.y = cG0[1]; pkn.z = cG1[0]; pkn.w = cG1[1]; } *park = pkn; }
        if constexpr (ALIGN_EPI) { if (wr == 1) PG8_BAR; }
    }
    PG8_WAIT_V(0);
    if constexpr (!ALIGN_EPI) { if (wr == 0) PG8_BAR; }
    PG8_BAR;
#undef PG8_SA
#undef PG8_SB
#undef PG8_DMA
#undef PG8_STA
#undef PG8_STB
#undef PG8_LDA
#undef PG8_LDB
#undef PG8_MMA
#undef PG8_CAT
#undef PG8_WAIT_V
#undef PG8_WAIT_L
#undef PG8_BAR
#undef PG8_SCHED
}
}
namespace attn_body {
using bf16=__hip_bfloat16;
using bf16x8=__attribute__((ext_vector_type(8)))short;
using s16x4=__attribute__((ext_vector_type(4)))short;
using f32x16=__attribute__((ext_vector_type(16)))float;
using u32x4=__attribute__((ext_vector_type(4)))unsigned;
constexpr int SEQ=2048,D=64,DM=512;
constexpr int NW=8,QBLK=32,QB=QBLK*NW,KVBLK=64,NQB=SEQ/QB;
constexpr int ATTN_PITCH=DM, ATTN_UNIT_ROWS=QB;
__device__ __forceinline__ int crow(int r,int hi){return (r&3)+8*(r>>2)+4*hi;}
#define SBAR() __builtin_amdgcn_sched_barrier(0)
__device__ __forceinline__ void cmask(f32x16&p0,f32x16&p1,int jb,int qrel,int hi){
  const float NEG=-INFINITY; int kb=64*jb+4*hi;
  #pragma unroll
  for(int r=0;r<16;++r){int kv=kb+(r&3)+8*(r>>2); if(kv>qrel)p0[r]=NEG; if(kv+32>qrel)p1[r]=NEG;}
}

constexpr int NSLOT=3, SLOTB=8192;
constexpr int LDS_K=0, LDS_V=NSLOT*SLOTB, LDS_WS=2*NSLOT*SLOTB, LDS_OST=LDS_WS+NW*64*4, LDS_BYTES=LDS_OST+NW*4096;
constexpr float C2=0.125f*1.4426950408889634f;
__device__ __forceinline__ void glds16(const void*gsrc,unsigned lds_dst){unsigned keep;
  asm volatile("s_mov_b32 %0, m0\n\ts_mov_b32 m0, %2\n\ts_nop 0\n\tglobal_load_lds_dwordx4 %1, off\n\ts_mov_b32 m0, %0":"=&s"(keep):"v"(gsrc),"s"(lds_dst):"memory");}
__device__ __forceinline__ float max3f(float a,float b,float c){float r;asm("v_max3_f32 %0, %1, %2, %3":"=v"(r):"v"(a),"v"(b),"v"(c));return r;}
__device__ __forceinline__ float max2f(float a,float b){float r;asm("v_max_f32_e32 %0, %1, %2":"=v"(r):"v"(a),"v"(b));return r;}
__device__ __forceinline__ float fadd_s(float a,float b){float r;asm("v_add_f32_e32 %0, %1, %2":"=v"(r):"v"(a),"v"(b));return r;}
__device__ __forceinline__ float fsub_s(float a,float b){float r;asm("v_sub_f32_e32 %0, %1, %2":"=v"(r):"v"(a),"v"(b));return r;}
typedef float f32x2_t __attribute__((ext_vector_type(2))); typedef __bf16 bf16x2_t __attribute__((ext_vector_type(2)));
__device__ __forceinline__ unsigned cvtpk_s(float lo,float hi){f32x2_t v={lo,hi};bf16x2_t b=__builtin_convertvector(v,bf16x2_t);return __builtin_bit_cast(unsigned,b);}
#define WAIT_BAR(N) asm volatile("s_waitcnt vmcnt(" #N ") lgkmcnt(0)\n\ts_barrier":::"memory")

__device__ __forceinline__ void qkt(f32x16&p0,f32x16&p1,const char*Kslot,const bf16x8*qr,const f32x16&negm,int r32,int hi){
  const char*kb=Kslot+hi*1024+r32*16;
  #pragma unroll
  for(int d0=0;d0<4;++d0){
    const bf16x8 b0=*reinterpret_cast<const bf16x8*>(kb+d0*2048);
    const bf16x8 b1=*reinterpret_cast<const bf16x8*>(kb+d0*2048+512);
    if(d0==0){p0=__builtin_amdgcn_mfma_f32_32x32x16_bf16(b0,qr[0],negm,0,0,0);p1=__builtin_amdgcn_mfma_f32_32x32x16_bf16(b1,qr[0],negm,0,0,0);}
    else{p0=__builtin_amdgcn_mfma_f32_32x32x16_bf16(b0,qr[d0],p0,0,0,0);p1=__builtin_amdgcn_mfma_f32_32x32x16_bf16(b1,qr[d0],p1,0,0,0);}}
}
typedef __attribute__((address_space(3))) const char* lds_cptr;
typedef short v4i16_t __attribute__((ext_vector_type(4)));
__device__ __forceinline__ void kload8(bf16x8*kf,lds_cptr kp){
  kf[0]=*(const __attribute__((address_space(3))) bf16x8*)(kp);      kf[1]=*(const __attribute__((address_space(3))) bf16x8*)(kp+512);
  kf[2]=*(const __attribute__((address_space(3))) bf16x8*)(kp+2048); kf[3]=*(const __attribute__((address_space(3))) bf16x8*)(kp+2560);
  kf[4]=*(const __attribute__((address_space(3))) bf16x8*)(kp+4096); kf[5]=*(const __attribute__((address_space(3))) bf16x8*)(kp+4608);
  kf[6]=*(const __attribute__((address_space(3))) bf16x8*)(kp+6144); kf[7]=*(const __attribute__((address_space(3))) bf16x8*)(kp+6656);
}
__device__ __forceinline__ void kload2(bf16x8*kf,lds_cptr kp,int j){ kf[2*j]=*(const __attribute__((address_space(3))) bf16x8*)(kp+j*2048); kf[2*j+1]=*(const __attribute__((address_space(3))) bf16x8*)(kp+j*2048+512); }
__device__ __forceinline__ s16x4 vtr(lds_cptr p){ return __builtin_bit_cast(s16x4,__builtin_amdgcn_ds_read_tr16_b64_v4i16((__attribute__((address_space(3))) v4i16_t*)p)); }
__device__ __forceinline__ float rowmax(const f32x16&p0,const f32x16&p1){
  float a=max3f(p0[0],p0[1],p1[0]),b=max3f(p0[2],p0[3],p1[1]);a=max3f(a,p1[2],p1[3]);
  #pragma unroll
  for(int r=4;r<16;r+=4){a=max3f(a,p0[r],p0[r+1]);b=max3f(b,p0[r+2],p0[r+3]);a=max3f(a,p1[r],p1[r+1]);b=max3f(b,p1[r+2],p1[r+3]);}
  const float m=max2f(a,b);
  auto rr=__builtin_amdgcn_permlane32_swap(__float_as_uint(m),__float_as_uint(m),false,false);
  return max2f(__uint_as_float(rr[0]),__uint_as_float(rr[1]));
}
__device__ __forceinline__ void pv(f32x16*o,int vb,bf16x8 pa0,bf16x8 pa1,bf16x8 pa2,bf16x8 pa3){
  #pragma unroll
  for(int d0=0;d0<2;++d0){s16x4 lo[4],hi[4];
    #pragma unroll
    for(int ks=0;ks<4;++ks){
      asm volatile("ds_read_b64_tr_b16 %0,%1 offset:%c2":"=&v"(lo[ks]):"v"(vb),"i"(d0*4096+ks*1024):"memory");
      asm volatile("ds_read_b64_tr_b16 %0,%1 offset:%c2":"=&v"(hi[ks]):"v"(vb),"i"(d0*4096+ks*1024+512):"memory");}
    asm volatile("s_waitcnt lgkmcnt(0)":::"memory");SBAR();
    #define PK(k) (bf16x8){lo[k][0],lo[k][1],lo[k][2],lo[k][3],hi[k][0],hi[k][1],hi[k][2],hi[k][3]}
    o[d0]=__builtin_amdgcn_mfma_f32_32x32x16_bf16(pa0,PK(0),o[d0],0,0,0);
    o[d0]=__builtin_amdgcn_mfma_f32_32x32x16_bf16(pa1,PK(1),o[d0],0,0,0);
    o[d0]=__builtin_amdgcn_mfma_f32_32x32x16_bf16(pa2,PK(2),o[d0],0,0,0);
    o[d0]=__builtin_amdgcn_mfma_f32_32x32x16_bf16(pa3,PK(3),o[d0],0,0,0);
    #undef PK
  }
}

#ifndef ATTN_STORE16
#define ATTN_STORE16(p,v) (*(u32x4*)(p)=(v))
#endif
template<int THRL> __device__ __forceinline__ void attn_unit(bool pre,bool has_nx,int nb,int nqkc,int nqb,bf16x8(&qr)[4],int wid_s,int b,int qkc,int voc,int qb,const bf16*Q,const bf16*__restrict__ K,const bf16*__restrict__ V,bf16*O,char*shm){
  const int wid=wid_s,lane=fresh_lane(),tid=wid*64+lane,r32=lane&31,hi=lane>>5;
  const long rowbase=(long)b*SEQ; const int q0=qb*QB;
  const bf16*Qw=Q+(rowbase+q0+wid*QBLK)*DM+qkc;
  const bf16*Kh=K+rowbase*DM+qkc,*Vh=V+rowbase*DM+voc;
  const unsigned lds0=(unsigned)(uintptr_t)shm;
  float*wsf=(float*)(shm+LDS_WS)+wid*64;
  const bf16*ksrc=Kh+(long)lane*DM+wid*8;
  const bf16*vsrc=Vh+(long)(16*(wid&3)+(lane>>2))*DM+(wid>>2)*32+(lane&3)*8;
  const unsigned kdst=lds0+LDS_K+wid*1024, vdst=lds0+LDS_V+wid*1024;
  #define DMA_K(t,slot) glds16(ksrc+(long)(t)*KVBLK*DM,(unsigned)__builtin_amdgcn_readfirstlane(kdst+(slot)))
  #define DMA_V(t,slot) glds16(vsrc+(long)(t)*KVBLK*DM,(unsigned)__builtin_amdgcn_readfirstlane(vdst+(slot)))
  const int vb0=(int)(lds0+LDS_V)+((lane>>4)&1)*32+(lane&3)*8+(4*hi+((lane&15)>>2))*64;
  const char*Kbase=shm+LDS_K; bf16x8 kf[8];
  const lds_cptr shm3=(lds_cptr)shm; const lds_cptr kp0=shm3+LDS_K+hi*1024+r32*16; const lds_cptr vp0=shm3+LDS_V+((lane>>4)&1)*32+(lane&3)*8+(4*hi+((lane&15)>>2))*64;
  const int NT=(q0+QB)/KVBLK;
  if(!pre){DMA_K(0,0);} DMA_V(0,0); if(!pre){DMA_K(1,SLOTB);}
  #pragma unroll
  for(int d0=0;d0<4;++d0){ if(!pre)qr[d0]=*reinterpret_cast<const bf16x8*>(&Qw[(long)r32*DM+d0*16+hi*8]); }
  float mhat=0.f,l_reg=0.f;f32x16 o[2];o[0]=f32x16{};o[1]=f32x16{};f32x16 negm=f32x16{};asm volatile("":"+v"(negm));
  const int qrel=wid*QBLK+r32;
  #define CMASK(P0,P1,t) do{int jb_=(t)-(NT-4); if(jb_>=0)cmask(P0,P1,jb_,qrel,hi);}while(0)
  bool resc=false;
  #define START(P0,P1) do{ const float rm=rowmax(P0,P1); resc=false; \
    { const float dl=rm; mhat=fadd_s(mhat,dl); \
      _Pragma("unroll") for(int r=0;r<16;++r){P0[r]=fsub_s(P0[r],dl);P1[r]=fsub_s(P1[r],dl);} \
      _Pragma("unroll") for(int r=0;r<16;++r)negm[r]=-mhat; asm volatile("":"+v"(negm)); } \
    _Pragma("unroll") for(int r=0;r<16;++r)P0[r]=__builtin_amdgcn_exp2f(P0[r]); }while(0)
  #define RESC() do{ if(resc){ asm volatile("s_waitcnt lgkmcnt(0)":::"memory"); \
      _Pragma("unroll") for(int d_=0;d_<2;++d_) _Pragma("unroll") for(int r=0;r<16;++r)o[d_][r]*=wsf[crow(r,hi)]; } }while(0)
  f32x16 pA0,pA1,pB0,pB1;
  int sl_prev=0,sl_cur=0,sl_next=SLOTB;
  #define ROT() do{sl_prev=sl_cur;sl_cur=sl_next;sl_next=(sl_next==(NSLOT-1)*SLOTB)?0:sl_next+SLOTB;}while(0)
  if(!pre){ DMA_K(2,2*SLOTB); WAIT_BAR(3); } else { WAIT_BAR(1); }
  qkt(pA0,pA1,Kbase,qr,negm,r32,hi);asm volatile("s_nop 15\n\ts_nop 7":"+v"(pA0),"+v"(pA1));CMASK(pA0,pA1,0);
  START(pA0,pA1);
  _Pragma("unroll") for(int r=0;r<16;++r)pA1[r]=__builtin_amdgcn_exp2f(pA1[r]);
  WAIT_BAR(0);
  DMA_K(3,0);DMA_V(1,SLOTB);
  ROT();
  kload8(kf,kp0+sl_cur);
  WAIT_BAR(2);
  s16x4 vlo[8],vhi[8]; u32x4 pw0,pw1,pw2,pw3;
  #define PKW(P,B) cvtpk_s(P[B],P[B+1])
  #define PAF(k) __builtin_bit_cast(bf16x8,pw##k)
  #define VFR(i) (bf16x8){vlo[i][0],vlo[i][1],vlo[i][2],vlo[i][3],vhi[i][0],vhi[i][1],vhi[i][2],vhi[i][3]}
  #define PIN(x) asm volatile("":"+v"(x))
  #define MX3(a,b,c) __builtin_fmaxf(__builtin_fmaxf((a),(b)),(c))
  #define GAPA(MF,A0,A1,A2,A3,W0,W1,PW) do{ MF; sacc+=A0; sacc+=A1; sacc+=A2; sacc+=A3; PIN(sacc); W0; W1; PIN(PW); SBAR(); }while(0)
  #define EX(v) __builtin_amdgcn_exp2f(v)
  #define GAPB(MF,X,B) do{ MF; X[B]=EX(X[B]); X[B+1]=EX(X[B+1]); X[B+2]=EX(X[B+2]); X[B+3]=EX(X[B+3]); PIN(X); SBAR(); }while(0)
  #define VRD(i) do{ vlo[i]=vtr(vp_+(((i)>>2)*4096+((i)&3)*1024)); vhi[i]=vtr(vp_+(((i)>>2)*4096+((i)&3)*1024+512)); }while(0)
  #define KRD(G,j) do{ if(G){ kload2(kf,kp0+sl_next,j); SBAR(); } }while(0)
  #define STEP(C0,C1,P0,P1,t,GK,GV,GL) do{ SBAR(); \
    const lds_cptr vp_=vp0+sl_prev; \
    VRD(0); SBAR(); float sacc=(P0[0]+P0[1]); \
    GAPA(C0=__builtin_amdgcn_mfma_f32_32x32x16_bf16(kf[0],qr[0],negm,0,0,0), P0[2],P0[3],P0[4],P0[5],     pw0[0]=PKW(P0,0), pw0[1]=PKW(P0,2), pw0); \
    VRD(4); SBAR(); GAPA(C1=__builtin_amdgcn_mfma_f32_32x32x16_bf16(kf[1],qr[0],negm,0,0,0), P0[6],P0[7],P0[8],P0[9],     pw0[2]=PKW(P0,4), pw0[3]=PKW(P0,6), pw0); \
    VRD(1); SBAR(); GAPA(C0=__builtin_amdgcn_mfma_f32_32x32x16_bf16(kf[2],qr[1],C0,0,0,0),   P0[10],P0[11],P0[12],P0[13], pw1[0]=PKW(P0,8), pw1[1]=PKW(P0,10), pw1); \
    VRD(5); SBAR(); GAPA(C1=__builtin_amdgcn_mfma_f32_32x32x16_bf16(kf[3],qr[1],C1,0,0,0),   P0[14],P0[15],P1[0],P1[1],   pw1[2]=PKW(P0,12),pw1[3]=PKW(P0,14), pw1); \
    VRD(2); SBAR(); GAPA(C0=__builtin_amdgcn_mfma_f32_32x32x16_bf16(kf[4],qr[2],C0,0,0,0),   P1[2],P1[3],P1[4],P1[5],     pw2[0]=PKW(P1,0), pw2[1]=PKW(P1,2), pw2); \
    VRD(6); SBAR(); GAPA(C1=__builtin_amdgcn_mfma_f32_32x32x16_bf16(kf[5],qr[2],C1,0,0,0),   P1[6],P1[7],P1[8],P1[9],     pw2[2]=PKW(P1,4), pw2[3]=PKW(P1,6), pw2); \
    VRD(3); SBAR(); GAPA(C0=__builtin_amdgcn_mfma_f32_32x32x16_bf16(kf[6],qr[3],C0,0,0,0),   P1[10],P1[11],P1[12],P1[13], pw3[0]=PKW(P1,8), pw3[1]=PKW(P1,10), pw3); \
    VRD(7); SBAR(); GAPA(C1=__builtin_amdgcn_mfma_f32_32x32x16_bf16(kf[7],qr[3],C1,0,0,0),   P1[14],P1[15],0.f,0.f,       pw3[2]=PKW(P1,12),pw3[3]=PKW(P1,14), pw3); \
    l_reg+=sacc; \
    if(GK){DMA_K((t)+3,sl_cur);} if(GV){DMA_V((t)+1,sl_next);} \
    CMASK(C0,C1,t); \
    { float a=MX3(C0[0],C0[1],C1[0]),b=MX3(C0[2],C0[3],C1[1]); a=MX3(a,C1[2],C1[3]); \
      _Pragma("unroll") for(int r=4;r<16;r+=4){a=MX3(a,C0[r],C0[r+1]);b=MX3(b,C0[r+2],C0[r+3]);a=MX3(a,C1[r],C1[r+1]);b=MX3(b,C1[r+2],C1[r+3]);} \
      float rm=__builtin_fmaxf(a,b); { auto rr=__builtin_amdgcn_permlane32_swap(__float_as_uint(rm),__float_as_uint(rm),false,false); rm=__builtin_fmaxf(__uint_as_float(rr[0]),__uint_as_float(rr[1])); } \
      resc=false; \
      if(__builtin_expect(__any(rm>(float)THRL),0)){ const float dl=__builtin_fmaxf(rm,0.f); mhat+=dl; \
        _Pragma("unroll") for(int r=0;r<16;++r){C0[r]-=dl;C1[r]-=dl;} \
        _Pragma("unroll") for(int r=0;r<16;++r)negm[r]=-mhat; asm volatile("":"+v"(negm)); \
        const float f=__builtin_amdgcn_exp2f(-dl); l_reg*=f; if(hi==0)wsf[r32]=f; resc=true; } } \
    SBAR(); \
    GAPB(o[0]=__builtin_amdgcn_mfma_f32_32x32x16_bf16(PAF(0),VFR(0),o[0],0,0,0), C0,0); \
    GAPB(o[1]=__builtin_amdgcn_mfma_f32_32x32x16_bf16(PAF(0),VFR(4),o[1],0,0,0), C0,4); \
    KRD(GL,0); GAPB(o[0]=__builtin_amdgcn_mfma_f32_32x32x16_bf16(PAF(1),VFR(1),o[0],0,0,0), C0,8); \
    KRD(GL,1); GAPB(o[1]=__builtin_amdgcn_mfma_f32_32x32x16_bf16(PAF(1),VFR(5),o[1],0,0,0), C0,12); \
    KRD(GL,2); GAPB(o[0]=__builtin_amdgcn_mfma_f32_32x32x16_bf16(PAF(2),VFR(2),o[0],0,0,0), C1,0); \
    KRD(GL,3); GAPB(o[1]=__builtin_amdgcn_mfma_f32_32x32x16_bf16(PAF(2),VFR(6),o[1],0,0,0), C1,4); \
    GAPB(o[0]=__builtin_amdgcn_mfma_f32_32x32x16_bf16(PAF(3),VFR(3),o[0],0,0,0), C1,8); \
    GAPB(o[1]=__builtin_amdgcn_mfma_f32_32x32x16_bf16(PAF(3),VFR(7),o[1],0,0,0), C1,12); \
    }while(0)
  int t=1;
  #undef CMASK
  #define CMASK(P0,P1,t) do{}while(0)
  for(;t+5<NT;t+=2){
    STEP(pB0,pB1,pA0,pA1,t,true,true,true);     WAIT_BAR(2); RESC(); ROT();
    STEP(pA0,pA1,pB0,pB1,t+1,true,true,true);   WAIT_BAR(2); RESC(); ROT();
  }
  #undef CMASK
  #define CMASK(P0,P1,t) do{int jb_=(t)-(NT-4); if(jb_>=0)cmask(P0,P1,jb_,qrel,hi);}while(0)
  #define ENDW(tt) do{ if((tt)+3<NT){WAIT_BAR(2);} else if((tt)+2<NT){WAIT_BAR(1);} else {WAIT_BAR(0);} }while(0)
  for(;t+1<NT;t+=2){
    STEP(pB0,pB1,pA0,pA1,t,(t+3<NT),(t+1<NT),(t+1<NT));       ENDW(t);   RESC(); ROT();
    STEP(pA0,pA1,pB0,pB1,t+1,(t+4<NT),(t+2<NT),(t+2<NT));     ENDW(t+1); RESC(); ROT();
  }
  STEP(pB0,pB1,pA0,pA1,NT-1,false,false,false); RESC();
  if(has_nx){ const bf16*kn=ksrc+((long)(nb-b)*SEQ*DM+(nqkc-qkc));
    glds16(kn,(unsigned)__builtin_amdgcn_readfirstlane(kdst)); glds16(kn+(long)KVBLK*DM,(unsigned)__builtin_amdgcn_readfirstlane(kdst+SLOTB)); glds16(kn+(long)2*KVBLK*DM,(unsigned)__builtin_amdgcn_readfirstlane(kdst+2*SLOTB));
    const bf16*Qn=Q+((long)nb*SEQ+nqb*QB+wid*QBLK)*DM+nqkc; const int ln_=fresh_lane(); const unsigned qo_=(unsigned)((ln_&31)*DM+(ln_>>5)*8);
    #pragma unroll
    for(int d0=0;d0<4;++d0)qr[d0]=*reinterpret_cast<const bf16x8*>(&Qn[qo_+d0*16]); }
  { float sacc=pB0[0]+pB0[1]; _Pragma("unroll") for(int r=2;r<16;++r)sacc+=pB0[r]; _Pragma("unroll") for(int r=0;r<16;++r)sacc+=pB1[r]; l_reg+=sacc;
    pw0=(u32x4){PKW(pB0,0),PKW(pB0,2),PKW(pB0,4),PKW(pB0,6)};pw1=(u32x4){PKW(pB0,8),PKW(pB0,10),PKW(pB0,12),PKW(pB0,14)};pw2=(u32x4){PKW(pB1,0),PKW(pB1,2),PKW(pB1,4),PKW(pB1,6)};pw3=(u32x4){PKW(pB1,8),PKW(pB1,10),PKW(pB1,12),PKW(pB1,14)};
    SBAR(); pv(o,vb0+sl_cur,PAF(0),PAF(1),PAF(2),PAF(3)); }
  #undef PKW
  #undef PAF
  #undef VFR
  #undef PIN
  #undef MX3
  #undef GAPA
  #undef GAPB
  #undef EX
  #undef VRD
  #undef KRD
  #undef STEP
  #undef ENDW
  {auto rr=__builtin_amdgcn_permlane32_swap(__float_as_uint(l_reg),__float_as_uint(l_reg),false,false);l_reg=__uint_as_float(rr[0])+__uint_as_float(rr[1]);}
  if(hi==0)wsf[32+r32]=l_reg;asm volatile("s_waitcnt lgkmcnt(0)":::"memory");
  float rli[16];
  #pragma unroll
  for(int r=0;r<16;++r)rli[r]=__builtin_amdgcn_rcpf(wsf[32+crow(r,hi)]);
  bf16*Ow=O+(rowbase+q0+wid*QBLK)*DM+voc;
  { bf16*stg=(bf16*)(shm+LDS_OST)+wid*2048;
    #pragma unroll
    for(int r=0;r<16;++r){const int orow=crow(r,hi);
      #pragma unroll
      for(int d0=0;d0<2;++d0)stg[orow*64+d0*32+r32]=__float2bfloat16(o[d0][r]*rli[r]);}
    asm volatile("s_waitcnt lgkmcnt(0)":::"memory");
    #pragma unroll
    for(int i=0;i<4;++i){const int row=i*8+(lane>>3),ch=lane&7; const u32x4 v=*(const u32x4*)(stg+row*64+ch*8); ATTN_STORE16(Ow+(long)row*DM+ch*8,v);} }
  asm volatile("s_waitcnt lgkmcnt(0)\n\ts_barrier":::"memory");
  #undef DMA_K
  #undef DMA_V
  #undef CMASK
  #undef START
  #undef RESC
  #undef ROT
}
constexpr int ATTN_LDS_BYTES=LDS_BYTES;
struct AttnPtrs { const bf16* Q; const bf16* K; const bf16* V; bf16* O1; bf16* O2; };
template<int THRL> __device__ __forceinline__ void attn_phase(char*lds,const AttnPtrs&T,int G,int vcu,int wid_s){
  #define ATTN_UNIT_OF(i,combo,qb,ok) do{ if(G==256){ ok=(i)<8; const int j=vcu&31; combo=(vcu&~31)+(j>>3)*8+(i); qb=((j&7)+(i))&7; } else { const int U=(i)*G+vcu; ok=U<2048; combo=U>>3; qb=7-(U&7); } }while(0)
  bf16x8 qr[4]={}; bool pre=false;
  for(int i=0;;++i){
    int combo,qb,ncombo,nqb; bool ok,nok; ATTN_UNIT_OF(i,combo,qb,ok); if(!ok)break; ATTN_UNIT_OF(i+1,ncombo,nqb,nok);
    const int vh=combo&1, c=(combo>>1)&1, h=(combo>>2)&3, b=combo>>4, nc=(ncombo>>1)&1, nh=(ncombo>>2)&3, nb=ncombo>>4;
    attn_unit<THRL>(pre,nok,nb,(2*nh+nc)*64,nqb,qr,wid_s,b,(2*h+c)*64,h*128+vh*64,qb,T.Q,T.K,T.V,c?T.O2:T.O1,lds);
    pre=nok;
  }
  #undef ATTN_UNIT_OF
}
#undef SBAR
#undef WAIT_BAR
}

#define GAS __attribute__((address_space(1)))
#define LAS __attribute__((address_space(3)))
typedef unsigned v4u __attribute__((ext_vector_type(4)));
typedef GAS unsigned gu32;
typedef GAS unsigned long long gu64;
#define RLX_AGENT __ATOMIC_RELAXED, __HIP_MEMORY_SCOPE_AGENT
#define LDS_WAIT() asm volatile("s_waitcnt lgkmcnt(0)" ::: "memory")
#define VM_WAIT() asm volatile("s_waitcnt vmcnt(0)" ::: "memory")
__device__ __forceinline__ unsigned long long rt() { return __builtin_amdgcn_s_memrealtime(); }

#define XB_TMO      128
#define XB_XCNT(j)  (256  + 64 * (j))
#define XB_XSUB(j)  (1280 + 64 * (j))
#define XB_XGEN(j)  (2304 + 64 * (j))
#define XB_TOP      3328
#define XB_TOPGEN   3392
#define XCD_BAR_WORDS 3456
#define XB_SPIN_CAP (1u << 18)

__device__ __forceinline__ unsigned xb_ld(unsigned* p)              { return __hip_atomic_load(p, __ATOMIC_RELAXED, __HIP_MEMORY_SCOPE_AGENT); }
__device__ __forceinline__ unsigned xb_add(unsigned* p, unsigned v) { return __hip_atomic_fetch_add(p, v, __ATOMIC_RELAXED, __HIP_MEMORY_SCOPE_AGENT); }
__device__ __forceinline__ unsigned xb_xcc_id() { return (unsigned)__builtin_amdgcn_s_getreg((3 << 11) | 20) & 0xFu; }
#define XB_SPIN(cond, bar) do { unsigned _sp = 0; while (cond) { __builtin_amdgcn_s_sleep(1); \
    if ((++_sp & 255u) == 0u) { if (xb_ld(&(bar)[XB_TMO])) break; if (_sp > XB_SPIN_CAP) { atomicAdd(&(bar)[XB_TMO], 1u); break; } } } } while (0)

struct XcdBarrier {
    int w;
    unsigned* bar; unsigned x;
    volatile LAS unsigned* st;
};

__device__ __forceinline__ XcdBarrier xcd_barrier_post(unsigned* bar, volatile LAS unsigned* st, int wave_s) {
    XcdBarrier b; b.w = wave_s; b.bar = bar; b.x = xb_xcc_id(); b.st = st;
    if (wave_s == 0 && fresh_lane() == 0) (void)xb_add(&bar[XB_XCNT(b.x)], 1u);
    return b;
}
__device__ __forceinline__ void xcd_barrier_complete(unsigned* bar, unsigned x, unsigned& nloc, unsigned& nx) {
    const unsigned G = gridDim.x * gridDim.y * gridDim.z;
    unsigned sum, cnt, mine, sp = 0u;
    for (;;) {
        sum = 0u; cnt = 0u; mine = 0u;
#pragma unroll
        for (unsigned j = 0; j < 16; ++j) { const unsigned c = xb_ld(&bar[XB_XCNT(j)]); sum += c; cnt += (c > 0u) ? 1u : 0u; mine = (j == x) ? c : mine; }
        if (sum == G) break;
        __builtin_amdgcn_s_sleep(1);
        if ((++sp & 255u) == 0u) { if (xb_ld(&bar[XB_TMO])) break; if (sp > XB_SPIN_CAP) { atomicAdd(&bar[XB_TMO], 1u); break; } }
    }
    nloc = mine > 0u ? mine : 1u; nx = cnt > 0u ? cnt : 1u;
}

__device__ __forceinline__ void xcd_barrier(const XcdBarrier& b) {
    asm volatile("s_waitcnt vmcnt(0)" ::: "memory");
    __syncthreads();
    if (b.w == 0 && fresh_lane() == 0) {
        unsigned* bar = b.bar;
        __builtin_amdgcn_s_waitcnt(0);
        unsigned nloc = b.st[0], nx = b.st[1];
        if (nloc == 0u) { xcd_barrier_complete(bar, b.x, nloc, nx); b.st[0] = nloc; b.st[1] = nx; }
        const unsigned old = xb_add(&bar[XB_XSUB(b.x)], 1u);
        const unsigned gen = old / nloc;
        if (old + 1u == (gen + 1u) * nloc) {
            __builtin_amdgcn_fence(__ATOMIC_RELEASE, "agent");
            asm volatile("s_waitcnt vmcnt(0)" ::: "memory");
            const unsigned og = xb_add(&bar[XB_TOP], 1u);
            const unsigned tg = og / nx;
            if (og + 1u == (tg + 1u) * nx) xb_add(&bar[XB_TOPGEN], 1u);
            else XB_SPIN(xb_ld(&bar[XB_TOPGEN]) == tg, bar);
            __builtin_amdgcn_fence(__ATOMIC_ACQUIRE, "agent");
            xb_add(&bar[XB_XGEN(b.x)], 1u);
            asm volatile("s_waitcnt vmcnt(0)" ::: "memory");
        } else {
            XB_SPIN(xb_ld(&bar[XB_XGEN(b.x)]) == gen, bar);
            __builtin_amdgcn_fence(__ATOMIC_ACQUIRE, "agent");
            asm volatile("s_waitcnt vmcnt(0)" ::: "memory");
        }
    }
    __syncthreads();
}

constexpr int NWAVES = 8;
constexpr int RING_OFF = 0, RING_BYTES = 131072;
constexpr int LDSCTL_OFF = RING_BYTES, MISC_OFF = LDSCTL_OFF + 320;
constexpr int RCTL_OFF = LDSCTL_OFF + 512;
constexpr int MOE_OFF = LDSCTL_OFF + 5120;
constexpr int CONV_OFF = LDSCTL_OFF + 6144;
constexpr int LDS_BYTES = 147456;
constexpr int CW_TMO = 0, CW_CODE = 1, CW_BAR = 4096;
constexpr int NPHASE = 12;
constexpr unsigned SKEW_P1 = 0u, SKEW_P7 = 0u, SKEW_P8 = 0u, SKEW_P4 = 0u, SKEW_P5 = 0u, SKEW_P10 = 0u;

struct Frame {
    LAS unsigned char* lds; volatile LAS unsigned* MISC; gu32* ctl;
    int wave, vcu, G;
};

template <int MODE> __device__ __forceinline__ int dst_row(int n) {
    if (MODE == 1) {
        if (n < 1536 || n >= 2560) return n;
        const int j = n - 1536; return j < 512 ? (6 + (j >> 7)) * 256 + (j & 127) : (6 + ((j - 512) >> 7)) * 256 + 128 + ((j - 512) & 127);
    } else if (MODE == 2) {
        const int j = n >> 1; return (j >> 7) * 256 + (n & 1) * 128 + (j & 127);
    }
    return n;
}
template <int MODE> __device__ __forceinline__ void p0_transpose_item(const float* __restrict__ W, int K, int N, bf16_t* __restrict__ WT, LAS float* scr, int item, int lane, int ldk = 0, int koff = 0) {
    if (ldk == 0) ldk = K;
    const int nblk = N / 32, kb = item / nblk, nb = item % nblk, k0 = 64 * kb, n0 = 32 * nb;
#pragma unroll 8
    for (int i = 0; i < 32; ++i) { const int kk = 2 * i + (lane >> 5); scr[kk * 33 + (lane & 31)] = W[(size_t)(k0 + kk) * N + n0 + (lane & 31)]; }
    LDS_WAIT(); asm volatile("" ::: "memory");
    const int c = lane & 7;
#pragma unroll
    for (int j = 0; j < 4; ++j) { const int n = (lane >> 3) + 8 * j; const LAS float* s = scr + (8 * c) * 33 + n;
        v4u o; o.x = pk2(s[0 * 33], s[1 * 33]); o.y = pk2(s[2 * 33], s[3 * 33]); o.z = pk2(s[4 * 33], s[5 * 33]); o.w = pk2(s[6 * 33], s[7 * 33]);
        *(GAS v4u*)(WT + (size_t)dst_row<MODE>(n0 + n) * ldk + koff + k0 + 8 * c) = o; }
    LDS_WAIT(); asm volatile("" ::: "memory");
}
template <int MODE> __device__ __forceinline__ void p0_transpose_item_fp8(const float* __restrict__ W, int K, int N, unsigned char* __restrict__ WT, LAS float* scr, int item, int lane, float S_W8, int ldk, int koff) {
    const int nblk = N / 32, kb = item / nblk, nb = item % nblk, k0 = 64 * kb, n0 = 32 * nb;
#pragma unroll 8
    for (int i = 0; i < 32; ++i) { const int kk = 2 * i + (lane >> 5); scr[kk * 33 + (lane & 31)] = W[(size_t)(k0 + kk) * N + n0 + (lane & 31)]; }
    LDS_WAIT(); asm volatile("" ::: "memory");
    const int c = lane & 3;
#pragma unroll
    for (int j = 0; j < 2; ++j) { const int n = (lane >> 2) + 16 * j; const LAS float* s = scr + (16 * c) * 33 + n;
        v4u o; o.x = pk4_fp8(s[0 * 33] * S_W8, s[1 * 33] * S_W8, s[2 * 33] * S_W8, s[3 * 33] * S_W8); o.y = pk4_fp8(s[4 * 33] * S_W8, s[5 * 33] * S_W8, s[6 * 33] * S_W8, s[7 * 33] * S_W8);
        o.z = pk4_fp8(s[8 * 33] * S_W8, s[9 * 33] * S_W8, s[10 * 33] * S_W8, s[11 * 33] * S_W8); o.w = pk4_fp8(s[12 * 33] * S_W8, s[13 * 33] * S_W8, s[14 * 33] * S_W8, s[15 * 33] * S_W8);
        *(GAS v4u*)(WT + (size_t)dst_row<MODE>(n0 + n) * ldk + koff + k0 + 16 * c) = o; }
    LDS_WAIT(); asm volatile("" ::: "memory");
}
struct MoeWTile { const float* W; unsigned char* WT; int K, N, k0, n0, mode; };
__device__ __forceinline__ MoeWTile moe_w_tile(int ti, const float* w_gu, const float* w_dn, unsigned char* Wgu_t, unsigned char* Wdn_t) {
    const int e = ti / 96, r = ti % 96; MoeWTile t;
    if (r < 64) { t.W = w_gu + (size_t)e * D * 2 * FF; t.WT = Wgu_t + (size_t)e * 2 * FF * D; t.K = D; t.N = 2 * FF; t.k0 = 64 * (r >> 2); t.n0 = 512 * (r & 3); t.mode = 2; }
    else { const int q = r - 64; t.W = w_dn + (size_t)e * FF * D; t.WT = Wdn_t + (size_t)e * D * FF; t.K = FF; t.N = D; t.k0 = 64 * (q >> 1); t.n0 = 512 * (q & 1); t.mode = 0; }
    return t;
}
struct P0Args { const float *x, *p, *g_mix, *w_in, *w_ao, *w_co, *w_o, *w_pg, *w_ple, *w_gu, *w_dn; bf16_t *Win_t, *Wao_t, *Wco_t, *Wo_t, *Wpg_t, *Wple_t; unsigned char *Wgu_t, *Wdn_t; bf16_t *XN, *PP; };
__device__ __forceinline__ void p0_prologue(Frame& F, const P0Args& a) {
    LAS float* scr = (LAS float*)(F.lds + RING_OFF + F.wave * 16384);
    const int lane = fresh_lane(), tid = F.wave * 64 + lane;
    const int gw = F.vcu * NWAVES + F.wave, NGW = F.G * NWAVES;
    constexpr int I_IN = (D / 64) * (INC / 32), I_AO = (AW / 64) * (D / 32), I_O = (D / 64) * (D / 32), I_PLE = (PLE / 64) * (D / 32), I_GU = (D / 64) * (2 * FF / 32), I_DN = (FF / 64) * (D / 32);
    constexpr int NSMALL = I_IN + 2 * I_AO + 2 * I_O + I_PLE;
    { LAS float* tile = (LAS float*)(F.lds + RING_OFF); constexpr int PITCH = 513, NT = NE * 96;
      const int t = tid, kr = t >> 7, n4 = (t & 127) * 4, nl = t >> 2, c = t & 3;
      f32x4 r[16]; int ti = blockIdx.x;
      if (ti < NT) { const MoeWTile w = moe_w_tile(ti, a.w_gu, a.w_dn, a.Wgu_t, a.Wdn_t);
#pragma unroll
          for (int i = 0; i < 16; ++i) r[i] = *(const f32x4*)(w.W + (size_t)(w.k0 + 4 * i + kr) * w.N + w.n0 + n4); }
      for (; ti < NT; ti += F.G) {
          const MoeWTile w = moe_w_tile(ti, a.w_gu, a.w_dn, a.Wgu_t, a.Wdn_t);
#pragma unroll
          for (int i = 0; i < 16; ++i) { LAS float* p = tile + (4 * i + kr) * PITCH + n4; p[0] = r[i][0]; p[1] = r[i][1]; p[2] = r[i][2]; p[3] = r[i][3]; }
          __syncthreads();
          if (ti + F.G < NT) { const MoeWTile wn = moe_w_tile(ti + F.G, a.w_gu, a.w_dn, a.Wgu_t, a.Wdn_t);
#pragma unroll
              for (int i = 0; i < 16; ++i) r[i] = *(const f32x4*)(wn.W + (size_t)(wn.k0 + 4 * i + kr) * wn.N + wn.n0 + n4); }
#pragma unroll
          for (int q = 0; q < 4; ++q) { const int n = nl + 128 * q; const LAS float* s = tile + (16 * c) * PITCH + n; v4u o;
              o.x = pk4_fp8(s[0 * PITCH] * S_W8, s[1 * PITCH] * S_W8, s[2 * PITCH] * S_W8, s[3 * PITCH] * S_W8); o.y = pk4_fp8(s[4 * PITCH] * S_W8, s[5 * PITCH] * S_W8, s[6 * PITCH] * S_W8, s[7 * PITCH] * S_W8);
              o.z = pk4_fp8(s[8 * PITCH] * S_W8, s[9 * PITCH] * S_W8, s[10 * PITCH] * S_W8, s[11 * PITCH] * S_W8); o.w = pk4_fp8(s[12 * PITCH] * S_W8, s[13 * PITCH] * S_W8, s[14 * PITCH] * S_W8, s[15 * PITCH] * S_W8);
              const int ns = w.n0 + n, dr = w.mode == 2 ? dst_row<2>(ns) : ns;
              *(GAS v4u*)(w.WT + (size_t)dr * w.K + w.k0 + 16 * c) = o; }
          __syncthreads();
      } }
    for (int it = gw; it < NSMALL; it += NGW) {
        int r = it;
        if (r < I_IN) { p0_transpose_item<1>(a.w_in, D, INC, a.Win_t, scr, r, lane); continue; } r -= I_IN;
        if (r < I_AO) { p0_transpose_item<0>(a.w_ao, AW, D, a.Wao_t, scr, r, lane, D, 0); continue; } r -= I_AO;
        if (r < I_AO) { p0_transpose_item<0>(a.w_co, CW, D, a.Wao_t, scr, r, lane, D, AW); continue; } r -= I_AO;
        if (r < I_O) { p0_transpose_item<0>(a.w_o, D, D, a.Wo_t, scr, r, lane); continue; } r -= I_O;
        if (r < I_O) { p0_transpose_item_fp8<0>(a.w_pg, D, D, (unsigned char*)a.Wpg_t, scr, r, lane, S_W8, UCW, PLE); continue; } r -= I_O;
        p0_transpose_item_fp8<0>(a.w_ple, PLE, D, (unsigned char*)a.Wpg_t, scr, r, lane, S_WPLE, UCW, 0);
    }
    { f32x4 gq[4];
#pragma unroll
      for (int j = 0; j < 4; ++j) gq[j] = ((const f32x4*)a.g_mix)[lane + 64 * j];
      f32x4 v[4], pv, vn[4], pn; int m = gw;
      if (m < M) { const f32x4* xr = (const f32x4*)(a.x + (size_t)m * D) + lane;
#pragma unroll
          for (int j = 0; j < 4; ++j) vn[j] = xr[64 * j];
          pn = ((const f32x4*)(a.p + (size_t)m * PLE))[lane]; }
      for (; m < M; m += NGW) {
#pragma unroll
          for (int j = 0; j < 4; ++j) v[j] = vn[j];
          pv = pn;
          if (m + NGW < M) { const f32x4* xr = (const f32x4*)(a.x + (size_t)(m + NGW) * D) + lane;
#pragma unroll
              for (int j = 0; j < 4; ++j) vn[j] = xr[64 * j];
              pn = ((const f32x4*)(a.p + (size_t)(m + NGW) * PLE))[lane]; }
          float s = 0.f;
#pragma unroll
          for (int j = 0; j < 4; ++j) s += v[j].x * v[j].x + v[j].y * v[j].y + v[j].z * v[j].z + v[j].w * v[j].w;
          const float rstd = rsqrtf(wave_sum(s) * (1.f / D) + EPS);
          u32x2* o8 = (u32x2*)(a.XN + (size_t)m * D) + lane;
#pragma unroll
          for (int j = 0; j < 4; ++j) { u32x2 w; w.x = pk2(v[j].x * rstd * gq[j].x, v[j].y * rstd * gq[j].y); w.y = pk2(v[j].z * rstd * gq[j].z, v[j].w * rstd * gq[j].w); o8[64 * j] = w; }
          ((unsigned*)((unsigned char*)a.PP + (size_t)m * UCW))[lane] = pk4_fp8(pv.x * S_P, pv.y * S_P, pv.z * S_P, pv.w * S_P);
      } }
}

template <int N> __device__ __forceinline__ void foldn(float (&v)[32], bool up, int mask) {
#pragma unroll
    for (int i = 0; i < N / 2; ++i) { const float mine = up ? v[i + N / 2] : v[i], other = up ? v[i] : v[i + N / 2]; v[i] = mine + __shfl_xor(other, mask); }
}
struct P3Args { const bf16_t *O1, *O2, *Z; const float *lq1, *lk1, *lq2, *lk2, *g_subln, *w_dw, *b_dw, *g_ln, *b_ln; bf16_t* AC; };
__device__ __forceinline__ void p3_combine_conv(Frame& F, const P3Args& a) {
    const int lane = fresh_lane(), wave = F.wave;
    const float lam = __expf(wave_sum(a.lq1[lane] * a.lk1[lane])) - __expf(wave_sum(a.lq2[lane] * a.lk2[lane])) + LAM_INIT;
    const int cg = wave & 3, th = wave >> 2, ch0 = cg * 128 + 2 * lane;
    f32x2 wk[KC];
#pragma unroll
    for (int k = 0; k < KC; ++k) wk[k] = *(const f32x2*)(a.w_dw + k * CW + ch0);
    const f32x2 bdw = *(const f32x2*)(a.b_dw + ch0), gl = *(const f32x2*)(a.g_ln + ch0), bl = *(const f32x2*)(a.b_ln + ch0);
    LAS float* part = (LAS float*)(F.lds + CONV_OFF);
    for (int chn = blockIdx.x; chn < M / 128; chn += F.G) {
        { const int c0 = lane * 8; const f32x4 g0 = *(const f32x4*)(a.g_subln + (c0 & 127)), g1 = *(const f32x4*)(a.g_subln + (c0 & 127) + 4);
          u32x4 xa[16], xb[16];
#pragma unroll
          for (int u = 0; u < 16; ++u) { const int m = chn * 128 + wave * 16 + u; xa[u] = *(const u32x4*)(a.O1 + (size_t)m * AW + c0); xb[u] = *(const u32x4*)(a.O2 + (size_t)m * AW + c0); }
#pragma unroll
          for (int q = 0; q < 16; q += 4) { const int m0 = chn * 128 + wave * 16 + q; u32x4 x1[4], x2[4];
#pragma unroll
            for (int u = 0; u < 4; ++u) { x1[u] = xa[q + u]; x2[u] = xb[q + u]; }
#pragma unroll
            for (int u = 0; u < 4; ++u) { float d[8]; float ss = 0.f;
#pragma unroll
                for (int i = 0; i < 4; ++i) { const unsigned ua = x1[u][i], ub = x2[u][i];
                    d[2 * i] = __uint_as_float(ua << 16) - lam * __uint_as_float(ub << 16); d[2 * i + 1] = __uint_as_float(ua & 0xffff0000u) - lam * __uint_as_float(ub & 0xffff0000u);
                    ss += d[2 * i] * d[2 * i] + d[2 * i + 1] * d[2 * i + 1]; }
                ss += __shfl_xor(ss, 1); ss += __shfl_xor(ss, 2); ss += __shfl_xor(ss, 4); ss += __shfl_xor(ss, 8);
                const float rstd = rsqrtf(ss * (1.f / 128.f) + EPS) * (1.f - LAM_INIT); u32x4 w;
                w.x = pk2(d[0] * rstd * g0.x, d[1] * rstd * g0.y); w.y = pk2(d[2] * rstd * g0.z, d[3] * rstd * g0.w); w.z = pk2(d[4] * rstd * g1.x, d[5] * rstd * g1.y); w.w = pk2(d[6] * rstd * g1.z, d[7] * rstd * g1.w);
                *(u32x4*)(a.AC + (size_t)(m0 + u) * D + c0) = w; } } }
        { const int ts = chn * 128 + th * 64, tseq = ts % SEQ;
          f32x2 zr[16 + KC - 1];
#pragma unroll
          for (int i = 0; i < 16 + KC - 1; ++i) { const bool ok = (tseq - (KC - 1) + i) >= 0; const unsigned v = ok ? *(const unsigned*)(a.Z + (size_t)(ts - (KC - 1) + i) * CW + ch0) : 0u; zr[i] = (f32x2){__uint_as_float(v << 16), __uint_as_float(v & 0xffff0000u)}; }
#pragma unroll 1
          for (int blk = 0; blk < 4; ++blk) {
            const int tok0 = ts + blk * 16;
            unsigned zn[16];
#pragma unroll
            for (int i = 0; i < 16; ++i) zn[i] = *(const unsigned*)(a.Z + (size_t)(blk < 3 ? tok0 + 16 + i : tok0) * CW + ch0);
            f32x2 y[16];
#pragma unroll
            for (int o = 0; o < 16; ++o) { f32x2 s = bdw;
#pragma unroll
                for (int k = 0; k < KC; ++k) s = wk[k] * zr[o + k] + s;
                y[o] = s; }
            float st[32];
#pragma unroll
            for (int o = 0; o < 16; ++o) { const f32x2 q = y[o] * y[o]; st[2 * o] = y[o].x + y[o].y; st[2 * o + 1] = q.x + q.y; }
            foldn<32>(st, lane & 32, 32); foldn<16>(st, lane & 16, 16); foldn<8>(st, lane & 8, 8); foldn<4>(st, lane & 4, 4); foldn<2>(st, lane & 2, 2);
            const float tot = st[0] + __shfl_xor(st[0], 1);
            LAS float* pb = part + (blk & 1) * 256 + th * 128;
            if ((lane & 1) == 0) pb[cg * 32 + (lane >> 1)] = tot;
            __syncthreads();
            float mean_l = 0.f, rstd_l = 0.f;
            if (lane < 16) { const float s1 = pb[2 * lane] + pb[32 + 2 * lane] + pb[64 + 2 * lane] + pb[96 + 2 * lane], s2 = pb[2 * lane + 1] + pb[32 + 2 * lane + 1] + pb[64 + 2 * lane + 1] + pb[96 + 2 * lane + 1];
                mean_l = s1 * (1.f / CW); const float var = fmaxf(s2 * (1.f / CW) - mean_l * mean_l, 0.f); rstd_l = rsqrtf(var + EPS); }
#pragma unroll
            for (int o = 0; o < 16; ++o) { const float mu = __builtin_bit_cast(float, __builtin_amdgcn_readlane(__builtin_bit_cast(int, mean_l), o)), rs = __builtin_bit_cast(float, __builtin_amdgcn_readlane(__builtin_bit_cast(int, rstd_l), o));
                f32x2 v = (y[o] - mu) * rs * gl + bl; v.x = v.x * pg8::fsig(v.x); v.y = v.y * pg8::fsig(v.y);
                *(unsigned*)(a.AC + (size_t)(tok0 + o) * D + AW + ch0) = pk2(v.x, v.y); }
#pragma unroll
            for (int i = 0; i < KC - 1; ++i) zr[i] = zr[i + 16];
#pragma unroll
            for (int i = 0; i < 16; ++i) zr[KC - 1 + i] = (f32x2){__uint_as_float(zn[i] << 16), __uint_as_float(zn[i] & 0xffff0000u)};
          } }
        __syncthreads();
    }
}

struct P6Args { const bf16_t* H; const float *g_ffn, *w_router, *b_router; unsigned char* U2;     int* topk_e; float* topk_g; int* list; unsigned* gcnt; };
__device__ __forceinline__ void p6_ins(unsigned long long (&v)[4], unsigned long long x) {
    const bool c0 = x > v[0], c1 = x > v[1], c2 = x > v[2], c3 = x > v[3];
    v[3] = c2 ? v[2] : (c3 ? x : v[3]); v[2] = c1 ? v[1] : (c2 ? x : v[2]); v[1] = c0 ? v[0] : (c1 ? x : v[1]); v[0] = c0 ? x : v[0];
}
__device__ __forceinline__ float p6_sumsq(unsigned w, float s) { const float lo = __uint_as_float(w << 16), hi = __uint_as_float(w & 0xffff0000u); return s + lo * lo + hi * hi; }
__device__ __forceinline__ void p6_router(Frame& F, const P6Args& a) {
    LAS unsigned* wT = (LAS unsigned*)(F.lds + RING_OFF); LAS int* lcnt = (LAS int*)(F.lds + RCTL_OFF); LAS int* lbase = lcnt + 32; LAS int* sl_e = lbase + 32; LAS int* sl_r = sl_e + 512; LAS float* sl_g = (LAS float*)(F.lds + CONV_OFF);
    const int lane = fresh_lane(), wave = F.wave, tid = wave * 64 + lane;
    for (int it = tid; it < (D / 2) * 8; it += 512) { const int k2 = it >> 3, c4 = it & 7; const float g0 = a.g_ffn[2 * k2], g1 = a.g_ffn[2 * k2 + 1];
        const f32x4 v0 = ((const f32x4*)a.w_router)[(2 * k2) * 8 + c4] * g0, v1 = ((const f32x4*)a.w_router)[(2 * k2 + 1) * 8 + c4] * g1;
#pragma unroll
        for (int i = 0; i < 4; ++i) { const int e = c4 * 4 + i; const unsigned h0 = f2bf(v0[i]), h1 = f2bf(v1[i]); const float r0 = v0[i] - __uint_as_float(h0 << 16), r1 = v1[i] - __uint_as_float(h1 << 16);
            const int w = e * (D / 2) + (k2 ^ (4 * (e & 15))); wT[w] = h0 | (h1 << 16); wT[NE * D / 2 + w] = f2bf(r0) | (f2bf(r1) << 16); } }
    if (tid < 32) lcnt[tid] = 0;
    __syncthreads();
    const int fr = lane & 15, fg = lane >> 4;
    f32x4 gg[4];
#pragma unroll
    for (int j = 0; j < 4; ++j) gg[j] = ((const f32x4*)a.g_ffn)[lane + 64 * j] * S_U2;
    const f32x4 bA = *(const f32x4*)(a.b_router + 4 * fg), bB = *(const f32x4*)(a.b_router + 16 + 4 * fg);
    for (int chn = blockIdx.x; chn < M / 128; chn += F.G) {
        const int t0 = chn * 128, tw = t0 + wave * 16;
        const bf16_t* hp = a.H + (size_t)(tw + fr) * D + fg * 8;
        const LAS unsigned* wp = wT + fr * (D / 2); const int sw = 4 * fr;
        f32x4 acc[2][2]; acc[0][0] = acc[0][1] = acc[1][0] = acc[1][1] = (f32x4){0.f, 0.f, 0.f, 0.f}; float ss = 0.f;
        u32x4 hv[8];
#pragma unroll
        for (int u = 0; u < 8; ++u) hv[u] = *(const u32x4*)(hp + 32 * u);
#pragma unroll 1
        for (int sb = 0; sb < 32; sb += 8) {
#pragma unroll
            for (int u = 0; u < 8; ++u) { const int s = sb + u; const u32x4 h = hv[u];
                if (sb + 8 < 32) hv[u] = *(const u32x4*)(hp + 32 * (s + 8));
                const int wo = (16 * s + 4 * fg) ^ sw;
                const pg8::bf16x8 w00 = *(const LAS pg8::bf16x8*)(wp + wo), w01 = *(const LAS pg8::bf16x8*)(wp + NE * D / 2 + wo), w10 = *(const LAS pg8::bf16x8*)(wp + 16 * (D / 2) + wo), w11 = *(const LAS pg8::bf16x8*)(wp + NE * D / 2 + 16 * (D / 2) + wo);
                ss = p6_sumsq(h.x, ss); ss = p6_sumsq(h.y, ss); ss = p6_sumsq(h.z, ss); ss = p6_sumsq(h.w, ss);
                const pg8::bf16x8 hb = __builtin_bit_cast(pg8::bf16x8, h);
                acc[0][0] = __builtin_amdgcn_mfma_f32_16x16x32_bf16(w00, hb, acc[0][0], 0, 0, 0); acc[0][1] = __builtin_amdgcn_mfma_f32_16x16x32_bf16(w01, hb, acc[0][1], 0, 0, 0);
                acc[1][0] = __builtin_amdgcn_mfma_f32_16x16x32_bf16(w10, hb, acc[1][0], 0, 0, 0); acc[1][1] = __builtin_amdgcn_mfma_f32_16x16x32_bf16(w11, hb, acc[1][1], 0, 0, 0); }
        }
        ss += __shfl_xor(ss, 16); ss += __shfl_xor(ss, 32);
        const float rn = rsqrtf(ss * (1.f / D) + EPS);
        unsigned long long v[4] = {0ull, 0ull, 0ull, 0ull};
#pragma unroll
        for (int blk = 0; blk < 2; ++blk)
#pragma unroll
            for (int i = 0; i < 4; ++i) { const float lg = (acc[blk][0][i] + acc[blk][1][i]) * rn + (blk ? bB[i] : bA[i]); const int e = 16 * blk + 4 * fg + i;
                unsigned ub = __float_as_uint(lg); ub = (ub & 0x80000000u) ? ~ub : (ub | 0x80000000u);
                p6_ins(v, ((unsigned long long)ub << 32) | (unsigned)(31 - e)); }
#pragma unroll
        for (int o = 16; o <= 32; o <<= 1) { unsigned long long p[4];
#pragma unroll
            for (int q = 0; q < 4; ++q) { const unsigned lo = __shfl_xor((unsigned)v[q], o), hi = __shfl_xor((unsigned)(v[q] >> 32), o); p[q] = ((unsigned long long)hi << 32) | lo; }
#pragma unroll
            for (int q = 0; q < 4; ++q) p6_ins(v, p[q]); }
        float tv[4];
#pragma unroll
        for (int q = 0; q < 4; ++q) { unsigned vb = (unsigned)(v[q] >> 32); vb = (vb & 0x80000000u) ? (vb & 0x7fffffffu) : ~vb; tv[q] = __uint_as_float(vb); }
        const float e1 = __expf(tv[1] - tv[0]), e2 = __expf(tv[2] - tv[0]), e3 = __expf(tv[3] - tv[0]), inv = 1.f / (1.f + e1 + e2 + e3);
        { const unsigned long long kk = fg == 0 ? v[0] : fg == 1 ? v[1] : fg == 2 ? v[2] : v[3]; const int e = 31 - (int)((unsigned)kk & 63u); const float gv = (fg == 0 ? 1.f : fg == 1 ? e1 : fg == 2 ? e2 : e3) * inv;
            const int m = tw + fr, sl = (wave * 16 + fr) * 4 + fg;
            a.topk_e[m * 4 + fg] = e; a.topk_g[m * 4 + fg] = gv;
            const int r = __hip_atomic_fetch_add(lcnt + e, 1, __ATOMIC_RELAXED, __HIP_MEMORY_SCOPE_WORKGROUP); sl_e[sl] = e; sl_r[sl] = r; sl_g[sl] = gv; }
#pragma unroll 1
        for (int hb8 = 0; hb8 < 16; hb8 += 8) { u32x2 raw[8][4];
#pragma unroll
            for (int q = 0; q < 8; ++q)
#pragma unroll
                for (int j = 0; j < 4; ++j) raw[q][j] = ((const u32x2*)(a.H + (size_t)(tw + hb8 + q) * D))[lane + 64 * j];
#pragma unroll
            for (int q = 0; q < 8; ++q) { const float rq = __int_as_float(__builtin_amdgcn_readlane(__float_as_int(rn), hb8 + q));
#pragma unroll
                for (int j = 0; j < 4; ++j) { const f32x4 sc = gg[j] * rq; const u32x2 w = raw[q][j];
                    ((unsigned*)(a.U2 + (size_t)(tw + hb8 + q) * D))[lane + 64 * j] = pk4_fp8(__uint_as_float(w.x << 16) * sc.x, __uint_as_float(w.x & 0xffff0000u) * sc.y, __uint_as_float(w.y << 16) * sc.z, __uint_as_float(w.y & 0xffff0000u) * sc.w); } } }
        __syncthreads();
        if (tid < 32) lbase[tid] = (int)__hip_atomic_fetch_add(a.gcnt + tid, (unsigned)lcnt[tid], __ATOMIC_RELAXED, __HIP_MEMORY_SCOPE_AGENT);
        __syncthreads();
        { const int e = sl_e[tid], pos = lbase[e] + sl_r[tid]; a.list[e * LIST_CAP + pos] = t0 * 4 + tid; ((float*)((char*)a.list + GLIST_DELTA))[e * LIST_CAP + pos] = sl_g[tid]; }
        __syncthreads();
        if (tid < 32) lcnt[tid] = 0;
        __syncthreads();
    }
}
__device__ __forceinline__ void moe_tables(Frame& F, const unsigned* gcnt) {
    LAS int* pmb = (LAS int*)(F.lds + MOE_OFF); LAS int* cnt = pmb + 64; LAS int* tu = pmb + 128; LAS unsigned short* ent = (LAS unsigned short*)(F.lds + CONV_OFF);
    const int tid = F.wave * 64 + fresh_lane();
    if (tid == 0) { int acc = 0; for (int e = 0; e < NE; ++e) { const int c = (int)__hip_atomic_load(gcnt + e, __ATOMIC_RELAXED, __HIP_MEMORY_SCOPE_AGENT); pmb[e] = acc; cnt[e] = c; acc += (c + 255) >> 8; } pmb[NE] = acc; tu[0] = acc; }
    __syncthreads();
    const int TU = tu[0];
    for (int mt = tid; mt < TU; mt += NWAVES * 64) { int e = 0;
#pragma unroll 1
        for (int k = 1; k < NE; ++k) if (pmb[k] <= mt) e = k;
        ent[mt] = (unsigned short)(e | ((mt - pmb[e]) << 5)); }
    __syncthreads();
}

__device__ __forceinline__ void p9_moe_combine(Frame& F, bf16_t* __restrict__ H, const unsigned char* __restrict__ Y, const float* __restrict__ g, unsigned char* __restrict__ U3) {
    const int gw = F.vcu * NWAVES + F.wave, NGW = F.G * NWAVES, lane = fresh_lane(); constexpr float isy = 1.f / S_Y;
    f32x4 gg[4];
#pragma unroll
    for (int j = 0; j < 4; ++j) gg[j] = *(const f32x4*)(g + 16 * lane + 4 * j);
    u32x4 nh0 = {0u, 0u, 0u, 0u}, nh1 = nh0, ny[TOPK];
#pragma unroll
    for (int k = 0; k < TOPK; ++k) ny[k] = nh0;
    if (gw < M) { const u32x4* hr = (const u32x4*)(H + (size_t)gw * D + 16 * lane); nh0 = hr[0]; nh1 = hr[1];
#pragma unroll
        for (int k = 0; k < TOPK; ++k) ny[k] = *(const u32x4*)(Y + ((size_t)gw * TOPK + k) * D + 16 * lane); }
    for (int m = gw; m < M; m += NGW) {
        u32x4* hr = (u32x4*)(H + (size_t)m * D + 16 * lane); const u32x4 h0 = nh0, h1 = nh1; u32x4 y[TOPK];
#pragma unroll
        for (int k = 0; k < TOPK; ++k) y[k] = ny[k];
        if (m + NGW < M) { const u32x4* hn = (const u32x4*)(H + (size_t)(m + NGW) * D + 16 * lane); nh0 = hn[0]; nh1 = hn[1];
#pragma unroll
            for (int k = 0; k < TOPK; ++k) ny[k] = *(const u32x4*)(Y + ((size_t)(m + NGW) * TOPK + k) * D + 16 * lane); }
        f32x4 v[4]; pg8::unpack8(h0, v[0], v[1]); pg8::unpack8(h1, v[2], v[3]);
#pragma unroll
        for (int k = 0; k < TOPK; ++k)
#pragma unroll
            for (int j = 0; j < 4; ++j) { float a, b, c, d; unpk4_fp8(y[k][j], a, b, c, d); v[j][0] += a * isy; v[j][1] += b * isy; v[j][2] += c * isy; v[j][3] += d * isy; }
        hr[0] = pg8::pack8(v[0], v[1]); hr[1] = pg8::pack8(v[2], v[3]);
        float s = 0.f;
#pragma unroll
        for (int j = 0; j < 4; ++j) s += v[j][0] * v[j][0] + v[j][1] * v[j][1] + v[j][2] * v[j][2] + v[j][3] * v[j][3];
        const float rstd = rsqrtf(wave_sum(s) * (1.f / D) + EPS);
        u32x4 o;
#pragma unroll
        for (int j = 0; j < 4; ++j) { const f32x4 t = v[j] * (rstd * S_U2) * gg[j]; o[j] = pk4_fp8(t[0], t[1], t[2], t[3]); }
        *(u32x4*)(U3 + (size_t)m * UCW + PLE + 16 * lane) = o;
    }
}
__device__ __forceinline__ void p11_final(Frame& F, const bf16_t* __restrict__ H, const float* __restrict__ g, float* __restrict__ O) {
    const int gw = F.vcu * NWAVES + F.wave, NGW = F.G * NWAVES, lane = fresh_lane();
    f32x4 gg[4];
#pragma unroll
    for (int j = 0; j < 4; ++j) gg[j] = *(const f32x4*)(g + 16 * lane + 4 * j);
    u32x4 n0a = {0u, 0u, 0u, 0u}, n0b = n0a, n1a = n0a, n1b = n0a;
    if (gw < M) { const u32x4* hr = (const u32x4*)(H + (size_t)gw * D + 16 * lane); n0a = hr[0]; n0b = hr[1]; }
    if (gw + NGW < M) { const u32x4* hr = (const u32x4*)(H + (size_t)(gw + NGW) * D + 16 * lane); n1a = hr[0]; n1b = hr[1]; }
    for (int m = gw; m < M; m += NGW) {
        const u32x4 ca = n0a, cb = n0b; n0a = n1a; n0b = n1b;
        if (m + 2 * NGW < M) { const u32x4* hn = (const u32x4*)(H + (size_t)(m + 2 * NGW) * D + 16 * lane); n1a = hn[0]; n1b = hn[1]; }
        f32x4 v[4]; pg8::unpack8(ca, v[0], v[1]); pg8::unpack8(cb, v[2], v[3]);
        float s = 0.f;
#pragma unroll
        for (int j = 0; j < 4; ++j) s += v[j][0] * v[j][0] + v[j][1] * v[j][1] + v[j][2] * v[j][2] + v[j][3] * v[j][3];
        const float rstd = rsqrtf(wave_sum(s) * (1.f / D) + EPS);
        f32x4* o = (f32x4*)(O + (size_t)m * D + 16 * lane);
#pragma unroll
        for (int j = 0; j < 4; ++j) o[j] = v[j] * rstd * gg[j];
    }
}

struct Args { const float* in[27]; float* out; unsigned char* ws; int ph_lo, ph_hi, li, pad; };
__global__ void __launch_bounds__(NWAVES * 64, 2) mega_fwd(Args args) {
    extern __shared__ __attribute__((aligned(16))) unsigned char lds[];
    Frame F;
    F.lds = (LAS unsigned char*)lds; F.MISC = (volatile LAS unsigned*)(F.lds + MISC_OFF);
    F.wave = __builtin_amdgcn_readfirstlane((int)threadIdx.x >> 6);
    F.G = gridDim.x; { const int bx = blockIdx.x; F.vcu = (F.G % 8 == 0) ? (bx % 8) * (F.G / 8) + bx / 8 : bx; }
    F.ctl = (gu32*)(args.ws + WS_CTL);
#define PHASE_ARGS() const __attribute__((address_space(4))) Args* ap_ = (const __attribute__((address_space(4))) Args*)__builtin_amdgcn_kernarg_segment_ptr(); asm volatile("" : "+s"(ap_)); unsigned char* const ws = ap_->ws
#define INP(i) (ap_->in[i])
#define WSP(T_, off) ((T_*)(ws + (off)))
    for (int u = F.wave * 64 + fresh_lane(); u < (LDS_BYTES - LDSCTL_OFF) / 4; u += NWAVES * 64) ((LAS unsigned*)(F.lds + LDSCTL_OFF))[u] = 0u;
    __syncthreads();
    XcdBarrier bar = xcd_barrier_post((unsigned*)(F.ctl + CW_BAR) + args.li * XCD_BAR_WORDS, F.MISC + 8, F.wave);
    const int lo = args.ph_lo, hi = args.ph_hi;
#ifndef PH_COMPILED
#define PH_COMPILED 0xFFF
#endif
#define IN(k) ((((PH_COMPILED) >> (k)) & 1) && lo <= (k) && (k) < hi)
#ifndef DUP_MASK
#define DUP_MASK 0
#endif
#define REPS(k) ((((DUP_MASK) >> (k)) & 1) + 1)
#define SEAM(k) do { if (IN(k) && IN((k) + 1)) xcd_barrier(bar); } while (0)

    for (int r_ = 0; r_ < REPS(0); ++r_) { if (r_) xcd_barrier(bar);
    if (IN(0)) { PHASE_ARGS(); const P0Args a{INP(0), INP(1), INP(2), INP(3), INP(9), INP(14), INP(15), INP(25), INP(23), INP(19), INP(21),
            WSP(bf16_t, WS_WIN), WSP(bf16_t, WS_WSM), WSP(bf16_t, WS_WSM + 1 * MiB), WSP(bf16_t, WS_WSM + 2 * MiB), WSP(bf16_t, WS_WSM + 4 * MiB), WSP(bf16_t, WS_WSM + 6 * MiB), WSP(unsigned char, WS_WGU), WSP(unsigned char, WS_WDN), WSP(bf16_t, WS_XN), WSP(bf16_t, WS_UC)};
        p0_prologue(F, a); }
    }
    SEAM(0);
    for (int r_ = 0; r_ < REPS(1); ++r_) { if (r_) xcd_barrier(bar);
    if (IN(1)) { PHASE_ARGS(); const pg8::Gemm g{WSP(bf16_t, WS_XN), WSP(bf16_t, WS_WIN), D, D, 0}; pg8::InProjOrder S; S.init(M, INC, F.G, (int)blockIdx.x);
        const pg8::EpiIn E{WSP(bf16_t, WS_Q), WSP(bf16_t, WS_K), WSP(bf16_t, WS_V), WSP(bf16_t, WS_Z), WSP(bf16_t, WS_SGA), WSP(bf16_t, WS_SGB)};
        pg8::gemm_phase<pg8::EpiIn, pg8::InProjOrder, true>(F.lds + RING_OFF, F.wave, g, S, E, SKEW_P1); }
    }
    SEAM(1);
    for (int r_ = 0; r_ < REPS(2); ++r_) { if (r_) xcd_barrier(bar);
    if (IN(2)) { PHASE_ARGS(); const attn_body::AttnPtrs AT{WSP(const attn_body::bf16, WS_Q), WSP(const attn_body::bf16, WS_K), WSP(const attn_body::bf16, WS_V), WSP(attn_body::bf16, WS_O1), WSP(attn_body::bf16, WS_O2)};
        attn_body::attn_phase<8>((char*)lds + RING_OFF, AT, F.G, F.vcu, F.wave); }
    }
    SEAM(2);
    for (int r_ = 0; r_ < REPS(3); ++r_) { if (r_) xcd_barrier(bar);
    if (IN(3)) { PHASE_ARGS(); const P3Args a{WSP(bf16_t, WS_O1), WSP(bf16_t, WS_O2), WSP(bf16_t, WS_Z), INP(4), INP(5), INP(6), INP(7), INP(8), INP(10), INP(11), INP(12), INP(13), WSP(bf16_t, WS_AC)}; p3_combine_conv(F, a); }
    }
    SEAM(3);
    for (int r_ = 0; r_ < REPS(4); ++r_) { if (r_) xcd_barrier(bar);
    if (IN(4)) { PHASE_ARGS(); pg8::StaticOrder S; S.init(M, D, F.G, (int)blockIdx.x);
        const pg8::Gemm g{WSP(bf16_t, WS_AC), WSP(bf16_t, WS_WSM), D, D, 0}; const pg8::EpiMixF E{WSP(unsigned char, WS_SGA), WSP(unsigned char, WS_SGB), WSP(bf16_t, WS_M1)};
        pg8::gemm_phase<pg8::EpiMixF, pg8::StaticOrder, true>(F.lds + RING_OFF, F.wave, g, S, E, SKEW_P4); }
    }
    SEAM(4);
    for (int r_ = 0; r_ < REPS(5); ++r_) { if (r_) xcd_barrier(bar);
    if (IN(5)) { PHASE_ARGS(); const pg8::Gemm g{WSP(bf16_t, WS_M1), WSP(bf16_t, WS_WSM + 2 * MiB), D, D, 0}; pg8::StaticOrder S; S.init(M, D, F.G, (int)blockIdx.x); const pg8::EpiWo E{INP(0), WSP(bf16_t, WS_H)};
        pg8::gemm_phase<pg8::EpiWo, pg8::StaticOrder, true>(F.lds + RING_OFF, F.wave, g, S, E, SKEW_P5); }
    }
    SEAM(5);
    for (int r_ = 0; r_ < REPS(6); ++r_) { if (r_) xcd_barrier(bar);
    if (IN(6)) { PHASE_ARGS(); const P6Args a{WSP(bf16_t, WS_H), INP(16), INP(17), INP(18), WSP(unsigned char, WS_XN), WSP(int, WS_TOPK_E), WSP(float, WS_TOPK_G), WSP(int, WS_LIST), WSP(unsigned, WS_CTL) + CW_GCNT}; p6_router(F, a); }
    }
    SEAM(6);
    if (IN(7) || IN(8)) { PHASE_ARGS(); moe_tables(F, WSP(unsigned, WS_CTL) + CW_GCNT); }
    for (int r_ = 0; r_ < REPS(7); ++r_) { if (r_) xcd_barrier(bar);
    if (IN(7)) { PHASE_ARGS(); const LAS int* pmb = (const LAS int*)(F.lds + MOE_OFF); const pg8::Gemm g{WSP(bf16_t, WS_XN), WSP(bf16_t, WS_WGU), D / 2, D / 2, (size_t)2 * FF * D / 2};
        const pg8::MoeOrder<true> S{(const LAS unsigned short*)(F.lds + CONV_OFF), pmb + 64, WSP(int, WS_LIST), 8, F.G, F.vcu, __builtin_amdgcn_readfirstlane(pmb[128]), D / 2}; const pg8::EpiGateUp E{INP(20), WSP(unsigned char, WS_ACT), (LAS float*)(F.lds + RCTL_OFF)};
        pg8::gemm_phase<pg8::EpiGateUp, pg8::MoeOrder<true>, true, true>(F.lds + RING_OFF, F.wave, g, S, E, SKEW_P7); }
    }
    SEAM(7);
    for (int r_ = 0; r_ < REPS(8); ++r_) { if (r_) xcd_barrier(bar);
    if (IN(8)) { PHASE_ARGS(); const LAS int* pmb = (const LAS int*)(F.lds + MOE_OFF); const pg8::Gemm g{WSP(bf16_t, WS_ACT), WSP(bf16_t, WS_WDN), FF / 2, FF / 2, (size_t)D * FF / 2};
        const pg8::MoeOrder<false> S{(const LAS unsigned short*)(F.lds + CONV_OFF), pmb + 64, WSP(int, WS_LIST), 4, F.G, F.vcu, __builtin_amdgcn_readfirstlane(pmb[128]), FF / 2}; const pg8::EpiDown E{INP(22), WSP(int, WS_LIST), WSP(unsigned char, WS_Y), WSP(unsigned char, WS_TRASH), (LAS unsigned*)(F.lds + LDSCTL_OFF + 8192)};
        pg8::gemm_phase<pg8::EpiDown, pg8::MoeOrder<false>, true, true>(F.lds + RING_OFF, F.wave, g, S, E, SKEW_P8); }
    }
    SEAM(8);
    for (int r_ = 0; r_ < REPS(9); ++r_) { if (r_) xcd_barrier(bar);
    if (IN(9)) { PHASE_ARGS(); p9_moe_combine(F, WSP(bf16_t, WS_H), WSP(unsigned char, WS_Y), INP(24), WSP(unsigned char, WS_UC)); }
    }
    SEAM(9);
    for (int r_ = 0; r_ < REPS(10); ++r_) { if (r_) xcd_barrier(bar);
    if (IN(10)) { PHASE_ARGS(); pg8::StaticOrder S; S.init(M, D, F.G, (int)blockIdx.x);
        const pg8::Gemm g{WSP(bf16_t, WS_UC), WSP(bf16_t, WS_WSM + 4 * MiB), UCW / 2, UCW / 2, 0}; const pg8::EpiPleF E{WSP(bf16_t, WS_E1), WSP(bf16_t, WS_H)};
        pg8::gemm_phase<pg8::EpiPleF, pg8::StaticOrder, true, true>(F.lds + RING_OFF, F.wave, g, S, E, SKEW_P10); }
    }
    SEAM(10);
    for (int r_ = 0; r_ < REPS(11); ++r_) { if (r_) xcd_barrier(bar);
    if (IN(11)) { PHASE_ARGS(); p11_final(F, WSP(bf16_t, WS_H), INP(26), ap_->out); }
    }
#undef IN
#undef SEAM
#undef PHASE_ARGS
#undef INP
#undef WSP
}

extern "C" void kernel_launch(void* const* d_in, const int* in_sizes, int n_in, void* d_out, int out_size, void* d_ws, size_t ws_size, hipStream_t stream) {
    static int grid = 0;
    if (grid == 0) {
        if (n_in != 27 || in_sizes[0] != M * D || out_size != M * D || ws_size < WS_END) { fprintf(stderr, "kernel_launch: unexpected shapes (n_in %d, in0 %d, out %d, ws %zu)\n", n_in, n_in > 0 ? in_sizes[0] : -1, out_size, ws_size); grid = -1; return; }
        int dev = 0, cus = 0, per_cu = 0;
        if (hipGetDevice(&dev) != hipSuccess || hipDeviceGetAttribute(&cus, hipDeviceAttributeMultiprocessorCount, dev) != hipSuccess) { grid = -1; return; }
        if (hipFuncSetAttribute((const void*)mega_fwd, hipFuncAttributeMaxDynamicSharedMemorySize, LDS_BYTES) != hipSuccess) { fprintf(stderr, "kernel_launch: hipFuncSetAttribute failed\n"); grid = -1; return; }
        if (hipOccupancyMaxActiveBlocksPerMultiprocessor(&per_cu, (const void*)mega_fwd, NWAVES * 64, LDS_BYTES) != hipSuccess || per_cu < 1) fprintf(stderr, "kernel_launch: occupancy query reports %d\n", per_cu);
        (void)hipGetLastError();
        grid = cus;
    }
    if (grid < 0) return;
    const float* const* in = (const float* const*)d_in;
    unsigned char* ws = (unsigned char*)d_ws; float* out = (float*)d_out;
    (void)hipMemsetAsync(ws + WS_CTL, 0, CTL_ZERO_BYTES, stream);
    Args a{};
    for (int i = 0; i < 27; ++i) a.in[i] = in[i];
    a.out = out; a.ws = ws;
#ifndef HDUP_MASK
#define HDUP_MASK 0
#endif
#if ONE_LAUNCH
    a.ph_lo = 0; a.ph_hi = NPHASE; a.li = 0;
    hipLaunchKernelGGL(mega_fwd, dim3(grid), dim3(NWAVES * 64), LDS_BYTES, stream, a);
#else
    for (int ph = 0; ph < NPHASE; ++ph) { a.ph_lo = ph; a.ph_hi = ph + 1; a.li = 3;
        const int nrep = 1 + (((HDUP_MASK) >> ph) & 1);
        for (int rep = 0; rep < nrep; ++rep) { const bool dry = rep + 1 < nrep;
            a.ws = ws + ((dry && ph == 9 && ws_size >= 1008 * MiB) ? 512 * MiB : (dry && ph == 10) ? 128 * MiB : (size_t)0);
            hipLaunchKernelGGL(mega_fwd, dim3(grid), dim3(NWAVES * 64), LDS_BYTES, stream, a);
            if (dry && ph == 6) (void)hipMemsetAsync(ws + WS_CTL + CW_GCNT * 4, 0, 128, stream); } }
#endif
}
```

```cpp
#include <hip/hip_runtime.h>
#include <cstdio>
#include <cstdint>
#include <hip/hip_bf16.h>
#include <cmath>
#define ONE_LAUNCH 1
#define DUP_MASK 0
#define KREP 1
#define EREP 1
#define HDUP_MASK 0

typedef unsigned short bf16_t;
typedef float f32x4 __attribute__((ext_vector_type(4)));
typedef unsigned u32x4 __attribute__((ext_vector_type(4)));
typedef unsigned u32x2 __attribute__((ext_vector_type(2)));
typedef float f32x2 __attribute__((ext_vector_type(2)));

constexpr int BATCH = 16, SEQ = 2048, D = 1024, M = BATCH * SEQ;
constexpr int AW = 512, CW = 512, NH = 4, HD = 64, KC = 31, NE = 32, TOPK = 4, FF = 1024, PLE = 256;
constexpr int INC = 3 * AW + 2 * CW + 2 * D;
constexpr float EPS = 1e-5f;
constexpr float C2 = 0.125f * 1.4426950408889634f;
constexpr float LAM_INIT = 0.2f;
constexpr int LIST_CAP = M;
constexpr int ACT_ROWS = M * TOPK + NE * 256;
constexpr int UCW = PLE + D;

constexpr size_t MiB = 1u << 20;
constexpr size_t WS_CTL = 0, CTL_ZERO_BYTES = 1 * MiB;
constexpr size_t WS_TOPK_E = 1 * MiB;
constexpr size_t WS_TOPK_G = 2 * MiB;
constexpr size_t WS_TRASH = 3 * MiB;
constexpr size_t WS_LIST = 4 * MiB;
constexpr size_t WS_GLIST = 26 * MiB, GLIST_DELTA = WS_GLIST - 4 * MiB;
constexpr size_t WS_WSM = 8 * MiB;
constexpr size_t WS_WIN = 16 * MiB;
constexpr size_t WS_WGU = 32 * MiB;
constexpr size_t WS_WDN = 160 * MiB;
constexpr size_t WS_UC = 224 * MiB;
constexpr size_t WS_H = 304 * MiB;
constexpr size_t WS_XN = 368 * MiB;
constexpr size_t WS_U2 = 496 * MiB;
constexpr size_t WS_Q = 432 * MiB, WS_K = 464 * MiB, WS_V = 496 * MiB;
constexpr size_t WS_Z = 528 * MiB;
constexpr size_t WS_SGA = 560 * MiB, WS_SGB = 624 * MiB;
constexpr size_t WS_O1 = 688 * MiB, WS_O2 = 720 * MiB;
constexpr size_t WS_AC = 752 * MiB;
constexpr size_t WS_M1 = 880 * MiB;
constexpr size_t WS_END = 944 * MiB;
constexpr size_t WS_Y = 368 * MiB;
constexpr size_t WS_ACT = 624 * MiB;
constexpr size_t WS_E1 = 688 * MiB;
static_assert(WS_ACT + (size_t)ACT_ROWS * FF <= WS_END && WS_Y + (size_t)M * TOPK * D <= WS_ACT, "overlays");
static_assert(WS_V - WS_K == WS_K - WS_Q, "Q | K | V equally spaced");
constexpr int CW_GCNT = 64;
constexpr int CW_MODE = 96;

__device__ __forceinline__ unsigned f2bf(float f) { unsigned u = __float_as_uint(f); return (u + 0x7fffu + ((u >> 16) & 1u)) >> 16; }
__device__ __forceinline__ unsigned pk2(float lo, float hi) { return f2bf(lo) | (f2bf(hi) << 16); }
constexpr float S_U2 = 16.f, S_W8 = 512.f, S_ACT = 4.f, S_Y = 32.f, S_P = 16.f, S_WPLE = 256.f;
__device__ __forceinline__ float clamp448(float x) { return __builtin_fminf(__builtin_fmaxf(x, -448.f), 448.f); }
__device__ __forceinline__ unsigned pk4_fp8(float a, float b, float c, float d) { int w = 0; w = __builtin_amdgcn_cvt_pk_fp8_f32(clamp448(a), clamp448(b), w, false); w = __builtin_amdgcn_cvt_pk_fp8_f32(clamp448(c), clamp448(d), w, true); return (unsigned)w; }
__device__ __forceinline__ void unpk4_fp8(unsigned w, float& a, float& b, float& c, float& d) { const f32x2 lo = __builtin_amdgcn_cvt_pk_f32_fp8((int)w, false), hi = __builtin_amdgcn_cvt_pk_f32_fp8((int)w, true); a = lo.x; b = lo.y; c = hi.x; d = hi.y; }
__device__ __forceinline__ int fresh_lane() { int l; asm volatile("v_mbcnt_lo_u32_b32 %0, -1, 0\n\tv_mbcnt_hi_u32_b32 %0, -1, %0" : "=v"(l)); return l; }
__device__ __forceinline__ float wave_sum(float v) {
#pragma unroll
    for (int o = 1; o < 64; o <<= 1) v += __shfl_xor(v, o);
    return v;
}

namespace pg8 {
#define PG8_LAS __attribute__((address_space(3)))
typedef short bf16x8 __attribute__((ext_vector_type(8)));
typedef int i32x4 __attribute__((ext_vector_type(4)));
constexpr int BM = 256, BK = 64, HALF = 128, HTB = HALF * BK * 2  , STAGE_BYTES = 8 * HTB, NXCD = 8, WGM = 8;

__host__ __device__ __forceinline__ int lds_byte(int r, int c) { const int st = (r >> 4) * 2 + (c >> 5), rr = r & 15, cc = c & 31, ob = rr * 64 + cc * 2; return st * 1024 + (ob ^ (((ob >> 9) & 1) << 5)); }
__host__ __device__ __forceinline__ void stage_rc(int b, int& R, int& C) { const int st = b / 1024, sb = b % 1024, swz = sb ^ (((sb >> 9) & 1) << 5); R = (st >> 1) * 16 + swz / 64; C = (st & 1) * 32 + (swz % 64) / 2; }
__host__ __device__ __forceinline__ int perm32(int rho) { const int n = rho >> 4, i = rho & 15; return 8 * (i >> 2) + 4 * n + (i & 3); }

struct Unit { int pm, pn, e, nv, p0; };
struct Gemm { const bf16_t* A; const bf16_t* Bt; int K, lda; size_t b_estride; };

struct StaticOrder {
    static constexpr bool GATHER = false;
    int nM, nN, nwg, G, c;
    __device__ void init(int M_, int N_, int G_, int c_) { nM = M_ / BM; nN = N_ / BM; nwg = nM * nN; G = G_; c = c_; }
    __device__ bool next(int i, Unit& u) const {
        const long L = (long)i * G + c; if (L >= nwg) return false;
        int wgid = (int)L; { const int q = nwg / NXCD, r = nwg % NXCD, xcd = wgid % NXCD, off = wgid / NXCD; wgid = (xcd < r ? xcd * (q + 1) : r * (q + 1) + (xcd - r) * q) + off; }
        const int nig = WGM * nN, gid = wgid / nig, fm = gid * WGM, gsz = (nM - fm) < WGM ? (nM - fm) : WGM;
        u.pm = fm + ((wgid % nig) % gsz); u.pn = (wgid % nig) / gsz; u.e = 0; u.nv = 256; u.p0 = 0; return true;
    }
    __device__ __forceinline__ unsigned row_off(const Unit&, int) const { return 0u; }
    __device__ __forceinline__ unsigned row_fin(int) const { return 0u; }
    __device__ __forceinline__ const int* idx_src(const Unit&) const { return nullptr; }
    __device__ __forceinline__ void a_ready(const Unit&) const {}
    __device__ __forceinline__ void done(const Unit&) const {}
};
struct InProjOrder {
    static constexpr bool GATHER = false;
    StaticOrder so; int x, j; bool custom;
    __device__ void init(int M_, int N_, int G_, int c_) { so.init(M_, N_, G_, c_); custom = (G_ == 256 && M_ / BM == 128 && N_ / BM == 18); x = c_ % NXCD; j = c_ / NXCD; }
    __device__ bool next(int i, Unit& u) const {
        if (!custom) return so.next(i, u);
        if (i >= 9) return false;
        int pm, pn;
        if (i == 2) { pm = j & 15; pn = 4 + (j >> 4); }
        else { const int k = i < 2 ? i : i - 3;        const int half = i < 2 ? i : (k & 1), grp = i < 2 ? 0 : 6 + 4 * (k >> 1); pm = 8 * half + (j & 7); pn = grp + (j >> 3); }
        u.pm = 16 * x + pm; u.pn = pn; u.e = 0; u.nv = 256; u.p0 = 0; return true;
    }
    __device__ __forceinline__ unsigned row_off(const Unit&, int) const { return 0u; }
    __device__ __forceinline__ unsigned row_fin(int) const { return 0u; }
    __device__ __forceinline__ const int* idx_src(const Unit&) const { return nullptr; }
    __device__ __forceinline__ void a_ready(const Unit&) const {}
    __device__ __forceinline__ void done(const Unit&) const {}
};
template <bool GATHER_> struct MoeOrder {
    static constexpr bool GATHER = GATHER_;
    const PG8_LAS unsigned short* ent; const PG8_LAS int* cnt; const int* list; int nN, G, vcu, TU, ld;
    __device__ bool next(int i, Unit& u) const {
        int mt, pn;
        if (G % (8 * nN) == 0) {
            const int mpx = G / 8 / nN, x = vcu / (G / 8), j = vcu % (G / 8), lo = (x * TU) / 8, hi = ((x + 1) * TU) / 8; mt = lo + i * mpx + (j % mpx); pn = j / mpx; if (mt >= hi) return false; }
        else { const int L = i * G + vcu; mt = L / nN; pn = L % nN; }
        if (mt >= TU) return false;
        const int v = __builtin_amdgcn_readfirstlane((int)ent[mt]), e = v & 31;
        u.pm = mt; u.pn = pn; u.e = e; u.p0 = 256 * (v >> 5); const int rem = __builtin_amdgcn_readfirstlane(cnt[e]) - u.p0; u.nv = rem < 256 ? rem : 256; return true;
    }
    __device__ __forceinline__ unsigned row_off(const Unit& u, int rl) const { const int r = rl < u.nv ? rl : u.nv - 1; const int tok = list[u.e * LIST_CAP + u.p0 + r] >> 2; return (unsigned)tok * (unsigned)ld; }
    __device__ __forceinline__ unsigned row_fin(int raw) const { return (unsigned)(raw >> 2) * (unsigned)ld; }
    __device__ __forceinline__ const int* idx_src(const Unit& u) const { return list + u.e * LIST_CAP + u.p0; }
    __device__ __forceinline__ void a_ready(const Unit&) const {}
    __device__ __forceinline__ void done(const Unit&) const {}
};

__device__ __forceinline__ unsigned cvt_pk_bf16(float lo, float hi) { unsigned r; asm volatile("v_cvt_pk_bf16_f32 %0, %1, %2" : "=v"(r) : "v"(lo), "v"(hi)); return r; }
__device__ __forceinline__ float fsig(float x) { return __builtin_amdgcn_rcpf(1.f + __builtin_amdgcn_exp2f(-1.4426950408889634f * x)); }
__device__ __forceinline__ u32x4 pack8(const f32x4 a, const f32x4 b) { u32x4 w; w.x = cvt_pk_bf16(a[0], a[1]); w.y = cvt_pk_bf16(a[2], a[3]); w.z = cvt_pk_bf16(b[0], b[1]); w.w = cvt_pk_bf16(b[2], b[3]); return w; }
__device__ __forceinline__ void unpack8(const u32x4 w, f32x4& a, f32x4& b) {
    a[0] = __uint_as_float(w.x << 16); a[1] = __uint_as_float(w.x & 0xffff0000u); a[2] = __uint_as_float(w.y << 16); a[3] = __uint_as_float(w.y & 0xffff0000u);
    b[0] = __uint_as_float(w.z << 16); b[1] = __uint_as_float(w.z & 0xffff0000u); b[2] = __uint_as_float(w.w << 16); b[3] = __uint_as_float(w.w & 0xffff0000u); }

__device__ __forceinline__ u32x4 widen16(u32x2 A, u32x2 B) {
    const auto r0 = __builtin_amdgcn_permlane16_swap(A.x, B.x, false, false), r1 = __builtin_amdgcn_permlane16_swap(A.y, B.y, false, false);
    return (u32x4){r0[0], r1[0], r0[1], r1[1]};
}
struct EpiIn { static constexpr bool PERM = true, AFTER_DRAIN = false, IDEMPOTENT = true, MIDK = false; bf16_t *Q, *K, *V, *Z, *SGA, *SGB;
    __device__ __forceinline__ void operator()(const f32x4 (&acc)[2][2][4][2], const Unit& u, int wr, int wc, int fr, int fq) const {
        const int pn = u.pn, row0 = u.pm * BM + wr * 64 + fr;
        if (pn >= 6 && pn < 10) {
            bf16_t* base = Z + (pn - 6) * 128 + wc * 32 + 8 * fq;
#pragma unroll
            for (int ai = 0; ai < 2; ++ai)
#pragma unroll
                for (int m = 0; m < 4; ++m) { f32x4 o0, o1;
#pragma unroll
                    for (int i = 0; i < 4; ++i) { o0[i] = acc[ai][0][m][0][i] * fsig(acc[ai][1][m][0][i]); o1[i] = acc[ai][0][m][1][i] * fsig(acc[ai][1][m][1][i]); }
                    *(u32x4*)(base + (size_t)(row0 + ai * HALF + m * 16) * CW) = pack8(o0, o1); }
        } else if (pn >= 10) {
            unsigned char* base = (unsigned char*)SGA + (size_t)((pn - 10) >> 2) * (WS_SGB - WS_SGA) + ((pn - 10) & 3) * 256 + wc * 32 + 8 * fq;
#pragma unroll
            for (int ai = 0; ai < 2; ++ai)
#pragma unroll
                for (int m = 0; m < 4; ++m) { unsigned char* rowp = base + (size_t)(row0 + ai * HALF + m * 16) * D;
                    u32x2 w[2];
#pragma unroll
                    for (int bj = 0; bj < 2; ++bj)
#pragma unroll
                        for (int n = 0; n < 2; ++n) { unsigned q[4];
#pragma unroll
                            for (int i = 0; i < 4; ++i) q[i] = (unsigned)__builtin_fmaxf(fsig(acc[ai][bj][m][n][i]) * 255.f + 0.5f, 1.f);
                            w[bj][n] = q[0] | (q[1] << 8) | (q[2] << 16) | (q[3] << 24); }
                    *(u32x4*)(rowp + (fq & 1) * (HALF - 8)) = widen16(w[0], w[1]); }
        } else {
            const float sc = pn < 2 ? C2 : 1.f;
            bf16_t* base = Q + (size_t)(pn >> 1) * ((WS_K - WS_Q) / 2) + (pn & 1) * 256 + wc * 32 + 8 * fq;
#pragma unroll
            for (int ai = 0; ai < 2; ++ai)
#pragma unroll
                for (int m = 0; m < 4; ++m) { bf16_t* rowp = base + (size_t)(row0 + ai * HALF + m * 16) * AW;
#pragma unroll
                    for (int bj = 0; bj < 2; ++bj) *(u32x4*)(rowp + bj * HALF) = pack8(acc[ai][bj][m][0] * sc, acc[ai][bj][m][1] * sc); }
        }
    }
};
struct EpiMixF { static constexpr bool PERM = true, AFTER_DRAIN = false, IDEMPOTENT = true, MIDK = true; static constexpr int MIDT = 8; const unsigned char* SGA; const unsigned char* SGB; bf16_t* Out;
    static __device__ __forceinline__ void ub4(unsigned w, f32x4& o) { o[0] = (float)(w & 0xffu); o[1] = (float)((w >> 8) & 0xffu); o[2] = (float)((w >> 16) & 0xffu); o[3] = (float)(w >> 24); }
    __device__ __forceinline__ void mid(f32x4 (&acc)[2][2][4][2], const Unit& u, int wr, int wc, int fr, int fq) const {
        const int row0 = u.pm * BM + wr * 64 + fr, col0 = u.pn * BM + wc * 32 + 8 * fq;
        u32x2 ra[2][4][2], rb[2][4][2];
#pragma unroll
        for (int ai = 0; ai < 2; ++ai)
#pragma unroll
            for (int m = 0; m < 4; ++m)
#pragma unroll
                for (int bj = 0; bj < 2; ++bj) { const size_t off = (size_t)(row0 + ai * HALF + m * 16) * D + col0 + bj * HALF; ra[ai][m][bj] = *(const u32x2*)(SGA + off); rb[ai][m][bj] = *(const u32x2*)(SGB + off); }
#pragma unroll
        for (int ai = 0; ai < 2; ++ai)
#pragma unroll
            for (int m = 0; m < 4; ++m)
#pragma unroll
                for (int bj = 0; bj < 2; ++bj)
#pragma unroll
                    for (int n = 0; n < 2; ++n) { f32x4 a, b; ub4(ra[ai][m][bj][n], a); ub4(rb[ai][m][bj][n], b);
#pragma unroll
                        for (int i = 0; i < 4; ++i) acc[ai][bj][m][n][i] *= a[i] * __builtin_amdgcn_rcpf(b[i]); }
    }
    __device__ __forceinline__ void operator()(const f32x4 (&acc)[2][2][4][2], const Unit& u, int wr, int wc, int fr, int fq) const {
        const int row0 = u.pm * BM + wr * 64 + fr, col0 = u.pn * BM + wc * 32 + 8 * fq;
        u32x2 rb[2][4][2];
#pragma unroll
        for (int ai = 0; ai < 2; ++ai)
#pragma unroll
            for (int m = 0; m < 4; ++m)
#pragma unroll
                for (int bj = 0; bj < 2; ++bj) rb[ai][m][bj] = *(const u32x2*)(SGB + (size_t)(row0 + ai * HALF + m * 16) * D + col0 + bj * HALF);
#pragma unroll
        for (int ai = 0; ai < 2; ++ai)
#pragma unroll
            for (int m = 0; m < 4; ++m)
#pragma unroll
                for (int bj = 0; bj < 2; ++bj) { const size_t off = (size_t)(row0 + ai * HALF + m * 16) * D + col0 + bj * HALF;
                    f32x4 s0, s1; ub4(rb[ai][m][bj][0], s0); ub4(rb[ai][m][bj][1], s1); *(u32x4*)(Out + off) = pack8(acc[ai][bj][m][0] * (s0 * (1.f / 255.f)), acc[ai][bj][m][1] * (s1 * (1.f / 255.f))); }
    }
};
struct EpiWo { static constexpr bool PERM = true, AFTER_DRAIN = false, IDEMPOTENT = true, MIDK = false; const float* X; bf16_t* H;
    __device__ __forceinline__ void operator()(const f32x4 (&acc)[2][2][4][2], const Unit& u, int wr, int wc, int fr, int fq) const {
        const int row0 = u.pm * BM + wr * 64 + fr, col0 = u.pn * BM + wc * 32 + 8 * fq;
#pragma unroll
        for (int ai = 0; ai < 2; ++ai)
#pragma unroll
            for (int m = 0; m < 4; ++m) { const size_t off = (size_t)(row0 + ai * HALF + m * 16) * D + col0;
#pragma unroll
                for (int bj = 0; bj < 2; ++bj) *(u32x4*)(H + off + bj * HALF) = pack8(*(const f32x4*)(X + off + bj * HALF) + acc[ai][bj][m][0], *(const f32x4*)(X + off + bj * HALF + 4) + acc[ai][bj][m][1]); }
    }
};
struct EpiGateUp { static constexpr bool PERM = true, AFTER_DRAIN = false, IDEMPOTENT = true, MIDK = true; static constexpr int MIDT = 2; const float* bias; unsigned char* ACT; PG8_LAS float* stg;
    __device__ __forceinline__ void mid(f32x4 (&acc)[2][2][4][2], const Unit& u, int wr, int wc, int fr, int fq) const {
        if (wr * 4 + wc == 0) { const char* src = (const char*)(bias + (size_t)u.e * (2 * FF) + 2 * u.pn * 128); unsigned off = (unsigned)(fq * 16 + fr) * 16u; asm volatile("" : "+s"(src), "+v"(off));
            __builtin_amdgcn_global_load_lds((const unsigned*)(src + off), (PG8_LAS unsigned*)stg, 16, 0, 0); }
    }
    __device__ __forceinline__ void operator()(const f32x4 (&acc)[2][2][4][2], const Unit& u, int wr, int wc, int fr, int fq) const {
        const int jb = u.pn * 128 + wc * 32 + 8 * fq; const PG8_LAS float* bp0 = stg + 2 * (wc * 32 + 8 * fq);
        const int row0 = u.pm * BM + wr * 64 + fr; constexpr float isc = 1.f / (S_U2 * S_W8);
        f32x4 bg[2], bl[2];
#pragma unroll
        for (int n = 0; n < 2; ++n) { const f32x4 b0 = *(const PG8_LAS f32x4*)(bp0 + 8 * n), b1 = *(const PG8_LAS f32x4*)(bp0 + 8 * n + 4); bg[n] = (f32x4){b0[0], b0[2], b1[0], b1[2]}; bl[n] = (f32x4){b0[1], b0[3], b1[1], b1[3]}; }
        unsigned char* const base = ACT + (size_t)(row0 + (fq & 1) * 16) * FF + jb - 8 * (fq & 1);
#pragma unroll
        for (int ai = 0; ai < 2; ++ai)
#pragma unroll
            for (int mp = 0; mp < 4; mp += 2) { u32x2 w[2];
#pragma unroll
                for (int mm = 0; mm < 2; ++mm) { const int m = mp + mm;
#pragma unroll
                    for (int n = 0; n < 2; ++n) { f32x4 o;
#pragma unroll
                        for (int i = 0; i < 4; ++i) { const float gate = fminf(acc[ai][0][m][n][i] * isc + bg[n][i], 7.f), lin = fminf(fmaxf(acc[ai][1][m][n][i] * isc + bl[n][i], -7.f), 7.f);
                            o[i] = (lin * gate + gate) * __builtin_amdgcn_rcpf(0.25f + 0.25f * __builtin_amdgcn_exp2f(-1.702f * 1.4426950408889634f * gate)); }
                        int q = 0; q = __builtin_amdgcn_cvt_pk_fp8_f32(o[0], o[1], q, false); q = __builtin_amdgcn_cvt_pk_fp8_f32(o[2], o[3], q, true); w[mm][n] = (unsigned)q; } }
                *(u32x4*)(base + (size_t)(ai * HALF + mp * 16) * FF) = widen16(w[0], w[1]); }
    }
};
struct EpiDown { static constexpr bool PERM = true, AFTER_DRAIN = false, IDEMPOTENT = true, MIDK = true; static constexpr int MIDT = 2; const float* bias; const int* list; unsigned char* Y; unsigned char* trash; PG8_LAS unsigned* stg;
    __device__ __forceinline__ void mid(f32x4 (&acc)[2][2][4][2], const Unit& u, int wr, int wc, int fr, int fq) const {
        const int w = wr * 4 + wc;
        const char* src = (const char*)(list + u.e * LIST_CAP + u.p0 + (w & 3) * 64) + (size_t)(w >> 2) * GLIST_DELTA; unsigned off = (unsigned)(fq * 16 + fr) * 4u; asm volatile("" : "+s"(src), "+v"(off));
        __builtin_amdgcn_global_load_lds((const unsigned*)(src + off), stg + w * 64, 4, 0, 0);
        if (w == 0) { const char* sb = (const char*)(bias + (size_t)u.e * D + u.pn * BM); unsigned ob = (unsigned)(fq * 16 + fr) * 16u; asm volatile("" : "+s"(sb), "+v"(ob));
            __builtin_amdgcn_global_load_lds((const unsigned*)(sb + ob), stg + 512, 16, 0, 0); }
    }
    __device__ __forceinline__ void operator()(const f32x4 (&acc)[2][2][4][2], const Unit& u, int wr, int wc, int fr, int fq) const {
        const int col0 = u.pn * BM + wc * 32 + 8 * fq; const PG8_LAS float* bp = (const PG8_LAS float*)(stg + 512) + wc * 32 + 8 * fq; constexpr float isc = 1.f / (S_ACT * S_W8);
        f32x4 bv[2][2];
#pragma unroll
        for (int bj = 0; bj < 2; ++bj)
#pragma unroll
            for (int n = 0; n < 2; ++n) bv[bj][n] = *(const PG8_LAS f32x4*)(bp + bj * HALF + 4 * n);
        int slot[8]; float gv[8];
#pragma unroll
        for (int q = 0; q < 8; ++q) { const int rl = (q >> 2) * HALF + wr * 64 + (q & 3) * 16 + fr; slot[q] = (int)stg[rl]; gv[q] = __uint_as_float(stg[256 + rl]) * S_Y; }
#pragma unroll
        for (int ai = 0; ai < 2; ++ai)
#pragma unroll
            for (int m = 0; m < 4; ++m) { const int q = ai * 4 + m, rl = ai * HALF + wr * 64 + m * 16 + fr; unsigned char* rowp = (rl < u.nv ? Y + (size_t)slot[q] * D : trash) + col0;
                u32x2 w[2];
#pragma unroll
                for (int bj = 0; bj < 2; ++bj) { const f32x4 v0 = (acc[ai][bj][m][0] * isc + bv[bj][0]) * gv[q], v1 = (acc[ai][bj][m][1] * isc + bv[bj][1]) * gv[q]; w[bj].x = pk4_fp8(v0[0], v0[1], v0[2], v0[3]); w[bj].y = pk4_fp8(v1[0], v1[1], v1[2], v1[3]); }
                *(u32x4*)(rowp + (fq & 1) * (HALF - 8)) = widen16(w[0], w[1]); }
    }
};
struct EpiPlain { static constexpr bool PERM = true, AFTER_DRAIN = false, IDEMPOTENT = true, MIDK = false; bf16_t* O;
    __device__ __forceinline__ void operator()(const f32x4 (&acc)[2][2][4][2], const Unit& u, int wr, int wc, int fr, int fq) const {
        const int row0 = u.pm * BM + wr * 64 + fr, col0 = u.pn * BM + wc * 32 + 8 * fq;
#pragma unroll
        for (int ai = 0; ai < 2; ++ai)
#pragma unroll
            for (int m = 0; m < 4; ++m)
#pragma unroll
                for (int bj = 0; bj < 2; ++bj) *(u32x4*)(O + (size_t)(row0 + ai * HALF + m * 16) * D + col0 + bj * HALF) = pack8(acc[ai][bj][m][0], acc[ai][bj][m][1]);
    }
};
struct EpiPleF { static constexpr bool PERM = true, AFTER_DRAIN = false, IDEMPOTENT = false, MIDK = true; static constexpr int MIDT = 2;     bf16_t* E1; bf16_t* H;
    __device__ __forceinline__ void mid(f32x4 (&acc)[2][2][4][2], const Unit& u, int wr, int wc, int fr, int fq) const {
        const int row0 = u.pm * BM + wr * 64 + fr, col0 = u.pn * BM + wc * 32 + 8 * fq;
#pragma unroll
        for (int ai = 0; ai < 2; ++ai)
#pragma unroll
            for (int m = 0; m < 4; ++m)
#pragma unroll
                for (int bj = 0; bj < 2; ++bj) { *(u32x4*)(E1 + (size_t)(row0 + ai * HALF + m * 16) * D + col0 + bj * HALF) = pack8(acc[ai][bj][m][0] * (1.f / (S_P * S_WPLE)), acc[ai][bj][m][1] * (1.f / (S_P * S_WPLE)));
                    acc[ai][bj][m][0] = (f32x4){0.f, 0.f, 0.f, 0.f}; acc[ai][bj][m][1] = (f32x4){0.f, 0.f, 0.f, 0.f}; }
        asm volatile("s_waitcnt vmcnt(0)" ::: "memory");
    }
    __device__ __forceinline__ void operator()(const f32x4 (&acc)[2][2][4][2], const Unit& u, int wr, int wc, int fr, int fq) const {
        const int row0 = u.pm * BM + wr * 64 + fr, col0 = u.pn * BM + wc * 32 + 8 * fq;
#pragma unroll
        for (int ai = 0; ai < 2; ++ai)
#pragma unroll
            for (int m = 0; m < 4; ++m)
#pragma unroll
                for (int bj = 0; bj < 2; ++bj) { const size_t o = (size_t)(row0 + ai * HALF + m * 16) * D + col0 + bj * HALF; f32x4 e0, e1, h0, h1; unpack8(*(const u32x4*)(E1 + o), e0, e1); unpack8(*(const u32x4*)(H + o), h0, h1);
                    const f32x4 a0 = acc[ai][bj][m][0] * (1.f / (S_U2 * S_W8)), a1 = acc[ai][bj][m][1] * (1.f / (S_U2 * S_W8));
#pragma unroll
                    for (int i = 0; i < 4; ++i) { h0[i] += e0[i] * fsig(a0[i]); h1[i] += e1[i] * fsig(a1[i]); }
                    *(u32x4*)(H + o) = pack8(h0, h1); }
    }
};

template <class Epi, class Sched, bool ALIGN_EPI, bool FP8 = false>
__device__ __forceinline__ void gemm_phase(PG8_LAS unsigned char* lds, int wave_s, const Gemm g, const Sched& S, const Epi& E, unsigned skew_ticks = 0u) {
    if (skew_ticks) { const unsigned xc = (unsigned)__builtin_amdgcn_s_getreg((3 << 11) | 20) & 0xFu, x = (skew_ticks >> 31) ? (xc & 1u) : xc;
        const unsigned long long t0 = __builtin_amdgcn_s_memrealtime(), dt = (unsigned long long)x * (skew_ticks & 0x7fffffffu);
        while (__builtin_amdgcn_s_memrealtime() - t0 < dt) __builtin_amdgcn_s_sleep(8); }
    const int wid = wave_s, lane = fresh_lane(), tid = wid * 64 + lane;
    const int wr = wid >> 2, wc = wid & 3, fr = lane & 15, fq = lane >> 4;
    const int K = g.K, nt = K / BK, lda = g.lda;
    unsigned voffA[2], voffB[2];
#pragma unroll
    for (int i = 0; i < 2; ++i) { int R, C; stage_rc(tid * 16 + i * 8192, R, C); const int Rb = Epi::PERM ? ((R & ~31) + perm32(R & 31)) : R;
        voffA[i] = (unsigned)(R * lda + C) * 2u; voffB[i] = (unsigned)(Rb * K + C) * 2u; }
    const size_t kstep = (size_t)(BK * 2);
    const size_t hstepA = (size_t)HALF * lda * 2, tstepA = 2 * hstepA, hstepB = (size_t)HALF * K * 2, tstepB = 2 * hstepB;
    const unsigned ldsw = (unsigned)wid * 1024u;
    const int aoff = lds_byte(wr * 64 + fr, fq * 8), boff = lds_byte(wc * 32 + fr, fq * 8);
#define PG8_SA(b, h) (((b) * 2 + (h)) * HTB)
#define PG8_SB(b, h) ((4 + (b) * 2 + (h)) * HTB)
#define PG8_DMA(bufoff, ptr, o0, o1) do { const char* _p = (const char*)(ptr); unsigned _q0 = (o0), _q1 = (o1); asm volatile("" : "+s"(_p), "+v"(_q0), "+v"(_q1));     \
        __builtin_amdgcn_global_load_lds((const unsigned*)(_p + _q0), (PG8_LAS unsigned*)(lds + (bufoff) + ldsw), 16, 0, 0); \
        __builtin_amdgcn_global_load_lds((const unsigned*)(_p + _q1), (PG8_LAS unsigned*)(lds + (bufoff) + ldsw + 8192), 16, 0, 0); } while (0)
#define PG8_STA(bufoff, h, koff, NX) do { if constexpr (Sched::GATHER) { \
        PG8_DMA(bufoff, (const char*)g.A + (koff), (h) ? cG1[0] : cG0[0], (h) ? cG1[1] : cG0[1]);     \
    } else { PG8_DMA(bufoff, ((NX) ? nA : cA) + (size_t)(h) * hstepA + (koff), voffA[0], voffA[1]); } } while (0)
#define PG8_STB(bufoff, h, koff, NX) PG8_DMA(bufoff, ((NX) ? nB : cB) + (size_t)(h) * hstepB + (koff), voffB[0], voffB[1])
#define PG8_LDA(dst, b, h) do { _Pragma("unroll") for (int m = 0; m < 4; ++m) _Pragma("unroll") for (int k = 0; k < 2; ++k) dst[m][k] = *(const PG8_LAS bf16x8*)(lds + PG8_SA(b, h) + aoff + m * 2048 + k * 1024); } while (0)
#define PG8_LDB(dst, b, h) do { _Pragma("unroll") for (int n = 0; n < 2; ++n) _Pragma("unroll") for (int k = 0; k < 2; ++k) dst[n][k] = *(const PG8_LAS bf16x8*)(lds + PG8_SB(b, h) + boff + n * 2048 + k * 1024); } while (0)
#define PG8_CAT(x) __builtin_shufflevector(__builtin_bit_cast(i32x4, x[0]), __builtin_bit_cast(i32x4, x[1]), 0, 1, 2, 3, 4, 5, 6, 7)
#define PG8_MMA(ai, bj, At, Bt) do { __builtin_amdgcn_s_setprio(1); _Pragma("unroll") for (int m = 0; m < 4; ++m) _Pragma("unroll") for (int n = 0; n < 2; ++n) { \
        if constexpr (FP8) acc[ai][bj][m][n] = __builtin_amdgcn_mfma_scale_f32_16x16x128_f8f6f4(PG8_CAT(Bt[n]), PG8_CAT(At[m]), acc[ai][bj][m][n], 0, 0, 0, 0x7f7f7f7f, 0, 0x7f7f7f7f); \
        else { _Pragma("unroll") for (int k = 0; k < 2; ++k) acc[ai][bj][m][n] = __builtin_amdgcn_mfma_f32_16x16x32_bf16(Bt[n][k], At[m][k], acc[ai][bj][m][n], 0, 0, 0); } } \
        __builtin_amdgcn_s_setprio(0); } while (0)
#define PG8_WAIT_V(n) asm volatile("s_waitcnt vmcnt(" #n ")" ::: "memory")
#define PG8_WAIT_L(n) asm volatile("s_waitcnt lgkmcnt(" #n ")" ::: "memory")
#define PG8_BAR __builtin_amdgcn_s_barrier()
#define PG8_SCHED __builtin_amdgcn_sched_barrier(0)
    Unit cur, nxt; int ui = 0;
    if (!S.next(0, cur)) return;
    f32x4 acc[2][2][4][2];
#pragma unroll
    for (int a = 0; a < 2; ++a)
#pragma unroll
        for (int b = 0; b < 2; ++b)
#pragma unroll
            for (int m = 0; m < 4; ++m)
#pragma unroll
                for (int n = 0; n < 2; ++n) acc[a][b][m][n] = (f32x4){0.f, 0.f, 0.f, 0.f};
    bf16x8 At[4][2], B0[2][2], B1[2][2];
    const char* cA = (const char*)g.A + (Sched::GATHER ? (size_t)0 : (size_t)cur.pm * tstepA);
    const char* cB = (const char*)g.Bt + (size_t)cur.e * g.b_estride * 2 + (size_t)cur.pn * tstepB;
    const char* nA = cA; const char* nB = cB;
    unsigned cG0[2] = {0u, 0u}, cG1[2] = {0u, 0u};
    const PG8_LAS int* const gidx = (const PG8_LAS int*)(lds + STAGE_BYTES + 512 + 1024);
    PG8_LAS u32x4* const park = (PG8_LAS u32x4*)(lds + STAGE_BYTES + 8192) + tid;
    if constexpr (Sched::GATHER) {
#pragma unroll
        for (int i = 0; i < 2; ++i) { int R, C; stage_rc((wid * 64 + fresh_lane()) * 16 + i * 8192, R, C); cG0[i] = (S.row_off(cur, R) + (unsigned)C) * 2u; cG1[i] = (S.row_off(cur, HALF + R) + (unsigned)C) * 2u; } }
    S.a_ready(cur);
    PG8_STB(PG8_SB(0, 0), 0, 0, false); PG8_STB(PG8_SB(0, 1), 1, 0, false); PG8_STA(PG8_SA(0, 0), 0, 0, false); PG8_STA(PG8_SA(0, 1), 1, 0, false);
    if (wr == 1) PG8_BAR;
    PG8_WAIT_V(2); PG8_BAR;
    PG8_STB(PG8_SB(1, 0), 0, kstep, false); PG8_STA(PG8_SA(1, 0), 0, kstep, false); PG8_STB(PG8_SB(1, 1), 1, kstep, false);
    PG8_WAIT_V(6); PG8_BAR;
    bool has_next = S.next(1, nxt);
    if constexpr (!Sched::GATHER) nA = has_next ? (const char*)g.A + (size_t)nxt.pm * tstepA : cA;
    nB = has_next ? (const char*)g.Bt + (size_t)nxt.e * g.b_estride * 2 + (size_t)nxt.pn * tstepB : cB;
    if constexpr (Sched::GATHER) {
        u32x4 pk; pk.x = cG0[0]; pk.y = cG0[1]; pk.z = cG1[0]; pk.w = cG1[1];
        if (has_next) {
            int R0, C0, R1, C1; stage_rc((wid * 64 + fresh_lane()) * 16, R0, C0); stage_rc((wid * 64 + fresh_lane()) * 16 + 8192, R1, C1);
            pk.x = (S.row_off(nxt, R0) + (unsigned)C0) * 2u; pk.y = (S.row_off(nxt, R1) + (unsigned)C1) * 2u; pk.z = (S.row_off(nxt, HALF + R0) + (unsigned)C0) * 2u; pk.w = (S.row_off(nxt, HALF + R1) + (unsigned)C1) * 2u; }
        *park = pk;
    }
    for (;;) {
#ifndef KREP
#define KREP 1
#endif
        for (int pass_ = 0; pass_ < KREP; ++pass_) {
        if (KREP > 1 && pass_ > 0) {
#pragma unroll
            for (int a = 0; a < 2; ++a)
#pragma unroll
                for (int b = 0; b < 2; ++b)
#pragma unroll
                    for (int m = 0; m < 4; ++m)
#pragma unroll
                        for (int n = 0; n < 2; ++n) acc[a][b][m][n] = (f32x4){0.f, 0.f, 0.f, 0.f}; }
#pragma unroll 1
        for (int t = 0; t < nt; t += 2) {
            const bool lastk = (t == nt - 2), last = lastk && (pass_ == KREP - 1);
            const size_t k1 = (size_t)(t + 1) * kstep, k2 = lastk ? (size_t)0 : (size_t)(t + 2) * kstep, k3 = k2 + kstep;
            if (last && has_next) S.a_ready(nxt);
            if constexpr (Sched::GATHER) { if (t == 2 && pass_ == KREP - 1 && has_next) { Unit n2;
                    if (S.next(ui + 2, n2) && wid < 4) { const char* src = (const char*)S.idx_src(n2) + wid * 256; unsigned off = (unsigned)fresh_lane() * 4u; asm volatile("" : "+s"(src), "+v"(off));
                        __builtin_amdgcn_global_load_lds((const unsigned*)(src + off), (PG8_LAS unsigned*)(lds + STAGE_BYTES + 512 + 1024) + wid * 64, 4, 0, 0); } } }
            if constexpr (Epi::MIDK) { if (t == Epi::MIDT && pass_ == KREP - 1) { const int el = fresh_lane(); E.mid(acc, cur, wr, wc, el & 15, el >> 4); } }
            PG8_LDB(B0, 0, 0); PG8_LDB(B1, 0, 1); PG8_SCHED; PG8_LDA(At, 0, 0); PG8_STA(PG8_SA(1, 1), 1, k1, false);
            if constexpr (Sched::GATHER) { if (last) { const u32x4 pk = *park; cG0[0] = pk.x; cG0[1] = pk.y; cG1[0] = pk.z; cG1[1] = pk.w; } }
            PG8_WAIT_V(8); PG8_WAIT_L(0); PG8_BAR; PG8_MMA(0, 0, At, B0); PG8_MMA(0, 1, At, B1); PG8_BAR; PG8_SCHED;
            PG8_LDA(At, 0, 1); PG8_STB(PG8_SB(0, 0), 0, k2, last); PG8_STB(PG8_SB(0, 1), 1, k2, last); PG8_STA(PG8_SA(0, 0), 0, k2, last);
            PG8_WAIT_V(8); PG8_WAIT_L(0); PG8_BAR; PG8_MMA(1, 0, At, B0); PG8_MMA(1, 1, At, B1); PG8_BAR; PG8_SCHED;
            PG8_LDB(B0, 1, 0); PG8_LDB(B1, 1, 1); PG8_SCHED; PG8_LDA(At, 1, 0); PG8_STA(PG8_SA(0, 1), 1, k2, last);
            PG8_WAIT_V(8); PG8_WAIT_L(0); PG8_BAR; PG8_MMA(0, 0, At, B0); PG8_MMA(0, 1, At, B1); PG8_BAR; PG8_SCHED;
            PG8_LDA(At, 1, 1); PG8_STB(PG8_SB(1, 0), 0, k3, last); PG8_STB(PG8_SB(1, 1), 1, k3, last); PG8_STA(PG8_SA(1, 0), 0, k3, last);
            PG8_WAIT_V(8); PG8_WAIT_L(0); PG8_BAR; PG8_MMA(1, 0, At, B0); PG8_MMA(1, 1, At, B1); PG8_BAR; PG8_SCHED;
        }
        }
        Unit nn; const bool has_nn = has_next && S.next(ui + 2, nn);
        u32x4 pkn = {0u, 0u, 0u, 0u};
        if constexpr (ALIGN_EPI) { if (wr == 0) PG8_BAR; }
#ifndef EREP
#define EREP 1
#endif
        { const int el = fresh_lane(); E(acc, cur, wr, wc, el & 15, el >> 4); }
        if constexpr (EREP > 1 && Epi::IDEMPOTENT) { asm volatile("s_waitcnt vmcnt(0)" ::: "memory"); const int el = fresh_lane(); E(acc, cur, wr, wc, el & 15, el >> 4); }
        S.done(cur);
        if (!has_next) break;
#pragma unroll
        for (int a = 0; a < 2; ++a)
#pragma unroll
            for (int b = 0; b < 2; ++b)
#pragma unroll
                for (int m = 0; m < 4; ++m)
#pragma unroll
                    for (int n = 0; n < 2; ++n) acc[a][b][m][n] = (f32x4){0.f, 0.f, 0.f, 0.f};
        cur = nxt; cA = nA; cB = nB; ++ui;
        nxt = nn; has_next = has_nn;
        if constexpr (!Sched::GATHER) nA = has_next ? (const char*)g.A + (size_t)nxt.pm * tstepA : cA;
        nB = has_next ? (const char*)g.Bt + (size_t)nxt.e * g.b_estride * 2 + (size_t)nxt.pn * tstepB : cB;
        if constexpr (Sched::GATHER) { int R0, C0, R1, C1; stage_rc((wid * 64 + fresh_lane()) * 16, R0, C0); stage_rc((wid * 64 + fresh_lane()) * 16 + 8192, R1, C1);
            const int nvm = (has_nn ? nn.nv : 1) - 1;
            const int q0 = R0 < nvm ? R0 : nvm, q1 = R1 < nvm ? R1 : nvm, q2 = HALF + R0 < nvm ? HALF + R0 : nvm, q3 = HALF + R1 < nvm ? HALF + R1 : nvm;
            pkn.x = (S.row_fin(gidx[q0]) + (unsigned)C0) * 2u; pkn.y = (S.row_fin(gidx[q1]) + (unsigned)C1) * 2u; pkn.z = (S.row_fin(gidx[q2]) + (unsigned)C0) * 2u; pkn.w = (S.row_fin(gidx[q3]) + (unsigned)C1) * 2u;
            if (!has_next) { pkn.x = cG0[0]; pkn.y = cG0[1]; pkn.z = cG1[0]; pkn.w = cG1[1]; } *park = pkn; }
        if constexpr (ALIGN_EPI) { if (wr == 1) PG8_BAR; }
    }
    PG8_WAIT_V(0);
    if constexpr (!ALIGN_EPI) { if (wr == 0) PG8_BAR; }
    PG8_BAR;
#undef PG8_SA
#undef PG8_SB
#undef PG8_DMA
#undef PG8_STA
#undef PG8_STB
#undef PG8_LDA
#undef PG8_LDB
#undef PG8_MMA
#undef PG8_CAT
#undef PG8_WAIT_V
#undef PG8_WAIT_L
#undef PG8_BAR
#undef PG8_SCHED
}
}
namespace attn_body {
using bf16=__hip_bfloat16;
using bf16x8=__attribute__((ext_vector_type(8)))short;
using s16x4=__attribute__((ext_vector_type(4)))short;
using f32x16=__attribute__((ext_vector_type(16)))float;
using u32x4=__attribute__((ext_vector_type(4)))unsigned;
constexpr int SEQ=2048,D=64,DM=512;
constexpr int NW=8,QBLK=32,QB=QBLK*NW,KVBLK=64,NQB=SEQ/QB;
constexpr int ATTN_PITCH=DM, ATTN_UNIT_ROWS=QB;
__device__ __forceinline__ int crow(int r,int hi){return (r&3)+8*(r>>2)+4*hi;}
#define SBAR() __builtin_amdgcn_sched_barrier(0)
__device__ __forceinline__ void cmask(f32x16&p0,f32x16&p1,int jb,int qrel,int hi){
  const float NEG=-INFINITY; int kb=64*jb+4*hi;
  #pragma unroll
  for(int r=0;r<16;++r){int kv=kb+(r&3)+8*(r>>2); if(kv>qrel)p0[r]=NEG; if(kv+32>qrel)p1[r]=NEG;}
}

constexpr int NSLOT=3, SLOTB=8192;
constexpr int LDS_K=0, LDS_V=NSLOT*SLOTB, LDS_WS=2*NSLOT*SLOTB, LDS_OST=LDS_WS+NW*64*4, LDS_BYTES=LDS_OST+NW*4096;
constexpr float C2=0.125f*1.4426950408889634f;
__device__ __forceinline__ void glds16(const void*gsrc,unsigned lds_dst){unsigned keep;
  asm volatile("s_mov_b32 %0, m0\n\ts_mov_b32 m0, %2\n\ts_nop 0\n\tglobal_load_lds_dwordx4 %1, off\n\ts_mov_b32 m0, %0":"=&s"(keep):"v"(gsrc),"s"(lds_dst):"memory");}
__device__ __forceinline__ float max3f(float a,float b,float c){float r;asm("v_max3_f32 %0, %1, %2, %3":"=v"(r):"v"(a),"v"(b),"v"(c));return r;}
__device__ __forceinline__ float max2f(float a,float b){float r;asm("v_max_f32_e32 %0, %1, %2":"=v"(r):"v"(a),"v"(b));return r;}
__device__ __forceinline__ float fadd_s(float a,float b){float r;asm("v_add_f32_e32 %0, %1, %2":"=v"(r):"v"(a),"v"(b));return r;}
__device__ __forceinline__ float fsub_s(float a,float b){float r;asm("v_sub_f32_e32 %0, %1, %2":"=v"(r):"v"(a),"v"(b));return r;}
typedef float f32x2_t __attribute__((ext_vector_type(2))); typedef __bf16 bf16x2_t __attribute__((ext_vector_type(2)));
__device__ __forceinline__ unsigned cvtpk_s(float lo,float hi){f32x2_t v={lo,hi};bf16x2_t b=__builtin_convertvector(v,bf16x2_t);return __builtin_bit_cast(unsigned,b);}
#define WAIT_BAR(N) asm volatile("s_waitcnt vmcnt(" #N ") lgkmcnt(0)\n\ts_barrier":::"memory")

__device__ __forceinline__ void qkt(f32x16&p0,f32x16&p1,const char*Kslot,const bf16x8*qr,const f32x16&negm,int r32,int hi){
  const char*kb=Kslot+hi*1024+r32*16;
  #pragma unroll
  for(int d0=0;d0<4;++d0){
    const bf16x8 b0=*reinterpret_cast<const bf16x8*>(kb+d0*2048);
    const bf16x8 b1=*reinterpret_cast<const bf16x8*>(kb+d0*2048+512);
    if(d0==0){p0=__builtin_amdgcn_mfma_f32_32x32x16_bf16(b0,qr[0],negm,0,0,0);p1=__builtin_amdgcn_mfma_f32_32x32x16_bf16(b1,qr[0],negm,0,0,0);}
    else{p0=__builtin_amdgcn_mfma_f32_32x32x16_bf16(b0,qr[d0],p0,0,0,0);p1=__builtin_amdgcn_mfma_f32_32x32x16_bf16(b1,qr[d0],p1,0,0,0);}}
}
typedef __attribute__((address_space(3))) const char* lds_cptr;
typedef short v4i16_t __attribute__((ext_vector_type(4)));
__device__ __forceinline__ void kload8(bf16x8*kf,lds_cptr kp){
  kf[0]=*(const __attribute__((address_space(3))) bf16x8*)(kp);      kf[1]=*(const __attribute__((address_space(3))) bf16x8*)(kp+512);
  kf[2]=*(const __attribute__((address_space(3))) bf16x8*)(kp+2048); kf[3]=*(const __attribute__((address_space(3))) bf16x8*)(kp+2560);
  kf[4]=*(const __attribute__((address_space(3))) bf16x8*)(kp+4096); kf[5]=*(const __attribute__((address_space(3))) bf16x8*)(kp+4608);
  kf[6]=*(const __attribute__((address_space(3))) bf16x8*)(kp+6144); kf[7]=*(const __attribute__((address_space(3))) bf16x8*)(kp+6656);
}
__device__ __forceinline__ void kload2(bf16x8*kf,lds_cptr kp,int j){ kf[2*j]=*(const __attribute__((address_space(3))) bf16x8*)(kp+j*2048); kf[2*j+1]=*(const __attribute__((address_space(3))) bf16x8*)(kp+j*2048+512); }
__device__ __forceinline__ s16x4 vtr(lds_cptr p){ return __builtin_bit_cast(s16x4,__builtin_amdgcn_ds_read_tr16_b64_v4i16((__attribute__((address_space(3))) v4i16_t*)p)); }
__device__ __forceinline__ float rowmax(const f32x16&p0,const f32x16&p1){
  float a=max3f(p0[0],p0[1],p1[0]),b=max3f(p0[2],p0[3],p1[1]);a=max3f(a,p1[2],p1[3]);
  #pragma unroll
  for(int r=4;r<16;r+=4){a=max3f(a,p0[r],p0[r+1]);b=max3f(b,p0[r+2],p0[r+3]);a=max3f(a,p1[r],p1[r+1]);b=max3f(b,p1[r+2],p1[r+3]);}
  const float m=max2f(a,b);
  auto rr=__builtin_amdgcn_permlane32_swap(__float_as_uint(m),__float_as_uint(m),false,false);
  return max2f(__uint_as_float(rr[0]),__uint_as_float(rr[1]));
}
__device__ __forceinline__ void pv(f32x16*o,int vb,bf16x8 pa0,bf16x8 pa1,bf16x8 pa2,bf16x8 pa3){
  #pragma unroll
  for(int d0=0;d0<2;++d0){s16x4 lo[4],hi[4];
    #pragma unroll
    for(int ks=0;ks<4;++ks){
      asm volatile("ds_read_b64_tr_b16 %0,%1 offset:%c2":"=&v"(lo[ks]):"v"(vb),"i"(d0*4096+ks*1024):"memory");
      asm volatile("ds_read_b64_tr_b16 %0,%1 offset:%c2":"=&v"(hi[ks]):"v"(vb),"i"(d0*4096+ks*1024+512):"memory");}
    asm volatile("s_waitcnt lgkmcnt(0)":::"memory");SBAR();
    #define PK(k) (bf16x8){lo[k][0],lo[k][1],lo[k][2],lo[k][3],hi[k][0],hi[k][1],hi[k][2],hi[k][3]}
    o[d0]=__builtin_amdgcn_mfma_f32_32x32x16_bf16(pa0,PK(0),o[d0],0,0,0);
    o[d0]=__builtin_amdgcn_mfma_f32_32x32x16_bf16(pa1,PK(1),o[d0],0,0,0);
    o[d0]=__builtin_amdgcn_mfma_f32_32x32x16_bf16(pa2,PK(2),o[d0],0,0,0);
    o[d0]=__builtin_amdgcn_mfma_f32_32x32x16_bf16(pa3,PK(3),o[d0],0,0,0);
    #undef PK
  }
}

#ifndef ATTN_STORE16
#define ATTN_STORE16(p,v) (*(u32x4*)(p)=(v))
#endif
template<int THRL> __device__ __forceinline__ void attn_unit(bool pre,bool has_nx,int nb,int nqkc,int nqb,bf16x8(&qr)[4],int wid_s,int b,int qkc,int voc,int qb,const bf16*Q,const bf16*__restrict__ K,const bf16*__restrict__ V,bf16*O,char*shm){
  const int wid=wid_s,lane=fresh_lane(),tid=wid*64+lane,r32=lane&31,hi=lane>>5;
  const long rowbase=(long)b*SEQ; const int q0=qb*QB;
  const bf16*Qw=Q+(rowbase+q0+wid*QBLK)*DM+qkc;
  const bf16*Kh=K+rowbase*DM+qkc,*Vh=V+rowbase*DM+voc;
  const unsigned lds0=(unsigned)(uintptr_t)shm;
  float*wsf=(float*)(shm+LDS_WS)+wid*64;
  const bf16*ksrc=Kh+(long)lane*DM+wid*8;
  const bf16*vsrc=Vh+(long)(16*(wid&3)+(lane>>2))*DM+(wid>>2)*32+(lane&3)*8;
  const unsigned kdst=lds0+LDS_K+wid*1024, vdst=lds0+LDS_V+wid*1024;
  #define DMA_K(t,slot) glds16(ksrc+(long)(t)*KVBLK*DM,(unsigned)__builtin_amdgcn_readfirstlane(kdst+(slot)))
  #define DMA_V(t,slot) glds16(vsrc+(long)(t)*KVBLK*DM,(unsigned)__builtin_amdgcn_readfirstlane(vdst+(slot)))
  const int vb0=(int)(lds0+LDS_V)+((lane>>4)&1)*32+(lane&3)*8+(4*hi+((lane&15)>>2))*64;
  const char*Kbase=shm+LDS_K; bf16x8 kf[8];
  const lds_cptr shm3=(lds_cptr)shm; const lds_cptr kp0=shm3+LDS_K+hi*1024+r32*16; const lds_cptr vp0=shm3+LDS_V+((lane>>4)&1)*32+(lane&3)*8+(4*hi+((lane&15)>>2))*64;
  const int NT=(q0+QB)/KVBLK;
  if(!pre){DMA_K(0,0);} DMA_V(0,0); if(!pre){DMA_K(1,SLOTB);}
  #pragma unroll
  for(int d0=0;d0<4;++d0){ if(!pre)qr[d0]=*reinterpret_cast<const bf16x8*>(&Qw[(long)r32*DM+d0*16+hi*8]); }
  float mhat=0.f,l_reg=0.f;f32x16 o[2];o[0]=f32x16{};o[1]=f32x16{};f32x16 negm=f32x16{};asm volatile("":"+v"(negm));
  const int qrel=wid*QBLK+r32;
  #define CMASK(P0,P1,t) do{int jb_=(t)-(NT-4); if(jb_>=0)cmask(P0,P1,jb_,qrel,hi);}while(0)
  bool resc=false;
  #define START(P0,P1) do{ const float rm=rowmax(P0,P1); resc=false; \
    { const float dl=rm; mhat=fadd_s(mhat,dl); \
      _Pragma("unroll") for(int r=0;r<16;++r){P0[r]=fsub_s(P0[r],dl);P1[r]=fsub_s(P1[r],dl);} \
      _Pragma("unroll") for(int r=0;r<16;++r)negm[r]=-mhat; asm volatile("":"+v"(negm)); } \
    _Pragma("unroll") for(int r=0;r<16;++r)P0[r]=__builtin_amdgcn_exp2f(P0[r]); }while(0)
  #define RESC() do{ if(resc){ asm volatile("s_waitcnt lgkmcnt(0)":::"memory"); \
      _Pragma("unroll") for(int d_=0;d_<2;++d_) _Pragma("unroll") for(int r=0;r<16;++r)o[d_][r]*=wsf[crow(r,hi)]; } }while(0)
  f32x16 pA0,pA1,pB0,pB1;
  int sl_prev=0,sl_cur=0,sl_next=SLOTB;
  #define ROT() do{sl_prev=sl_cur;sl_cur=sl_next;sl_next=(sl_next==(NSLOT-1)*SLOTB)?0:sl_next+SLOTB;}while(0)
  if(!pre){ DMA_K(2,2*SLOTB); WAIT_BAR(3); } else { WAIT_BAR(1); }
  qkt(pA0,pA1,Kbase,qr,negm,r32,hi);asm volatile("s_nop 15\n\ts_nop 7":"+v"(pA0),"+v"(pA1));CMASK(pA0,pA1,0);
  START(pA0,pA1);
  _Pragma("unroll") for(int r=0;r<16;++r)pA1[r]=__builtin_amdgcn_exp2f(pA1[r]);
  WAIT_BAR(0);
  DMA_K(3,0);DMA_V(1,SLOTB);
  ROT();
  kload8(kf,kp0+sl_cur);
  WAIT_BAR(2);
  s16x4 vlo[8],vhi[8]; u32x4 pw0,pw1,pw2,pw3;
  #define PKW(P,B) cvtpk_s(P[B],P[B+1])
  #define PAF(k) __builtin_bit_cast(bf16x8,pw##k)
  #define VFR(i) (bf16x8){vlo[i][0],vlo[i][1],vlo[i][2],vlo[i][3],vhi[i][0],vhi[i][1],vhi[i][2],vhi[i][3]}
  #define PIN(x) asm volatile("":"+v"(x))
  #define MX3(a,b,c) __builtin_fmaxf(__builtin_fmaxf((a),(b)),(c))
  #define GAPA(MF,A0,A1,A2,A3,W0,W1,PW) do{ MF; sacc+=A0; sacc+=A1; sacc+=A2; sacc+=A3; PIN(sacc); W0; W1; PIN(PW); SBAR(); }while(0)
  #define EX(v) __builtin_amdgcn_exp2f(v)
  #define GAPB(MF,X,B) do{ MF; X[B]=EX(X[B]); X[B+1]=EX(X[B+1]); X[B+2]=EX(X[B+2]); X[B+3]=EX(X[B+3]); PIN(X); SBAR(); }while(0)
  #define VRD(i) do{ vlo[i]=vtr(vp_+(((i)>>2)*4096+((i)&3)*1024)); vhi[i]=vtr(vp_+(((i)>>2)*4096+((i)&3)*1024+512)); }while(0)
  #define KRD(G,j) do{ if(G){ kload2(kf,kp0+sl_next,j); SBAR(); } }while(0)
  #define STEP(C0,C1,P0,P1,t,GK,GV,GL) do{ SBAR(); \
    const lds_cptr vp_=vp0+sl_prev; \
    VRD(0); SBAR(); float sacc=(P0[0]+P0[1]); \
    GAPA(C0=__builtin_amdgcn_mfma_f32_32x32x16_bf16(kf[0],qr[0],negm,0,0,0), P0[2],P0[3],P0[4],P0[5],     pw0[0]=PKW(P0,0), pw0[1]=PKW(P0,2), pw0); \
    VRD(4); SBAR(); GAPA(C1=__builtin_amdgcn_mfma_f32_32x32x16_bf16(kf[1],qr[0],negm,0,0,0), P0[6],P0[7],P0[8],P0[9],     pw0[2]=PKW(P0,4), pw0[3]=PKW(P0,6), pw0); \
    VRD(1); SBAR(); GAPA(C0=__builtin_amdgcn_mfma_f32_32x32x16_bf16(kf[2],qr[1],C0,0,0,0),   P0[10],P0[11],P0[12],P0[13], pw1[0]=PKW(P0,8), pw1[1]=PKW(P0,10), pw1); \
    VRD(5); SBAR(); GAPA(C1=__builtin_amdgcn_mfma_f32_32x32x16_bf16(kf[3],qr[1],C1,0,0,0),   P0[14],P0[15],P1[0],P1[1],   pw1[2]=PKW(P0,12),pw1[3]=PKW(P0,14), pw1); \
    VRD(2); SBAR(); GAPA(C0=__builtin_amdgcn_mfma_f32_32x32x16_bf16(kf[4],qr[2],C0,0,0,0),   P1[2],P1[3],P1[4],P1[5],     pw2[0]=PKW(P1,0), pw2[1]=PKW(P1,2), pw2); \
    VRD(6); SBAR(); GAPA(C1=__builtin_amdgcn_mfma_f32_32x32x16_bf16(kf[5],qr[2],C1,0,0,0),   P1[6],P1[7],P1[8],P1[9],     pw2[2]=PKW(P1,4), pw2[3]=PKW(P1,6), pw2); \
    VRD(3); SBAR(); GAPA(C0=__builtin_amdgcn_mfma_f32_32x32x16_bf16(kf[6],qr[3],C0,0,0,0),   P1[10],P1[11],P1[12],P1[13], pw3[0]=PKW(P1,8), pw3[1]=PKW(P1,10), pw3); \
    VRD(7); SBAR(); GAPA(C1=__builtin_amdgcn_mfma_f32_32x32x16_bf16(kf[7],qr[3],C1,0,0,0),   P1[14],P1[15],0.f,0.f,       pw3[2]=PKW(P1,12),pw3[3]=PKW(P1,14), pw3); \
    l_reg+=sacc; \
    if(GK){DMA_K((t)+3,sl_cur);} if(GV){DMA_V((t)+1,sl_next);} \
    CMASK(C0,C1,t); \
    { float a=MX3(C0[0],C0[1],C1[0]),b=MX3(C0[2],C0[3],C1[1]); a=MX3(a,C1[2],C1[3]); \
      _Pragma("unroll") for(int r=4;r<16;r+=4){a=MX3(a,C0[r],C0[r+1]);b=MX3(b,C0[r+2],C0[r+3]);a=MX3(a,C1[r],C1[r+1]);b=MX3(b,C1[r+2],C1[r+3]);} \
      float rm=__builtin_fmaxf(a,b); { auto rr=__builtin_amdgcn_permlane32_swap(__float_as_uint(rm),__float_as_uint(rm),false,false); rm=__builtin_fmaxf(__uint_as_float(rr[0]),__uint_as_float(rr[1])); } \
      resc=false; \
      if(__builtin_expect(__any(rm>(float)THRL),0)){ const float dl=__builtin_fmaxf(rm,0.f); mhat+=dl; \
        _Pragma("unroll") for(int r=0;r<16;++r){C0[r]-=dl;C1[r]-=dl;} \
        _Pragma("unroll") for(int r=0;r<16;++r)negm[r]=-mhat; asm volatile("":"+v"(negm)); \
        const float f=__builtin_amdgcn_exp2f(-dl); l_reg*=f; if(hi==0)wsf[r32]=f; resc=true; } } \
    SBAR(); \
    GAPB(o[0]=__builtin_amdgcn_mfma_f32_32x32x16_bf16(PAF(0),VFR(0),o[0],0,0,0), C0,0); \
    GAPB(o[1]=__builtin_amdgcn_mfma_f32_32x32x16_bf16(PAF(0),VFR(4),o[1],0,0,0), C0,4); \
    KRD(GL,0); GAPB(o[0]=__builtin_amdgcn_mfma_f32_32x32x16_bf16(PAF(1),VFR(1),o[0],0,0,0), C0,8); \
    KRD(GL,1); GAPB(o[1]=__builtin_amdgcn_mfma_f32_32x32x16_bf16(PAF(1),VFR(5),o[1],0,0,0), C0,12); \
    KRD(GL,2); GAPB(o[0]=__builtin_amdgcn_mfma_f32_32x32x16_bf16(PAF(2),VFR(2),o[0],0,0,0), C1,0); \
    KRD(GL,3); GAPB(o[1]=__builtin_amdgcn_mfma_f32_32x32x16_bf16(PAF(2),VFR(6),o[1],0,0,0), C1,4); \
    GAPB(o[0]=__builtin_amdgcn_mfma_f32_32x32x16_bf16(PAF(3),VFR(3),o[0],0,0,0), C1,8); \
    GAPB(o[1]=__builtin_amdgcn_mfma_f32_32x32x16_bf16(PAF(3),VFR(7),o[1],0,0,0), C1,12); \
    }while(0)
  int t=1;
  #undef CMASK
  #define CMASK(P0,P1,t) do{}while(0)
  for(;t+5<NT;t+=2){
    STEP(pB0,pB1,pA0,pA1,t,true,true,true);     WAIT_BAR(2); RESC(); ROT();
    STEP(pA0,pA1,pB0,pB1,t+1,true,true,true);   WAIT_BAR(2); RESC(); ROT();
  }
  #undef CMASK
  #define CMASK(P0,P1,t) do{int jb_=(t)-(NT-4); if(jb_>=0)cmask(P0,P1,jb_,qrel,hi);}while(0)
  #define ENDW(tt) do{ if((tt)+3<NT){WAIT_BAR(2);} else if((tt)+2<NT){WAIT_BAR(1);} else {WAIT_BAR(0);} }while(0)
  for(;t+1<NT;t+=2){
    STEP(pB0,pB1,pA0,pA1,t,(t+3<NT),(t+1<NT),(t+1<NT));       ENDW(t);   RESC(); ROT();
    STEP(pA0,pA1,pB0,pB1,t+1,(t+4<NT),(t+2<NT),(t+2<NT));     ENDW(t+1); RESC(); ROT();
  }
  STEP(pB0,pB1,pA0,pA1,NT-1,false,false,false); RESC();
  if(has_nx){ const bf16*kn=ksrc+((long)(nb-b)*SEQ*DM+(nqkc-qkc));
    glds16(kn,(unsigned)__builtin_amdgcn_readfirstlane(kdst)); glds16(kn+(long)KVBLK*DM,(unsigned)__builtin_amdgcn_readfirstlane(kdst+SLOTB)); glds16(kn+(long)2*KVBLK*DM,(unsigned)__builtin_amdgcn_readfirstlane(kdst+2*SLOTB));
    const bf16*Qn=Q+((long)nb*SEQ+nqb*QB+wid*QBLK)*DM+nqkc; const int ln_=fresh_lane(); const unsigned qo_=(unsigned)((ln_&31)*DM+(ln_>>5)*8);
    #pragma unroll
    for(int d0=0;d0<4;++d0)qr[d0]=*reinterpret_cast<const bf16x8*>(&Qn[qo_+d0*16]); }
  { float sacc=pB0[0]+pB0[1]; _Pragma("unroll") for(int r=2;r<16;++r)sacc+=pB0[r]; _Pragma("unroll") for(int r=0;r<16;++r)sacc+=pB1[r]; l_reg+=sacc;
    pw0=(u32x4){PKW(pB0,0),PKW(pB0,2),PKW(pB0,4),PKW(pB0,6)};pw1=(u32x4){PKW(pB0,8),PKW(pB0,10),PKW(pB0,12),PKW(pB0,14)};pw2=(u32x4){PKW(pB1,0),PKW(pB1,2),PKW(pB1,4),PKW(pB1,6)};pw3=(u32x4){PKW(pB1,8),PKW(pB1,10),PKW(pB1,12),PKW(pB1,14)};
    SBAR(); pv(o,vb0+sl_cur,PAF(0),PAF(1),PAF(2),PAF(3)); }
  #undef PKW
  #undef PAF
  #undef VFR
  #undef PIN
  #undef MX3
  #undef GAPA
  #undef GAPB
  #undef EX
  #undef VRD
  #undef KRD
  #undef STEP
  #undef ENDW
  {auto rr=__builtin_amdgcn_permlane32_swap(__float_as_uint(l_reg),__float_as_uint(l_reg),false,false);l_reg=__uint_as_float(rr[0])+__uint_as_float(rr[1]);}
  if(hi==0)wsf[32+r32]=l_reg;asm volatile("s_waitcnt lgkmcnt(0)":::"memory");
  float rli[16];
  #pragma unroll
  for(int r=0;r<16;++r)rli[r]=__builtin_amdgcn_rcpf(wsf[32+crow(r,hi)]);
  bf16*Ow=O+(rowbase+q0+wid*QBLK)*DM+voc;
  { bf16*stg=(bf16*)(shm+LDS_OST)+wid*2048;
    #pragma unroll
    for(int r=0;r<16;++r){const int orow=crow(r,hi);
      #pragma unroll
      for(int d0=0;d0<2;++d0)stg[orow*64+d0*32+r32]=__float2bfloat16(o[d0][r]*rli[r]);}
    asm volatile("s_waitcnt lgkmcnt(0)":::"memory");
    #pragma unroll
    for(int i=0;i<4;++i){const int row=i*8+(lane>>3),ch=lane&7; const u32x4 v=*(const u32x4*)(stg+row*64+ch*8); ATTN_STORE16(Ow+(long)row*DM+ch*8,v);} }
  asm volatile("s_waitcnt lgkmcnt(0)\n\ts_barrier":::"memory");
  #undef DMA_K
  #undef DMA_V
  #undef CMASK
  #undef START
  #undef RESC
  #undef ROT
}
constexpr int ATTN_LDS_BYTES=LDS_BYTES;
struct AttnPtrs { const bf16* Q; const bf16* K; const bf16* V; bf16* O1; bf16* O2; };
template<int THRL> __device__ __forceinline__ void attn_phase(char*lds,const AttnPtrs&T,int G,int vcu,int wid_s){
  #define ATTN_UNIT_OF(i,combo,qb,ok) do{ if(G==256){ ok=(i)<8; const int j=vcu&31; combo=(vcu&~31)+(j>>3)*8+(i); qb=((j&7)+(i))&7; } else { const int U=(i)*G+vcu; ok=U<2048; combo=U>>3; qb=7-(U&7); } }while(0)
  bf16x8 qr[4]={}; bool pre=false;
  for(int i=0;;++i){
    int combo,qb,ncombo,nqb; bool ok,nok; ATTN_UNIT_OF(i,combo,qb,ok); if(!ok)break; ATTN_UNIT_OF(i+1,ncombo,nqb,nok);
    const int vh=combo&1, c=(combo>>1)&1, h=(combo>>2)&3, b=combo>>4, nc=(ncombo>>1)&1, nh=(ncombo>>2)&3, nb=ncombo>>4;
    attn_unit<THRL>(pre,nok,nb,(2*nh+nc)*64,nqb,qr,wid_s,b,(2*h+c)*64,h*128+vh*64,qb,T.Q,T.K,T.V,c?T.O2:T.O1,lds);
    pre=nok;
  }
  #undef ATTN_UNIT_OF
}
#undef SBAR
#undef WAIT_BAR
}

#define GAS __attribute__((address_space(1)))
#define LAS __attribute__((address_space(3)))
typedef unsigned v4u __attribute__((ext_vector_type(4)));
typedef GAS unsigned gu32;
typedef GAS unsigned long long gu64;
#define RLX_AGENT __ATOMIC_RELAXED, __HIP_MEMORY_SCOPE_AGENT
#define LDS_WAIT() asm volatile("s_waitcnt lgkmcnt(0)" ::: "memory")
#define VM_WAIT() asm volatile("s_waitcnt vmcnt(0)" ::: "memory")
__device__ __forceinline__ unsigned long long rt() { return __builtin_amdgcn_s_memrealtime(); }

#define XB_TMO      128
#define XB_XCNT(j)  (256  + 64 * (j))
#define XB_XSUB(j)  (1280 + 64 * (j))
#define XB_XGEN(j)  (2304 + 64 * (j))
#define XB_TOP      3328
#define XB_TOPGEN   3392
#define XCD_BAR_WORDS 3456
#define XB_SPIN_CAP (1u << 18)

__device__ __forceinline__ unsigned xb_ld(unsigned* p)              { return __hip_atomic_load(p, __ATOMIC_RELAXED, __HIP_MEMORY_SCOPE_AGENT); }
__device__ __forceinline__ unsigned xb_add(unsigned* p, unsigned v) { return __hip_atomic_fetch_add(p, v, __ATOMIC_RELAXED, __HIP_MEMORY_SCOPE_AGENT); }
__device__ __forceinline__ unsigned xb_xcc_id() { return (unsigned)__builtin_amdgcn_s_getreg((3 << 11) | 20) & 0xFu; }
#define XB_SPIN(cond, bar) do { unsigned _sp = 0; while (cond) { __builtin_amdgcn_s_sleep(1); \
    if ((++_sp & 255u) == 0u) { if (xb_ld(&(bar)[XB_TMO])) break; if (_sp > XB_SPIN_CAP) { atomicAdd(&(bar)[XB_TMO], 1u); break; } } } } while (0)

struct XcdBarrier {
    int w;
    unsigned* bar; unsigned x;
    volatile LAS unsigned* st;
};

__device__ __forceinline__ XcdBarrier xcd_barrier_post(unsigned* bar, volatile LAS unsigned* st, int wave_s) {
    XcdBarrier b; b.w = wave_s; b.bar = bar; b.x = xb_xcc_id(); b.st = st;
    if (wave_s == 0 && fresh_lane() == 0) (void)xb_add(&bar[XB_XCNT(b.x)], 1u);
    return b;
}
__device__ __forceinline__ void xcd_barrier_complete(unsigned* bar, unsigned x, unsigned& nloc, unsigned& nx) {
    const unsigned G = gridDim.x * gridDim.y * gridDim.z;
    unsigned sum, cnt, mine, sp = 0u;
    for (;;) {
        sum = 0u; cnt = 0u; mine = 0u;
#pragma unroll
        for (unsigned j = 0; j < 16; ++j) { const unsigned c = xb_ld(&bar[XB_XCNT(j)]); sum += c; cnt += (c > 0u) ? 1u : 0u; mine = (j == x) ? c : mine; }
        if (sum == G) break;
        __builtin_amdgcn_s_sleep(1);
        if ((++sp & 255u) == 0u) { if (xb_ld(&bar[XB_TMO])) break; if (sp > XB_SPIN_CAP) { atomicAdd(&bar[XB_TMO], 1u); break; } }
    }
    nloc = mine > 0u ? mine : 1u; nx = cnt > 0u ? cnt : 1u;
}

__device__ __forceinline__ void xcd_barrier(const XcdBarrier& b) {
    asm volatile("s_waitcnt vmcnt(0)" ::: "memory");
    __syncthreads();
    if (b.w == 0 && fresh_lane() == 0) {
        unsigned* bar = b.bar;
        __builtin_amdgcn_s_waitcnt(0);
        unsigned nloc = b.st[0], nx = b.st[1];
        if (nloc == 0u) { xcd_barrier_complete(bar, b.x, nloc, nx); b.st[0] = nloc; b.st[1] = nx; }
        const unsigned old = xb_add(&bar[XB_XSUB(b.x)], 1u);
        const unsigned gen = old / nloc;
        if (old + 1u == (gen + 1u) * nloc) {
            __builtin_amdgcn_fence(__ATOMIC_RELEASE, "agent");
            asm volatile("s_waitcnt vmcnt(0)" ::: "memory");
            const unsigned og = xb_add(&bar[XB_TOP], 1u);
            const unsigned tg = og / nx;
            if (og + 1u == (tg + 1u) * nx) xb_add(&bar[XB_TOPGEN], 1u);
            else XB_SPIN(xb_ld(&bar[XB_TOPGEN]) == tg, bar);
            __builtin_amdgcn_fence(__ATOMIC_ACQUIRE, "agent");
            xb_add(&bar[XB_XGEN(b.x)], 1u);
            asm volatile("s_waitcnt vmcnt(0)" ::: "memory");
        } else {
            XB_SPIN(xb_ld(&bar[XB_XGEN(b.x)]) == gen, bar);
            __builtin_amdgcn_fence(__ATOMIC_ACQUIRE, "agent");
            asm volatile("s_waitcnt vmcnt(0)" ::: "memory");
        }
    }
    __syncthreads();
}

constexpr int NWAVES = 8;
constexpr int RING_OFF = 0, RING_BYTES = 131072;
constexpr int LDSCTL_OFF = RING_BYTES, MISC_OFF = LDSCTL_OFF + 320;
constexpr int RCTL_OFF = LDSCTL_OFF + 512;
constexpr int MOE_OFF = LDSCTL_OFF + 5120;
constexpr int CONV_OFF = LDSCTL_OFF + 6144;
constexpr int LDS_BYTES = 147456;
constexpr int CW_TMO = 0, CW_CODE = 1, CW_BAR = 4096;
constexpr int NPHASE = 12;
constexpr unsigned SKEW_P1 = 0u, SKEW_P7 = 0u, SKEW_P8 = 0u, SKEW_P4 = 0u, SKEW_P5 = 0u, SKEW_P10 = 0u;

struct Frame {
    LAS unsigned char* lds; volatile LAS unsigned* MISC; gu32* ctl;
    int wave, vcu, G;
    int local_ok;
};

template <int MODE> __device__ __forceinline__ int dst_row(int n) {
    if (MODE == 1) {
        if (n < 1536 || n >= 2560) return n;
        const int j = n - 1536; return j < 512 ? (6 + (j >> 7)) * 256 + (j & 127) : (6 + ((j - 512) >> 7)) * 256 + 128 + ((j - 512) & 127);
    } else if (MODE == 2) {
        const int j = n >> 1; return (j >> 7) * 256 + (n & 1) * 128 + (j & 127);
    }
    return n;
}
template <int MODE> __device__ __forceinline__ void p0_transpose_item(const float* __restrict__ W, int K, int N, bf16_t* __restrict__ WT, LAS float* scr, int item, int lane, int ldk = 0, int koff = 0) {
    if (ldk == 0) ldk = K;
    const int nblk = N / 32, kb = item / nblk, nb = item % nblk, k0 = 64 * kb, n0 = 32 * nb;
#pragma unroll 8
    for (int i = 0; i < 32; ++i) { const int kk = 2 * i + (lane >> 5); scr[kk * 33 + (lane & 31)] = W[(size_t)(k0 + kk) * N + n0 + (lane & 31)]; }
    LDS_WAIT(); asm volatile("" ::: "memory");
    const int c = lane & 7;
#pragma unroll
    for (int j = 0; j < 4; ++j) { const int n = (lane >> 3) + 8 * j; const LAS float* s = scr + (8 * c) * 33 + n;
        v4u o; o.x = pk2(s[0 * 33], s[1 * 33]); o.y = pk2(s[2 * 33], s[3 * 33]); o.z = pk2(s[4 * 33], s[5 * 33]); o.w = pk2(s[6 * 33], s[7 * 33]);
        *(GAS v4u*)(WT + (size_t)dst_row<MODE>(n0 + n) * ldk + koff + k0 + 8 * c) = o; }
    LDS_WAIT(); asm volatile("" ::: "memory");
}
template <int MODE> __device__ __forceinline__ void p0_transpose_item_fp8(const float* __restrict__ W, int K, int N, unsigned char* __restrict__ WT, LAS float* scr, int item, int lane, float S_W8, int ldk, int koff) {
    const int nblk = N / 32, kb = item / nblk, nb = item % nblk, k0 = 64 * kb, n0 = 32 * nb;
#pragma unroll 8
    for (int i = 0; i < 32; ++i) { const int kk = 2 * i + (lane >> 5); scr[kk * 33 + (lane & 31)] = W[(size_t)(k0 + kk) * N + n0 + (lane & 31)]; }
    LDS_WAIT(); asm volatile("" ::: "memory");
    const int c = lane & 3;
#pragma unroll
    for (int j = 0; j < 2; ++j) { const int n = (lane >> 2) + 16 * j; const LAS float* s = scr + (16 * c) * 33 + n;
        v4u o; o.x = pk4_fp8(s[0 * 33] * S_W8, s[1 * 33] * S_W8, s[2 * 33] * S_W8, s[3 * 33] * S_W8); o.y = pk4_fp8(s[4 * 33] * S_W8, s[5 * 33] * S_W8, s[6 * 33] * S_W8, s[7 * 33] * S_W8);
        o.z = pk4_fp8(s[8 * 33] * S_W8, s[9 * 33] * S_W8, s[10 * 33] * S_W8, s[11 * 33] * S_W8); o.w = pk4_fp8(s[12 * 33] * S_W8, s[13 * 33] * S_W8, s[14 * 33] * S_W8, s[15 * 33] * S_W8);
        *(GAS v4u*)(WT + (size_t)dst_row<MODE>(n0 + n) * ldk + koff + k0 + 16 * c) = o; }
    LDS_WAIT(); asm volatile("" ::: "memory");
}
struct MoeWTile { const float* W; unsigned char* WT; int K, N, k0, n0, mode; };
__device__ __forceinline__ MoeWTile moe_w_tile(int ti, const float* w_gu, const float* w_dn, unsigned char* Wgu_t, unsigned char* Wdn_t) {
    const int e = ti / 96, r = ti % 96; MoeWTile t;
    if (r < 64) { t.W = w_gu + (size_t)e * D * 2 * FF; t.WT = Wgu_t + (size_t)e * 2 * FF * D; t.K = D; t.N = 2 * FF; t.k0 = 64 * (r >> 2); t.n0 = 512 * (r & 3); t.mode = 2; }
    else { const int q = r - 64; t.W = w_dn + (size_t)e * FF * D; t.WT = Wdn_t + (size_t)e * D * FF; t.K = FF; t.N = D; t.k0 = 64 * (q >> 1); t.n0 = 512 * (q & 1); t.mode = 0; }
    return t;
}
struct P0Args { const float *x, *p, *g_mix, *w_in, *w_ao, *w_co, *w_o, *w_pg, *w_ple, *w_gu, *w_dn; bf16_t *Win_t, *Wao_t, *Wco_t, *Wo_t, *Wpg_t, *Wple_t; unsigned char *Wgu_t, *Wdn_t; bf16_t *XN, *PP; };
__device__ __forceinline__ void p0_prologue(Frame& F, const P0Args& a) {
    LAS float* scr = (LAS float*)(F.lds + RING_OFF + F.wave * 16384);
    const int lane = fresh_lane(), tid = F.wave * 64 + lane;
    const int gw = F.vcu * NWAVES + F.wave, NGW = F.G * NWAVES;
    constexpr int I_IN = (D / 64) * (INC / 32), I_AO = (AW / 64) * (D / 32), I_O = (D / 64) * (D / 32), I_PLE = (PLE / 64) * (D / 32), I_GU = (D / 64) * (2 * FF / 32), I_DN = (FF / 64) * (D / 32);
    constexpr int NSMALL = I_IN + 2 * I_AO + 2 * I_O + I_PLE;
    { LAS float* tile = (LAS float*)(F.lds + RING_OFF); constexpr int PITCH = 513, NT = NE * 96;
      const int t = tid, kr = t >> 7, n4 = (t & 127) * 4, nl = t >> 2, c = t & 3;
      f32x4 r[16]; int ti = blockIdx.x;
      if (ti < NT) { const MoeWTile w = moe_w_tile(ti, a.w_gu, a.w_dn, a.Wgu_t, a.Wdn_t);
#pragma unroll
          for (int i = 0; i < 16; ++i) r[i] = *(const f32x4*)(w.W + (size_t)(w.k0 + 4 * i + kr) * w.N + w.n0 + n4); }
      for (; ti < NT; ti += F.G) {
          const MoeWTile w = moe_w_tile(ti, a.w_gu, a.w_dn, a.Wgu_t, a.Wdn_t);
#pragma unroll
          for (int i = 0; i < 16; ++i) { LAS float* p = tile + (4 * i + kr) * PITCH + n4; p[0] = r[i][0]; p[1] = r[i][1]; p[2] = r[i][2]; p[3] = r[i][3]; }
          __syncthreads();
          if (ti + F.G < NT) { const MoeWTile wn = moe_w_tile(ti + F.G, a.w_gu, a.w_dn, a.Wgu_t, a.Wdn_t);
#pragma unroll
              for (int i = 0; i < 16; ++i) r[i] = *(const f32x4*)(wn.W + (size_t)(wn.k0 + 4 * i + kr) * wn.N + wn.n0 + n4); }
#pragma unroll
          for (int q = 0; q < 4; ++q) { const int n = nl + 128 * q; const LAS float* s = tile + (16 * c) * PITCH + n; v4u o;
              o.x = pk4_fp8(s[0 * PITCH] * S_W8, s[1 * PITCH] * S_W8, s[2 * PITCH] * S_W8, s[3 * PITCH] * S_W8); o.y = pk4_fp8(s[4 * PITCH] * S_W8, s[5 * PITCH] * S_W8, s[6 * PITCH] * S_W8, s[7 * PITCH] * S_W8);
              o.z = pk4_fp8(s[8 * PITCH] * S_W8, s[9 * PITCH] * S_W8, s[10 * PITCH] * S_W8, s[11 * PITCH] * S_W8); o.w = pk4_fp8(s[12 * PITCH] * S_W8, s[13 * PITCH] * S_W8, s[14 * PITCH] * S_W8, s[15 * PITCH] * S_W8);
              const int ns = w.n0 + n, dr = w.mode == 2 ? dst_row<2>(ns) : ns;
              *(GAS v4u*)(w.WT + (size_t)dr * w.K + w.k0 + 16 * c) = o; }
          __syncthreads();
      } }
    for (int it = gw; it < NSMALL; it += NGW) {
        int r = it;
        if (r < I_IN) { p0_transpose_item<1>(a.w_in, D, INC, a.Win_t, scr, r, lane); continue; } r -= I_IN;
        if (r < I_AO) { p0_transpose_item<0>(a.w_ao, AW, D, a.Wao_t, scr, r, lane, D, 0); continue; } r -= I_AO;
        if (r < I_AO) { p0_transpose_item<0>(a.w_co, CW, D, a.Wao_t, scr, r, lane, D, AW); continue; } r -= I_AO;
        if (r < I_O) { p0_transpose_item<0>(a.w_o, D, D, a.Wo_t, scr, r, lane); continue; } r -= I_O;
        if (r < I_O) { p0_transpose_item_fp8<0>(a.w_pg, D, D, (unsigned char*)a.Wpg_t, scr, r, lane, S_W8, UCW, PLE); continue; } r -= I_O;
        p0_transpose_item_fp8<0>(a.w_ple, PLE, D, (unsigned char*)a.Wpg_t, scr, r, lane, S_WPLE, UCW, 0);
    }
    { f32x4 gq[4];
#pragma unroll
      for (int j = 0; j < 4; ++j) gq[j] = ((const f32x4*)a.g_mix)[lane + 64 * j];
      f32x4 v[4], pv, vn[4], pn; int m = gw;
      if (m < M) { const f32x4* xr = (const f32x4*)(a.x + (size_t)m * D) + lane;
#pragma unroll
          for (int j = 0; j < 4; ++j) vn[j] = xr[64 * j];
          pn = ((const f32x4*)(a.p + (size_t)m * PLE))[lane]; }
      for (; m < M; m += NGW) {
#pragma unroll
          for (int j = 0; j < 4; ++j) v[j] = vn[j];
          pv = pn;
          if (m + NGW < M) { const f32x4* xr = (const f32x4*)(a.x + (size_t)(m + NGW) * D) + lane;
#pragma unroll
              for (int j = 0; j < 4; ++j) vn[j] = xr[64 * j];
              pn = ((const f32x4*)(a.p + (size_t)(m + NGW) * PLE))[lane]; }
          float s = 0.f;
#pragma unroll
          for (int j = 0; j < 4; ++j) s += v[j].x * v[j].x + v[j].y * v[j].y + v[j].z * v[j].z + v[j].w * v[j].w;
          const float rstd = rsqrtf(wave_sum(s) * (1.f / D) + EPS);
          u32x2* o8 = (u32x2*)(a.XN + (size_t)m * D) + lane;
#pragma unroll
          for (int j = 0; j < 4; ++j) { u32x2 w; w.x = pk2(v[j].x * rstd * gq[j].x, v[j].y * rstd * gq[j].y); w.y = pk2(v[j].z * rstd * gq[j].z, v[j].w * rstd * gq[j].w); o8[64 * j] = w; }
          ((unsigned*)((unsigned char*)a.PP + (size_t)m * UCW))[lane] = pk4_fp8(pv.x * S_P, pv.y * S_P, pv.z * S_P, pv.w * S_P);
      } }
}

template <int N> __device__ __forceinline__ void foldn(float (&v)[32], bool up, int mask) {
#pragma unroll
    for (int i = 0; i < N / 2; ++i) { const float mine = up ? v[i + N / 2] : v[i], other = up ? v[i] : v[i + N / 2]; v[i] = mine + __shfl_xor(other, mask); }
}
struct P3Args { const bf16_t *O1, *O2, *Z; const float *lq1, *lk1, *lq2, *lk2, *g_subln, *w_dw, *b_dw, *g_ln, *b_ln; bf16_t* AC; };
__device__ __forceinline__ void p3_combine_conv(Frame& F, const P3Args& a) {
    const int lane = fresh_lane(), wave = F.wave;
    const float lam = __expf(wave_sum(a.lq1[lane] * a.lk1[lane])) - __expf(wave_sum(a.lq2[lane] * a.lk2[lane])) + LAM_INIT;
    const int cg = wave & 3, th = wave >> 2, ch0 = cg * 128 + 2 * lane;
    f32x2 wk[KC];
#pragma unroll
    for (int k = 0; k < KC; ++k) wk[k] = *(const f32x2*)(a.w_dw + k * CW + ch0);
    const f32x2 bdw = *(const f32x2*)(a.b_dw + ch0), gl = *(const f32x2*)(a.g_ln + ch0), bl = *(const f32x2*)(a.b_ln + ch0);
    LAS float* part = (LAS float*)(F.lds + CONV_OFF);
    for (int chn = F.vcu; chn < M / 128; chn += F.G) {
        { const int c0 = lane * 8; const f32x4 g0 = *(const f32x4*)(a.g_subln + (c0 & 127)), g1 = *(const f32x4*)(a.g_subln + (c0 & 127) + 4);
          for (int q = 0; q < 16; q += 4) { const int m0 = chn * 128 + wave * 16 + q; u32x4 x1[4], x2[4];
#pragma unroll
            for (int u = 0; u < 4; ++u) { x1[u] = *(const u32x4*)(a.O1 + (size_t)(m0 + u) * AW + c0); x2[u] = *(const u32x4*)(a.O2 + (size_t)(m0 + u) * AW + c0); }
#pragma unroll
            for (int u = 0; u < 4; ++u) { float d[8]; float ss = 0.f;
#pragma unroll
                for (int i = 0; i < 4; ++i) { const unsigned ua = x1[u][i], ub = x2[u][i];
                    d[2 * i] = __uint_as_float(ua << 16) - lam * __uint_as_float(ub << 16); d[2 * i + 1] = __uint_as_float(ua & 0xffff0000u) - lam * __uint_as_float(ub & 0xffff0000u);
                    ss += d[2 * i] * d[2 * i] + d[2 * i + 1] * d[2 * i + 1]; }
                ss += __shfl_xor(ss, 1); ss += __shfl_xor(ss, 2); ss += __shfl_xor(ss, 4); ss += __shfl_xor(ss, 8);
                const float rstd = rsqrtf(ss * (1.f / 128.f) + EPS) * (1.f - LAM_INIT); u32x4 w;
                w.x = pk2(d[0] * rstd * g0.x, d[1] * rstd * g0.y); w.y = pk2(d[2] * rstd * g0.z, d[3] * rstd * g0.w); w.z = pk2(d[4] * rstd * g1.x, d[5] * rstd * g1.y); w.w = pk2(d[6] * rstd * g1.z, d[7] * rstd * g1.w);
                *(u32x4*)(a.AC + (size_t)(m0 + u) * D + c0) = w; } } }
        { const int ts = chn * 128 + th * 64, tseq = ts % SEQ;
          f32x2 zr[16 + KC - 1];
#pragma unroll
          for (int i = 0; i < 16 + KC - 1; ++i) { const bool ok = (tseq - (KC - 1) + i) >= 0; const unsigned v = ok ? *(const unsigned*)(a.Z + (size_t)(ts - (KC - 1) + i) * CW + ch0) : 0u; zr[i] = (f32x2){__uint_as_float(v << 16), __uint_as_float(v & 0xffff0000u)}; }
#pragma unroll 1
          for (int blk = 0; blk < 4; ++blk) {
            const int tok0 = ts + blk * 16;
            unsigned zn[16];
#pragma unroll
            for (int i = 0; i < 16; ++i) zn[i] = *(const unsigned*)(a.Z + (size_t)(blk < 3 ? tok0 + 16 + i : tok0) * CW + ch0);
            f32x2 y[16];
#pragma unroll
            for (int o = 0; o < 16; ++o) { f32x2 s = bdw;
#pragma unroll
                for (int k = 0; k < KC; ++k) s = wk[k] * zr[o + k] + s;
                y[o] = s; }
            float st[32];
#pragma unroll
            for (int o = 0; o < 16; ++o) { const f32x2 q = y[o] * y[o]; st[2 * o] = y[o].x + y[o].y; st[2 * o + 1] = q.x + q.y; }
            foldn<32>(st, lane & 32, 32); foldn<16>(st, lane & 16, 16); foldn<8>(st, lane & 8, 8); foldn<4>(st, lane & 4, 4); foldn<2>(st, lane & 2, 2);
            const float tot = st[0] + __shfl_xor(st[0], 1);
            LAS float* pb = part + (blk & 1) * 256 + th * 128;
            if ((lane & 1) == 0) pb[cg * 32 + (lane >> 1)] = tot;
            __syncthreads();
            float mean_l = 0.f, rstd_l = 0.f;
            if (lane < 16) { const float s1 = pb[2 * lane] + pb[32 + 2 * lane] + pb[64 + 2 * lane] + pb[96 + 2 * lane], s2 = pb[2 * lane + 1] + pb[32 + 2 * lane + 1] + pb[64 + 2 * lane + 1] + pb[96 + 2 * lane + 1];
                mean_l = s1 * (1.f / CW); const float var = fmaxf(s2 * (1.f / CW) - mean_l * mean_l, 0.f); rstd_l = rsqrtf(var + EPS); }
#pragma unroll
            for (int o = 0; o < 16; ++o) { const float mu = __builtin_bit_cast(float, __builtin_amdgcn_readlane(__builtin_bit_cast(int, mean_l), o)), rs = __builtin_bit_cast(float, __builtin_amdgcn_readlane(__builtin_bit_cast(int, rstd_l), o));
                f32x2 v = (y[o] - mu) * rs * gl + bl; v.x = v.x * pg8::fsig(v.x); v.y = v.y * pg8::fsig(v.y);
                *(unsigned*)(a.AC + (size_t)(tok0 + o) * D + AW + ch0) = pk2(v.x, v.y); }
#pragma unroll
            for (int i = 0; i < KC - 1; ++i) zr[i] = zr[i + 16];
#pragma unroll
            for (int i = 0; i < 16; ++i) zr[KC - 1 + i] = (f32x2){__uint_as_float(zn[i] << 16), __uint_as_float(zn[i] & 0xffff0000u)};
          } }
        __syncthreads();
    }
}

struct P6Args { const bf16_t* H; const float *g_ffn, *w_router, *b_router; unsigned char* U2;     int* topk_e; float* topk_g; int* list; unsigned* gcnt; };
__device__ __forceinline__ void p6_ins(unsigned long long (&v)[4], unsigned long long x) {
    const bool c0 = x > v[0], c1 = x > v[1], c2 = x > v[2], c3 = x > v[3];
    v[3] = c2 ? v[2] : (c3 ? x : v[3]); v[2] = c1 ? v[1] : (c2 ? x : v[2]); v[1] = c0 ? v[0] : (c1 ? x : v[1]); v[0] = c0 ? x : v[0];
}
__device__ __forceinline__ float p6_sumsq(unsigned w, float s) { const float lo = __uint_as_float(w << 16), hi = __uint_as_float(w & 0xffff0000u); return s + lo * lo + hi * hi; }
__device__ __forceinline__ void p6_router(Frame& F, const P6Args& a) {
    LAS unsigned* wT = (LAS unsigned*)(F.lds + RING_OFF); LAS int* lcnt = (LAS int*)(F.lds + RCTL_OFF); LAS int* lbase = lcnt + 32; LAS int* sl_e = lbase + 32; LAS int* sl_r = sl_e + 512; LAS float* sl_g = (LAS float*)(F.lds + CONV_OFF);
    const int lane = fresh_lane(), wave = F.wave, tid = wave * 64 + lane;
    for (int it = tid; it < (D / 2) * 8; it += 512) { const int k2 = it >> 3, c4 = it & 7; const float g0 = a.g_ffn[2 * k2], g1 = a.g_ffn[2 * k2 + 1];
        const f32x4 v0 = ((const f32x4*)a.w_router)[(2 * k2) * 8 + c4] * g0, v1 = ((const f32x4*)a.w_router)[(2 * k2 + 1) * 8 + c4] * g1;
#pragma unroll
        for (int i = 0; i < 4; ++i) { const int e = c4 * 4 + i; const unsigned h0 = f2bf(v0[i]), h1 = f2bf(v1[i]); const float r0 = v0[i] - __uint_as_float(h0 << 16), r1 = v1[i] - __uint_as_float(h1 << 16);
            const int w = e * (D / 2) + (k2 ^ (4 * (e & 15))); wT[w] = h0 | (h1 << 16); wT[NE * D / 2 + w] = f2bf(r0) | (f2bf(r1) << 16); } }
    if (tid < 32) lcnt[tid] = 0;
    __syncthreads();
    const int fr = lane & 15, fg = lane >> 4;
    f32x4 gg[4];
#pragma unroll
    for (int j = 0; j < 4; ++j) gg[j] = ((const f32x4*)a.g_ffn)[lane + 64 * j] * S_U2;
    const f32x4 bA = *(const f32x4*)(a.b_router + 4 * fg), bB = *(const f32x4*)(a.b_router + 16 + 4 * fg);
    for (int chn = F.vcu; chn < M / 128; chn += F.G) {
        const int t0 = chn * 128, tw = t0 + wave * 16;
        const bf16_t* hp = a.H + (size_t)(tw + fr) * D + fg * 8;
        const LAS unsigned* wp = wT + fr * (D / 2); const int sw = 4 * fr;
        f32x4 acc[2][2]; acc[0][0] = acc[0][1] = acc[1][0] = acc[1][1] = (f32x4){0.f, 0.f, 0.f, 0.f}; float ss = 0.f;
        u32x4 hv[8];
#pragma unroll
        for (int u = 0; u < 8; ++u) hv[u] = *(const u32x4*)(hp + 32 * u);
#pragma unroll 1
        for (int sb = 0; sb < 32; sb += 8) {
#pragma unroll
            for (int u = 0; u < 8; ++u) { const int s = sb + u; const u32x4 h = hv[u];
                if (sb + 8 < 32) hv[u] = *(const u32x4*)(hp + 32 * (s + 8));
                const int wo = (16 * s + 4 * fg) ^ sw;
                const pg8::bf16x8 w00 = *(const LAS pg8::bf16x8*)(wp + wo), w01 = *(const LAS pg8::bf16x8*)(wp + NE * D / 2 + wo), w10 = *(const LAS pg8::bf16x8*)(wp + 16 * (D / 2) + wo), w11 = *(const LAS pg8::bf16x8*)(wp + NE * D / 2 + 16 * (D / 2) + wo);
                ss = p6_sumsq(h.x, ss); ss = p6_sumsq(h.y, ss); ss = p6_sumsq(h.z, ss); ss = p6_sumsq(h.w, ss);
                const pg8::bf16x8 hb = __builtin_bit_cast(pg8::bf16x8, h);
                acc[0][0] = __builtin_amdgcn_mfma_f32_16x16x32_bf16(w00, hb, acc[0][0], 0, 0, 0); acc[0][1] = __builtin_amdgcn_mfma_f32_16x16x32_bf16(w01, hb, acc[0][1], 0, 0, 0);
                acc[1][0] = __builtin_amdgcn_mfma_f32_16x16x32_bf16(w10, hb, acc[1][0], 0, 0, 0); acc[1][1] = __builtin_amdgcn_mfma_f32_16x16x32_bf16(w11, hb, acc[1][1], 0, 0, 0); }
        }
        ss += __shfl_xor(ss, 16); ss += __shfl_xor(ss, 32);
        const float rn = rsqrtf(ss * (1.f / D) + EPS);
        unsigned long long v[4] = {0ull, 0ull, 0ull, 0ull};
#pragma unroll
        for (int blk = 0; blk < 2; ++blk)
#pragma unroll
            for (int i = 0; i < 4; ++i) { const float lg = (acc[blk][0][i] + acc[blk][1][i]) * rn + (blk ? bB[i] : bA[i]); const int e = 16 * blk + 4 * fg + i;
                unsigned ub = __float_as_uint(lg); ub = (ub & 0x80000000u) ? ~ub : (ub | 0x80000000u);
                p6_ins(v, ((unsigned long long)ub << 32) | (unsigned)(31 - e)); }
#pragma unroll
        for (int o = 16; o <= 32; o <<= 1) { unsigned long long p[4];
#pragma unroll
            for (int q = 0; q < 4; ++q) { const unsigned lo = __shfl_xor((unsigned)v[q], o), hi = __shfl_xor((unsigned)(v[q] >> 32), o); p[q] = ((unsigned long long)hi << 32) | lo; }
#pragma unroll
            for (int q = 0; q < 4; ++q) p6_ins(v, p[q]); }
        float tv[4];
#pragma unroll
        for (int q = 0; q < 4; ++q) { unsigned vb = (unsigned)(v[q] >> 32); vb = (vb & 0x80000000u) ? (vb & 0x7fffffffu) : ~vb; tv[q] = __uint_as_float(vb); }
        const float e1 = __expf(tv[1] - tv[0]), e2 = __expf(tv[2] - tv[0]), e3 = __expf(tv[3] - tv[0]), inv = 1.f / (1.f + e1 + e2 + e3);
        { const unsigned long long kk = fg == 0 ? v[0] : fg == 1 ? v[1] : fg == 2 ? v[2] : v[3]; const int e = 31 - (int)((unsigned)kk & 63u); const float gv = (fg == 0 ? 1.f : fg == 1 ? e1 : fg == 2 ? e2 : e3) * inv;
            const int m = tw + fr, sl = (wave * 16 + fr) * 4 + fg;
            a.topk_e[m * 4 + fg] = e; a.topk_g[m * 4 + fg] = gv;
            const int r = __hip_atomic_fetch_add(lcnt + e, 1, __ATOMIC_RELAXED, __HIP_MEMORY_SCOPE_WORKGROUP); sl_e[sl] = e; sl_r[sl] = r; sl_g[sl] = gv; }
#pragma unroll 1
        for (int hb8 = 0; hb8 < 16; hb8 += 8) { u32x2 raw[8][4];
#pragma unroll
            for (int q = 0; q < 8; ++q)
#pragma unroll
                for (int j = 0; j < 4; ++j) raw[q][j] = ((const u32x2*)(a.H + (size_t)(tw + hb8 + q) * D))[lane + 64 * j];
#pragma unroll
            for (int q = 0; q < 8; ++q) { const float rq = __int_as_float(__builtin_amdgcn_readlane(__float_as_int(rn), hb8 + q));
#pragma unroll
                for (int j = 0; j < 4; ++j) { const f32x4 sc = gg[j] * rq; const u32x2 w = raw[q][j];
                    ((unsigned*)(a.U2 + (size_t)(tw + hb8 + q) * D))[lane + 64 * j] = pk4_fp8(__uint_as_float(w.x << 16) * sc.x, __uint_as_float(w.x & 0xffff0000u) * sc.y, __uint_as_float(w.y << 16) * sc.z, __uint_as_float(w.y & 0xffff0000u) * sc.w); } } }
        __syncthreads();
        if (tid < 32) lbase[tid] = (int)__hip_atomic_fetch_add(a.gcnt + tid, (unsigned)lcnt[tid], __ATOMIC_RELAXED, __HIP_MEMORY_SCOPE_AGENT);
        __syncthreads();
        { const int e = sl_e[tid], pos = lbase[e] + sl_r[tid]; a.list[e * LIST_CAP + pos] = t0 * 4 + tid; ((float*)((char*)a.list + GLIST_DELTA))[e * LIST_CAP + pos] = sl_g[tid]; }
        __syncthreads();
        if (tid < 32) lcnt[tid] = 0;
        __syncthreads();
    }
}
__device__ __forceinline__ void moe_tables(Frame& F, const unsigned* gcnt) {
    LAS int* pmb = (LAS int*)(F.lds + MOE_OFF); LAS int* cnt = pmb + 64; LAS int* tu = pmb + 128; LAS unsigned short* ent = (LAS unsigned short*)(F.lds + CONV_OFF);
    const int tid = F.wave * 64 + fresh_lane();
    if (tid == 0) { int acc = 0; for (int e = 0; e < NE; ++e) { const int c = (int)__hip_atomic_load(gcnt + e, __ATOMIC_RELAXED, __HIP_MEMORY_SCOPE_AGENT); pmb[e] = acc; cnt[e] = c; acc += (c + 255) >> 8; } pmb[NE] = acc; tu[0] = acc; }
    __syncthreads();
    const int TU = tu[0];
    for (int mt = tid; mt < TU; mt += NWAVES * 64) { int e = 0;
#pragma unroll 1
        for (int k = 1; k < NE; ++k) if (pmb[k] <= mt) e = k;
        ent[mt] = (unsigned short)(e | ((mt - pmb[e]) << 5)); }
    __syncthreads();
}

__device__ __forceinline__ void p9_moe_combine(Frame& F, bf16_t* __restrict__ H, const unsigned char* __restrict__ Y, const float* __restrict__ g, unsigned char* __restrict__ U3) {
    const int NGW_ = F.G * NWAVES, own = (M % NGW_ == 0), gw = (F.vcu * NWAVES + F.wave) * (own ? M / NGW_ : 1), NGW = own ? 1 : NGW_, MEND = own ? gw + M / NGW_ : M, lane = fresh_lane(); constexpr float isy = 1.f / S_Y;
    f32x4 gg[4];
#pragma unroll
    for (int j = 0; j < 4; ++j) gg[j] = *(const f32x4*)(g + 16 * lane + 4 * j);
    u32x4 nh0 = {0u, 0u, 0u, 0u}, nh1 = nh0, ny[TOPK];
#pragma unroll
    for (int k = 0; k < TOPK; ++k) ny[k] = nh0;
    if (gw < MEND) { const u32x4* hr = (const u32x4*)(H + (size_t)gw * D + 16 * lane); nh0 = hr[0]; nh1 = hr[1];
#pragma unroll
        for (int k = 0; k < TOPK; ++k) ny[k] = *(const u32x4*)(Y + ((size_t)gw * TOPK + k) * D + 16 * lane); }
    for (int m = gw; m < MEND; m += NGW) {
        u32x4* hr = (u32x4*)(H + (size_t)m * D + 16 * lane); const u32x4 h0 = nh0, h1 = nh1; u32x4 y[TOPK];
#pragma unroll
        for (int k = 0; k < TOPK; ++k) y[k] = ny[k];
        if (m + NGW < MEND) { const u32x4* hn = (const u32x4*)(H + (size_t)(m + NGW) * D + 16 * lane); nh0 = hn[0]; nh1 = hn[1];
#pragma unroll
            for (int k = 0; k < TOPK; ++k) ny[k] = *(const u32x4*)(Y + ((size_t)(m + NGW) * TOPK + k) * D + 16 * lane); }
        f32x4 v[4]; pg8::unpack8(h0, v[0], v[1]); pg8::unpack8(h1, v[2], v[3]);
#pragma unroll
        for (int k = 0; k < TOPK; ++k)
#pragma unroll
            for (int j = 0; j < 4; ++j) { float a, b, c, d; unpk4_fp8(y[k][j], a, b, c, d); v[j][0] += a * isy; v[j][1] += b * isy; v[j][2] += c * isy; v[j][3] += d * isy; }
        hr[0] = pg8::pack8(v[0], v[1]); hr[1] = pg8::pack8(v[2], v[3]);
        float s = 0.f;
#pragma unroll
        for (int j = 0; j < 4; ++j) s += v[j][0] * v[j][0] + v[j][1] * v[j][1] + v[j][2] * v[j][2] + v[j][3] * v[j][3];
        const float rstd = rsqrtf(wave_sum(s) * (1.f / D) + EPS);
        u32x4 o;
#pragma unroll
        for (int j = 0; j < 4; ++j) { const f32x4 t = v[j] * (rstd * S_U2) * gg[j]; o[j] = pk4_fp8(t[0], t[1], t[2], t[3]); }
        *(u32x4*)(U3 + (size_t)m * UCW + PLE + 16 * lane) = o;
    }
}
__device__ __forceinline__ void p11_final(Frame& F, const bf16_t* __restrict__ H, const float* __restrict__ g, float* __restrict__ O) {
    const int NGW_ = F.G * NWAVES, own = (M % NGW_ == 0), gw = (F.vcu * NWAVES + F.wave) * (own ? M / NGW_ : 1), NGW = own ? 1 : NGW_, MEND = own ? gw + M / NGW_ : M, lane = fresh_lane();
    f32x4 gg[4];
#pragma unroll
    for (int j = 0; j < 4; ++j) gg[j] = *(const f32x4*)(g + 16 * lane + 4 * j);
    u32x4 n0a = {0u, 0u, 0u, 0u}, n0b = n0a, n1a = n0a, n1b = n0a;
    if (gw < MEND) { const u32x4* hr = (const u32x4*)(H + (size_t)gw * D + 16 * lane); n0a = hr[0]; n0b = hr[1]; }
    if (gw + NGW < MEND) { const u32x4* hr = (const u32x4*)(H + (size_t)(gw + NGW) * D + 16 * lane); n1a = hr[0]; n1b = hr[1]; }
    for (int m = gw; m < MEND; m += NGW) {
        const u32x4 ca = n0a, cb = n0b; n0a = n1a; n0b = n1b;
        if (m + 2 * NGW < MEND) { const u32x4* hn = (const u32x4*)(H + (size_t)(m + 2 * NGW) * D + 16 * lane); n1a = hn[0]; n1b = hn[1]; }
        f32x4 v[4]; pg8::unpack8(ca, v[0], v[1]); pg8::unpack8(cb, v[2], v[3]);
        float s = 0.f;
#pragma unroll
        for (int j = 0; j < 4; ++j) s += v[j][0] * v[j][0] + v[j][1] * v[j][1] + v[j][2] * v[j][2] + v[j][3] * v[j][3];
        const float rstd = rsqrtf(wave_sum(s) * (1.f / D) + EPS);
        f32x4* o = (f32x4*)(O + (size_t)m * D + 16 * lane);
#pragma unroll
        for (int j = 0; j < 4; ++j) o[j] = v[j] * rstd * gg[j];
    }
}

__device__ __forceinline__ void xcd_barrier_local(const XcdBarrier& b) {
    asm volatile("s_waitcnt vmcnt(0)" ::: "memory");
    __syncthreads();
    if (b.w == 0 && fresh_lane() == 0) {
        unsigned* bar = b.bar;
        __builtin_amdgcn_s_waitcnt(0);
        const unsigned nloc = b.st[0];
        const unsigned old = xb_add(&bar[XB_XSUB(b.x)], 1u), gen = old / nloc;
        if (old + 1u == (gen + 1u) * nloc) xb_add(&bar[XB_XGEN(b.x)], 1u);
        else XB_SPIN(xb_ld(&bar[XB_XGEN(b.x)]) == gen, bar);
        __builtin_amdgcn_fence(__ATOMIC_ACQUIRE, "agent");
        asm volatile("s_waitcnt vmcnt(0)" ::: "memory");
    }
    __syncthreads();
}
struct Args { const float* in[27]; float* out; unsigned char* ws; int ph_lo, ph_hi, li, pad; };
__global__ void __launch_bounds__(NWAVES * 64, 2) mega_fwd(Args args) {
    extern __shared__ __attribute__((aligned(16))) unsigned char lds[];
    Frame F;
    F.lds = (LAS unsigned char*)lds; F.MISC = (volatile LAS unsigned*)(F.lds + MISC_OFF);
    F.wave = __builtin_amdgcn_readfirstlane((int)threadIdx.x >> 6);
    F.G = gridDim.x; { const int bx = blockIdx.x; F.vcu = (F.G % 8 == 0) ? (bx % 8) * (F.G / 8) + bx / 8 : bx; }
    F.ctl = (gu32*)(args.ws + WS_CTL);
#define PHASE_ARGS() const __attribute__((address_space(4))) Args* ap_ = (const __attribute__((address_space(4))) Args*)__builtin_amdgcn_kernarg_segment_ptr(); asm volatile("" : "+s"(ap_)); unsigned char* const ws = ap_->ws
#define INP(i) (ap_->in[i])
#define WSP(T_, off) ((T_*)(ws + (off)))
    for (int u = F.wave * 64 + fresh_lane(); u < (LDS_BYTES - LDSCTL_OFF) / 4; u += NWAVES * 64) ((LAS unsigned*)(F.lds + LDSCTL_OFF))[u] = 0u;
    __syncthreads();
    XcdBarrier bar = xcd_barrier_post((unsigned*)(F.ctl + CW_BAR) + args.li * XCD_BAR_WORDS, F.MISC + 8, F.wave);
    if (F.wave == 0 && fresh_lane() == 0 && (bar.x != (unsigned)blockIdx.x % 8u || gridDim.x != 256u)) (void)__hip_atomic_fetch_or((unsigned*)(F.ctl + CW_MODE), 1u, __ATOMIC_RELAXED, __HIP_MEMORY_SCOPE_AGENT);
    F.local_ok = 0;
    const int lo = args.ph_lo, hi = args.ph_hi;
#ifndef PH_COMPILED
#define PH_COMPILED 0xFFF
#endif
#define IN(k) ((((PH_COMPILED) >> (k)) & 1) && lo <= (k) && (k) < hi)
#ifndef DUP_MASK
#define DUP_MASK 0
#endif
#define REPS(k) ((((DUP_MASK) >> (k)) & 1) + 1)
#ifndef LOCAL_SEAMS
#define LOCAL_SEAMS 0x6BE
#endif
#define SEAM(k) do { if (IN(k) && IN((k) + 1)) { if ((((LOCAL_SEAMS) >> (k)) & 1) && F.local_ok) xcd_barrier_local(bar); else xcd_barrier(bar); \
        if ((k) == 0) F.local_ok = __builtin_amdgcn_readfirstlane((int)(__hip_atomic_load((unsigned*)(F.ctl + CW_MODE), __ATOMIC_RELAXED, __HIP_MEMORY_SCOPE_AGENT) == 0u)); } } while (0)

    for (int r_ = 0; r_ < REPS(0); ++r_) { if (r_) xcd_barrier(bar);
    if (IN(0)) { PHASE_ARGS(); const P0Args a{INP(0), INP(1), INP(2), INP(3), INP(9), INP(14), INP(15), INP(25), INP(23), INP(19), INP(21),
            WSP(bf16_t, WS_WIN), WSP(bf16_t, WS_WSM), WSP(bf16_t, WS_WSM + 1 * MiB), WSP(bf16_t, WS_WSM + 2 * MiB), WSP(bf16_t, WS_WSM + 4 * MiB), WSP(bf16_t, WS_WSM + 6 * MiB), WSP(unsigned char, WS_WGU), WSP(unsigned char, WS_WDN), WSP(bf16_t, WS_XN), WSP(bf16_t, WS_UC)};
        p0_prologue(F, a); }
    }
    SEAM(0);
    for (int r_ = 0; r_ < REPS(1); ++r_) { if (r_) xcd_barrier(bar);
    if (IN(1)) { PHASE_ARGS(); const pg8::Gemm g{WSP(bf16_t, WS_XN), WSP(bf16_t, WS_WIN), D, D, 0}; pg8::InProjOrder S; S.init(M, INC, F.G, (int)blockIdx.x);
        const pg8::EpiIn E{WSP(bf16_t, WS_Q), WSP(bf16_t, WS_K), WSP(bf16_t, WS_V), WSP(bf16_t, WS_Z), WSP(bf16_t, WS_SGA), WSP(bf16_t, WS_SGB)};
        pg8::gemm_phase<pg8::EpiIn, pg8::InProjOrder, true>(F.lds + RING_OFF, F.wave, g, S, E, SKEW_P1); }
    }
    SEAM(1);
    for (int r_ = 0; r_ < REPS(2); ++r_) { if (r_) xcd_barrier(bar);
    if (IN(2)) { PHASE_ARGS(); const attn_body::AttnPtrs AT{WSP(const attn_body::bf16, WS_Q), WSP(const attn_body::bf16, WS_K), WSP(const attn_body::bf16, WS_V), WSP(attn_body::bf16, WS_O1), WSP(attn_body::bf16, WS_O2)};
        attn_body::attn_phase<8>((char*)lds + RING_OFF, AT, F.G, F.vcu, F.wave); }
    }
    SEAM(2);
    for (int r_ = 0; r_ < REPS(3); ++r_) { if (r_) xcd_barrier(bar);
    if (IN(3)) { PHASE_ARGS(); const P3Args a{WSP(bf16_t, WS_O1), WSP(bf16_t, WS_O2), WSP(bf16_t, WS_Z), INP(4), INP(5), INP(6), INP(7), INP(8), INP(10), INP(11), INP(12), INP(13), WSP(bf16_t, WS_AC)}; p3_combine_conv(F, a); }
    }
    SEAM(3);
    for (int r_ = 0; r_ < REPS(4); ++r_) { if (r_) xcd_barrier(bar);
    if (IN(4)) { PHASE_ARGS(); pg8::StaticOrder S; S.init(M, D, F.G, (int)blockIdx.x);
        const pg8::Gemm g{WSP(bf16_t, WS_AC), WSP(bf16_t, WS_WSM), D, D, 0}; const pg8::EpiMixF E{WSP(unsigned char, WS_SGA), WSP(unsigned char, WS_SGB), WSP(bf16_t, WS_M1)};
        pg8::gemm_phase<pg8::EpiMixF, pg8::StaticOrder, true>(F.lds + RING_OFF, F.wave, g, S, E, SKEW_P4); }
    }
    SEAM(4);
    for (int r_ = 0; r_ < REPS(5); ++r_) { if (r_) xcd_barrier(bar);
    if (IN(5)) { PHASE_ARGS(); const pg8::Gemm g{WSP(bf16_t, WS_M1), WSP(bf16_t, WS_WSM + 2 * MiB), D, D, 0}; pg8::StaticOrder S; S.init(M, D, F.G, (int)blockIdx.x); const pg8::EpiWo E{INP(0), WSP(bf16_t, WS_H)};
        pg8::gemm_phase<pg8::EpiWo, pg8::StaticOrder, true>(F.lds + RING_OFF, F.wave, g, S, E, SKEW_P5); }
    }
    SEAM(5);
    for (int r_ = 0; r_ < REPS(6); ++r_) { if (r_) xcd_barrier(bar);
    if (IN(6)) { PHASE_ARGS(); const P6Args a{WSP(bf16_t, WS_H), INP(16), INP(17), INP(18), WSP(unsigned char, WS_U2), WSP(int, WS_TOPK_E), WSP(float, WS_TOPK_G), WSP(int, WS_LIST), WSP(unsigned, WS_CTL) + CW_GCNT}; p6_router(F, a); }
    }
    SEAM(6);
    if (IN(7) || IN(8)) { PHASE_ARGS(); moe_tables(F, WSP(unsigned, WS_CTL) + CW_GCNT); }
    for (int r_ = 0; r_ < REPS(7); ++r_) { if (r_) xcd_barrier(bar);
    if (IN(7)) { PHASE_ARGS(); const LAS int* pmb = (const LAS int*)(F.lds + MOE_OFF); const pg8::Gemm g{WSP(bf16_t, WS_U2), WSP(bf16_t, WS_WGU), D / 2, D / 2, (size_t)2 * FF * D / 2};
        const pg8::MoeOrder<true> S{(const LAS unsigned short*)(F.lds + CONV_OFF), pmb + 64, WSP(int, WS_LIST), 8, F.G, F.vcu, __builtin_amdgcn_readfirstlane(pmb[128]), D / 2}; const pg8::EpiGateUp E{INP(20), WSP(unsigned char, WS_ACT), (LAS float*)(F.lds + RCTL_OFF)};
        pg8::gemm_phase<pg8::EpiGateUp, pg8::MoeOrder<true>, true, true>(F.lds + RING_OFF, F.wave, g, S, E, SKEW_P7); }
    }
    SEAM(7);
    for (int r_ = 0; r_ < REPS(8); ++r_) { if (r_) xcd_barrier(bar);
    if (IN(8)) { PHASE_ARGS(); const LAS int* pmb = (const LAS int*)(F.lds + MOE_OFF); const pg8::Gemm g{WSP(bf16_t, WS_ACT), WSP(bf16_t, WS_WDN), FF / 2, FF / 2, (size_t)D * FF / 2};
        const pg8::MoeOrder<false> S{(const LAS unsigned short*)(F.lds + CONV_OFF), pmb + 64, WSP(int, WS_LIST), 4, F.G, F.vcu, __builtin_amdgcn_readfirstlane(pmb[128]), FF / 2}; const pg8::EpiDown E{INP(22), WSP(int, WS_LIST), WSP(unsigned char, WS_Y), WSP(unsigned char, WS_TRASH), (LAS unsigned*)(F.lds + LDSCTL_OFF + 8192)};
        pg8::gemm_phase<pg8::EpiDown, pg8::MoeOrder<false>, true, true>(F.lds + RING_OFF, F.wave, g, S, E, SKEW_P8); }
    }
    SEAM(8);
    for (int r_ = 0; r_ < REPS(9); ++r_) { if (r_) xcd_barrier(bar);
    if (IN(9)) { PHASE_ARGS(); p9_moe_combine(F, WSP(bf16_t, WS_H), WSP(unsigned char, WS_Y), INP(24), WSP(unsigned char, WS_UC)); }
    }
    SEAM(9);
    for (int r_ = 0; r_ < REPS(10); ++r_) { if (r_) xcd_barrier(bar);
    if (IN(10)) { PHASE_ARGS(); pg8::StaticOrder S; S.init(M, D, F.G, (int)blockIdx.x);
        const pg8::Gemm g{WSP(bf16_t, WS_UC), WSP(bf16_t, WS_WSM + 4 * MiB), UCW / 2, UCW / 2, 0}; const pg8::EpiPleF E{WSP(bf16_t, WS_E1), WSP(bf16_t, WS_H)};
        pg8::gemm_phase<pg8::EpiPleF, pg8::StaticOrder, true, true>(F.lds + RING_OFF, F.wave, g, S, E, SKEW_P10); }
    }
    SEAM(10);
    for (int r_ = 0; r_ < REPS(11); ++r_) { if (r_) xcd_barrier(bar);
    if (IN(11)) { PHASE_ARGS(); p11_final(F, WSP(bf16_t, WS_H), INP(26), ap_->out); }
    }
#undef IN
#undef SEAM
#undef PHASE_ARGS
#undef INP
#undef WSP
}

extern "C" void kernel_launch(void* const* d_in, const int* in_sizes, int n_in, void* d_out, int out_size, void* d_ws, size_t ws_size, hipStream_t stream) {
    static int grid = 0;
    if (grid == 0) {
        if (n_in != 27 || in_sizes[0] != M * D || out_size != M * D || ws_size < WS_END) { fprintf(stderr, "kernel_launch: unexpected shapes (n_in %d, in0 %d, out %d, ws %zu)\n", n_in, n_in > 0 ? in_sizes[0] : -1, out_size, ws_size); grid = -1; return; }
        int dev = 0, cus = 0, per_cu = 0;
        if (hipGetDevice(&dev) != hipSuccess || hipDeviceGetAttribute(&cus, hipDeviceAttributeMultiprocessorCount, dev) != hipSuccess) { grid = -1; return; }
        if (hipFuncSetAttribute((const void*)mega_fwd, hipFuncAttributeMaxDynamicSharedMemorySize, LDS_BYTES) != hipSuccess) { fprintf(stderr, "kernel_launch: hipFuncSetAttribute failed\n"); grid = -1; return; }
        if (hipOccupancyMaxActiveBlocksPerMultiprocessor(&per_cu, (const void*)mega_fwd, NWAVES * 64, LDS_BYTES) != hipSuccess || per_cu < 1) fprintf(stderr, "kernel_launch: occupancy query reports %d\n", per_cu);
        (void)hipGetLastError();
        grid = cus;
    }
    if (grid < 0) return;
    const float* const* in = (const float* const*)d_in;
    unsigned char* ws = (unsigned char*)d_ws; float* out = (float*)d_out;
    (void)hipMemsetAsync(ws + WS_CTL, 0, CTL_ZERO_BYTES, stream);
    Args a{};
    for (int i = 0; i < 27; ++i) a.in[i] = in[i];
    a.out = out; a.ws = ws;
#ifndef HDUP_MASK
#define HDUP_MASK 0
#endif
#if ONE_LAUNCH
    a.ph_lo = 0; a.ph_hi = NPHASE; a.li = 0;
    hipLaunchKernelGGL(mega_fwd, dim3(grid), dim3(NWAVES * 64), LDS_BYTES, stream, a);
#else
    for (int ph = 0; ph < NPHASE; ++ph) { a.ph_lo = ph; a.ph_hi = ph + 1; a.li = 3;
        const int nrep = 1 + (((HDUP_MASK) >> ph) & 1);
        for (int rep = 0; rep < nrep; ++rep) { const bool dry = rep + 1 < nrep;
            a.ws = ws + ((dry && ph == 9 && ws_size >= 1008 * MiB) ? 512 * MiB : (dry && ph == 10) ? 128 * MiB : (size_t)0);
            hipLaunchKernelGGL(mega_fwd, dim3(grid), dim3(NWAVES * 64), LDS_BYTES, stream, a);
            if (dry && ph == 6) (void)hipMemsetAsync(ws + WS_CTL + CW_GCNT * 4, 0, 128, stream); } }
#endif
}
```

```cpp
#include <hip/hip_runtime.h>
#include <cstdio>
#include <cstdint>
#include <hip/hip_bf16.h>
#include <cmath>
#define ONE_LAUNCH 1
#define DUP_MASK 0
#define KREP 1
#define EREP 1
#define HDUP_MASK 0

typedef unsigned short bf16_t;
typedef float f32x4 __attribute__((ext_vector_type(4)));
typedef unsigned u32x4 __attribute__((ext_vector_type(4)));
typedef unsigned u32x2 __attribute__((ext_vector_type(2)));
typedef float f32x2 __attribute__((ext_vector_type(2)));

constexpr int BATCH = 16, SEQ = 2048, D = 1024, M = BATCH * SEQ;
constexpr int AW = 512, CW = 512, NH = 4, HD = 64, KC = 31, NE = 32, TOPK = 4, FF = 1024, PLE = 256;
constexpr int INC = 3 * AW + 2 * CW + 2 * D;
constexpr float EPS = 1e-5f;
constexpr float C2 = 0.125f * 1.4426950408889634f;
constexpr float LAM_INIT = 0.2f;
constexpr int LIST_CAP = M;
constexpr int ACT_ROWS = M * TOPK + NE * 256;
constexpr int UCW = PLE + D;

constexpr size_t MiB = 1u << 20;
constexpr size_t WS_CTL = 0, CTL_ZERO_BYTES = 1 * MiB;
constexpr size_t WS_TOPK_E = 1 * MiB;
constexpr size_t WS_TOPK_G = 2 * MiB;
constexpr size_t WS_TRASH = 3 * MiB;
constexpr size_t WS_LIST = 4 * MiB;
constexpr size_t WS_GLIST = 26 * MiB, GLIST_DELTA = WS_GLIST - 4 * MiB;
constexpr size_t WS_WSM = 8 * MiB;
constexpr size_t WS_WIN = 16 * MiB;
constexpr size_t WS_WGU = 32 * MiB;
constexpr size_t WS_WDN = 160 * MiB;
constexpr size_t WS_UC = 224 * MiB;
constexpr size_t WS_H = 304 * MiB;
constexpr size_t WS_XN = 368 * MiB;
constexpr size_t WS_U2 = 496 * MiB;
constexpr size_t WS_Q = 432 * MiB, WS_K = 464 * MiB, WS_V = 496 * MiB;
constexpr size_t WS_Z = 528 * MiB;
constexpr size_t WS_SGA = 560 * MiB, WS_SGB = 624 * MiB;
constexpr size_t WS_O1 = 688 * MiB, WS_O2 = 720 * MiB;
constexpr size_t WS_AC = 752 * MiB;
constexpr size_t WS_M1 = 880 * MiB;
constexpr size_t WS_END = 944 * MiB;
constexpr size_t WS_Y = 368 * MiB;
constexpr size_t WS_ACT = 624 * MiB;
constexpr size_t WS_E1 = 688 * MiB;
static_assert(WS_ACT + (size_t)ACT_ROWS * FF <= WS_END && WS_Y + (size_t)M * TOPK * D <= WS_ACT, "overlays");
static_assert(WS_V - WS_K == WS_K - WS_Q, "Q | K | V equally spaced");
constexpr int CW_GCNT = 64;
constexpr int CW_MODE = 96;

__device__ __forceinline__ unsigned f2bf(float f) { unsigned u = __float_as_uint(f); return (u + 0x7fffu + ((u >> 16) & 1u)) >> 16; }
__device__ __forceinline__ unsigned pk2(float lo, float hi) { return f2bf(lo) | (f2bf(hi) << 16); }
constexpr float S_U2 = 16.f, S_W8 = 512.f, S_ACT = 4.f, S_Y = 32.f, S_P = 16.f, S_WPLE = 256.f;
__device__ __forceinline__ float clamp448(float x) { return __builtin_fminf(__builtin_fmaxf(x, -448.f), 448.f); }
__device__ __forceinline__ unsigned pk4_fp8(float a, float b, float c, float d) { int w = 0; w = __builtin_amdgcn_cvt_pk_fp8_f32(clamp448(a), clamp448(b), w, false); w = __builtin_amdgcn_cvt_pk_fp8_f32(clamp448(c), clamp448(d), w, true); return (unsigned)w; }
__device__ __forceinline__ void unpk4_fp8(unsigned w, float& a, float& b, float& c, float& d) { const f32x2 lo = __builtin_amdgcn_cvt_pk_f32_fp8((int)w, false), hi = __builtin_amdgcn_cvt_pk_f32_fp8((int)w, true); a = lo.x; b = lo.y; c = hi.x; d = hi.y; }
__device__ __forceinline__ int fresh_lane() { int l; asm volatile("v_mbcnt_lo_u32_b32 %0, -1, 0\n\tv_mbcnt_hi_u32_b32 %0, -1, %0" : "=v"(l)); return l; }
__device__ __forceinline__ float wave_sum(float v) {
#pragma unroll
    for (int o = 1; o < 64; o <<= 1) v += __shfl_xor(v, o);
    return v;
}

namespace pg8 {
#define PG8_LAS __attribute__((address_space(3)))
typedef short bf16x8 __attribute__((ext_vector_type(8)));
typedef int i32x4 __attribute__((ext_vector_type(4)));
constexpr int BM = 256, BK = 64, HALF = 128, HTB = HALF * BK * 2  , STAGE_BYTES = 8 * HTB, NXCD = 8, WGM = 8;

__host__ __device__ __forceinline__ int lds_byte(int r, int c) { const int st = (r >> 4) * 2 + (c >> 5), rr = r & 15, cc = c & 31, ob = rr * 64 + cc * 2; return st * 1024 + (ob ^ (((ob >> 9) & 1) << 5)); }
__host__ __device__ __forceinline__ void stage_rc(int b, int& R, int& C) { const int st = b / 1024, sb = b % 1024, swz = sb ^ (((sb >> 9) & 1) << 5); R = (st >> 1) * 16 + swz / 64; C = (st & 1) * 32 + (swz % 64) / 2; }
__host__ __device__ __forceinline__ int perm32(int rho) { const int n = rho >> 4, i = rho & 15; return 8 * (i >> 2) + 4 * n + (i & 3); }

struct Unit { int pm, pn, e, nv, p0; };
struct Gemm { const bf16_t* A; const bf16_t* Bt; int K, lda; size_t b_estride; };

struct StaticOrder {
    static constexpr bool GATHER = false;
    int nM, nN, nwg, G, c;
    __device__ void init(int M_, int N_, int G_, int c_) { nM = M_ / BM; nN = N_ / BM; nwg = nM * nN; G = G_; c = c_; }
    __device__ bool next(int i, Unit& u) const {
        const long L = (long)i * G + c; if (L >= nwg) return false;
        int wgid = (int)L; { const int q = nwg / NXCD, r = nwg % NXCD, xcd = wgid % NXCD, off = wgid / NXCD; wgid = (xcd < r ? xcd * (q + 1) : r * (q + 1) + (xcd - r) * q) + off; }
        const int nig = WGM * nN, gid = wgid / nig, fm = gid * WGM, gsz = (nM - fm) < WGM ? (nM - fm) : WGM;
        u.pm = fm + ((wgid % nig) % gsz); u.pn = (wgid % nig) / gsz; u.e = 0; u.nv = 256; u.p0 = 0; return true;
    }
    __device__ __forceinline__ unsigned row_off(const Unit&, int) const { return 0u; }
    __device__ __forceinline__ unsigned row_fin(int) const { return 0u; }
    __device__ __forceinline__ const int* idx_src(const Unit&) const { return nullptr; }
    __device__ __forceinline__ void a_ready(const Unit&) const {}
    __device__ __forceinline__ void done(const Unit&) const {}
};
struct InProjOrder {
    static constexpr bool GATHER = false;
    StaticOrder so; int x, j; bool custom;
    __device__ void init(int M_, int N_, int G_, int c_) { so.init(M_, N_, G_, c_); custom = (G_ == 256 && M_ / BM == 128 && N_ / BM == 18); x = c_ % NXCD; j = c_ / NXCD; }
    __device__ bool next(int i, Unit& u) const {
        if (!custom) return so.next(i, u);
        if (i >= 9) return false;
        int pm, pn;
        if (i == 2) { pm = j & 15; pn = 4 + (j >> 4); }
        else { const int k = i < 2 ? i : i - 3;        const int half = i < 2 ? i : (k & 1), grp = i < 2 ? 0 : 6 + 4 * (k >> 1); pm = 8 * half + (j & 7); pn = grp + (j >> 3); }
        u.pm = 16 * x + pm; u.pn = pn; u.e = 0; u.nv = 256; u.p0 = 0; return true;
    }
    __device__ __forceinline__ unsigned row_off(const Unit&, int) const { return 0u; }
    __device__ __forceinline__ unsigned row_fin(int) const { return 0u; }
    __device__ __forceinline__ const int* idx_src(const Unit&) const { return nullptr; }
    __device__ __forceinline__ void a_ready(const Unit&) const {}
    __device__ __forceinline__ void done(const Unit&) const {}
};
template <bool GATHER_> struct MoeOrder {
    static constexpr bool GATHER = GATHER_;
    const PG8_LAS unsigned short* ent; const PG8_LAS int* cnt; const int* list; int nN, G, vcu, TU, ld;
    __device__ bool next(int i, Unit& u) const {
        int mt, pn;
        if (G % (8 * nN) == 0) {
            const int mpx = G / 8 / nN, x = vcu / (G / 8), j = vcu % (G / 8), lo = (x * TU) / 8, hi = ((x + 1) * TU) / 8; mt = lo + i * mpx + (j % mpx); pn = j / mpx; if (mt >= hi) return false; }
        else { const int L = i * G + vcu; mt = L / nN; pn = L % nN; }
        if (mt >= TU) return false;
        const int v = __builtin_amdgcn_readfirstlane((int)ent[mt]), e = v & 31;
        u.pm = mt; u.pn = pn; u.e = e; u.p0 = 256 * (v >> 5); const int rem = __builtin_amdgcn_readfirstlane(cnt[e]) - u.p0; u.nv = rem < 256 ? rem : 256; return true;
    }
    __device__ __forceinline__ unsigned row_off(const Unit& u, int rl) const { const int r = rl < u.nv ? rl : u.nv - 1; const int tok = list[u.e * LIST_CAP + u.p0 + r] >> 2; return (unsigned)tok * (unsigned)ld; }
    __device__ __forceinline__ unsigned row_fin(int raw) const { return (unsigned)(raw >> 2) * (unsigned)ld; }
    __device__ __forceinline__ const int* idx_src(const Unit& u) const { return list + u.e * LIST_CAP + u.p0; }
    __device__ __forceinline__ void a_ready(const Unit&) const {}
    __device__ __forceinline__ void done(const Unit&) const {}
};

__device__ __forceinline__ unsigned cvt_pk_bf16(float lo, float hi) { unsigned r; asm volatile("v_cvt_pk_bf16_f32 %0, %1, %2" : "=v"(r) : "v"(lo), "v"(hi)); return r; }
__device__ __forceinline__ float fsig(float x) { return __builtin_amdgcn_rcpf(1.f + __builtin_amdgcn_exp2f(-1.4426950408889634f * x)); }
__device__ __forceinline__ u32x4 pack8(const f32x4 a, const f32x4 b) { u32x4 w; w.x = cvt_pk_bf16(a[0], a[1]); w.y = cvt_pk_bf16(a[2], a[3]); w.z = cvt_pk_bf16(b[0], b[1]); w.w = cvt_pk_bf16(b[2], b[3]); return w; }
__device__ __forceinline__ void unpack8(const u32x4 w, f32x4& a, f32x4& b) {
    a[0] = __uint_as_float(w.x << 16); a[1] = __uint_as_float(w.x & 0xffff0000u); a[2] = __uint_as_float(w.y << 16); a[3] = __uint_as_float(w.y & 0xffff0000u);
    b[0] = __uint_as_float(w.z << 16); b[1] = __uint_as_float(w.z & 0xffff0000u); b[2] = __uint_as_float(w.w << 16); b[3] = __uint_as_float(w.w & 0xffff0000u); }

__device__ __forceinline__ u32x4 widen16(u32x2 A, u32x2 B) {
    const auto r0 = __builtin_amdgcn_permlane16_swap(A.x, B.x, false, false), r1 = __builtin_amdgcn_permlane16_swap(A.y, B.y, false, false);
    return (u32x4){r0[0], r1[0], r0[1], r1[1]};
}
struct EpiIn { static constexpr bool PERM = true, AFTER_DRAIN = false, IDEMPOTENT = true, MIDK = false; bf16_t *Q, *K, *V, *Z, *SGA, *SGB;
    __device__ __forceinline__ void operator()(const f32x4 (&acc)[2][2][4][2], const Unit& u, int wr, int wc, int fr, int fq) const {
        const int pn = u.pn, row0 = u.pm * BM + wr * 64 + fr;
        if (pn >= 6 && pn < 10) {
            bf16_t* base = Z + (pn - 6) * 128 + wc * 32 + 8 * fq;
#pragma unroll
            for (int ai = 0; ai < 2; ++ai)
#pragma unroll
                for (int m = 0; m < 4; ++m) { f32x4 o0, o1;
#pragma unroll
                    for (int i = 0; i < 4; ++i) { o0[i] = acc[ai][0][m][0][i] * fsig(acc[ai][1][m][0][i]); o1[i] = acc[ai][0][m][1][i] * fsig(acc[ai][1][m][1][i]); }
                    *(u32x4*)(base + (size_t)(row0 + ai * HALF + m * 16) * CW) = pack8(o0, o1); }
        } else if (pn >= 10) {
            unsigned char* base = (unsigned char*)SGA + (size_t)((pn - 10) >> 2) * (WS_SGB - WS_SGA) + ((pn - 10) & 3) * 256 + wc * 32 + 8 * fq;
#pragma unroll
            for (int ai = 0; ai < 2; ++ai)
#pragma unroll
                for (int m = 0; m < 4; ++m) { unsigned char* rowp = base + (size_t)(row0 + ai * HALF + m * 16) * D;
                    u32x2 w[2];
#pragma unroll
                    for (int bj = 0; bj < 2; ++bj)
#pragma unroll
                        for (int n = 0; n < 2; ++n) { unsigned q[4];
#pragma unroll
                            for (int i = 0; i < 4; ++i) q[i] = (unsigned)__builtin_fmaxf(fsig(acc[ai][bj][m][n][i]) * 255.f + 0.5f, 1.f);
                            w[bj][n] = q[0] | (q[1] << 8) | (q[2] << 16) | (q[3] << 24); }
                    *(u32x4*)(rowp + (fq & 1) * (HALF - 8)) = widen16(w[0], w[1]); }
        } else {
            const float sc = pn < 2 ? C2 : 1.f;
            bf16_t* base = Q + (size_t)(pn >> 1) * ((WS_K - WS_Q) / 2) + (pn & 1) * 256 + wc * 32 + 8 * fq;
#pragma unroll
            for (int ai = 0; ai < 2; ++ai)
#pragma unroll
                for (int m = 0; m < 4; ++m) { bf16_t* rowp = base + (size_t)(row0 + ai * HALF + m * 16) * AW;
#pragma unroll
                    for (int bj = 0; bj < 2; ++bj) *(u32x4*)(rowp + bj * HALF) = pack8(acc[ai][bj][m][0] * sc, acc[ai][bj][m][1] * sc); }
        }
    }
};
struct EpiMixF { static constexpr bool PERM = true, AFTER_DRAIN = false, IDEMPOTENT = true, MIDK = true; static constexpr int MIDT = 8; const unsigned char* SGA; const unsigned char* SGB; bf16_t* Out;
    static __device__ __forceinline__ void ub4(unsigned w, f32x4& o) { o[0] = (float)(w & 0xffu); o[1] = (float)((w >> 8) & 0xffu); o[2] = (float)((w >> 16) & 0xffu); o[3] = (float)(w >> 24); }
    __device__ __forceinline__ void mid(f32x4 (&acc)[2][2][4][2], const Unit& u, int wr, int wc, int fr, int fq) const {
        const int row0 = u.pm * BM + wr * 64 + fr, col0 = u.pn * BM + wc * 32 + 8 * fq;
        u32x2 ra[2][4][2], rb[2][4][2];
#pragma unroll
        for (int ai = 0; ai < 2; ++ai)
#pragma unroll
            for (int m = 0; m < 4; ++m)
#pragma unroll
                for (int bj = 0; bj < 2; ++bj) { const size_t off = (size_t)(row0 + ai * HALF + m * 16) * D + col0 + bj * HALF; ra[ai][m][bj] = *(const u32x2*)(SGA + off); rb[ai][m][bj] = *(const u32x2*)(SGB + off); }
#pragma unroll
        for (int ai = 0; ai < 2; ++ai)
#pragma unroll
            for (int m = 0; m < 4; ++m)
#pragma unroll
                for (int bj = 0; bj < 2; ++bj)
#pragma unroll
                    for (int n = 0; n < 2; ++n) { f32x4 a, b; ub4(ra[ai][m][bj][n], a); ub4(rb[ai][m][bj][n], b);
#pragma unroll
                        for (int i = 0; i < 4; ++i) acc[ai][bj][m][n][i] *= a[i] * __builtin_amdgcn_rcpf(b[i]); }
    }
    __device__ __forceinline__ void operator()(const f32x4 (&acc)[2][2][4][2], const Unit& u, int wr, int wc, int fr, int fq) const {
        const int row0 = u.pm * BM + wr * 64 + fr, col0 = u.pn * BM + wc * 32 + 8 * fq;
        u32x2 rb[2][4][2];
#pragma unroll
        for (int ai = 0; ai < 2; ++ai)
#pragma unroll
            for (int m = 0; m < 4; ++m)
#pragma unroll
                for (int bj = 0; bj < 2; ++bj) rb[ai][m][bj] = *(const u32x2*)(SGB + (size_t)(row0 + ai * HALF + m * 16) * D + col0 + bj * HALF);
#pragma unroll
        for (int ai = 0; ai < 2; ++ai)
#pragma unroll
            for (int m = 0; m < 4; ++m)
#pragma unroll
                for (int bj = 0; bj < 2; ++bj) { const size_t off = (size_t)(row0 + ai * HALF + m * 16) * D + col0 + bj * HALF;
                    f32x4 s0, s1; ub4(rb[ai][m][bj][0], s0); ub4(rb[ai][m][bj][1], s1); *(u32x4*)(Out + off) = pack8(acc[ai][bj][m][0] * (s0 * (1.f / 255.f)), acc[ai][bj][m][1] * (s1 * (1.f / 255.f))); }
    }
};
struct EpiWo { static constexpr bool PERM = true, AFTER_DRAIN = false, IDEMPOTENT = true, MIDK = false; const float* X; bf16_t* H;
    __device__ __forceinline__ void operator()(const f32x4 (&acc)[2][2][4][2], const Unit& u, int wr, int wc, int fr, int fq) const {
        const int row0 = u.pm * BM + wr * 64 + fr, col0 = u.pn * BM + wc * 32 + 8 * fq;
#pragma unroll
        for (int ai = 0; ai < 2; ++ai)
#pragma unroll
            for (int m = 0; m < 4; ++m) { const size_t off = (size_t)(row0 + ai * HALF + m * 16) * D + col0;
#pragma unroll
                for (int bj = 0; bj < 2; ++bj) *(u32x4*)(H + off + bj * HALF) = pack8(*(const f32x4*)(X + off + bj * HALF) + acc[ai][bj][m][0], *(const f32x4*)(X + off + bj * HALF + 4) + acc[ai][bj][m][1]); }
    }
};
struct EpiGateUp { static constexpr bool PERM = true, AFTER_DRAIN = false, IDEMPOTENT = true, MIDK = true; static constexpr int MIDT = 2; const float* bias; unsigned char* ACT; PG8_LAS float* stg;
    __device__ __forceinline__ void mid(f32x4 (&acc)[2][2][4][2], const Unit& u, int wr, int wc, int fr, int fq) const {
        if (wr * 4 + wc == 0) { const char* src = (const char*)(bias + (size_t)u.e * (2 * FF) + 2 * u.pn * 128); unsigned off = (unsigned)(fq * 16 + fr) * 16u; asm volatile("" : "+s"(src), "+v"(off));
            __builtin_amdgcn_global_load_lds((const unsigned*)(src + off), (PG8_LAS unsigned*)stg, 16, 0, 0); }
    }
    __device__ __forceinline__ void operator()(const f32x4 (&acc)[2][2][4][2], const Unit& u, int wr, int wc, int fr, int fq) const {
        const int jb = u.pn * 128 + wc * 32 + 8 * fq; const PG8_LAS float* bp0 = stg + 2 * (wc * 32 + 8 * fq);
        const int row0 = u.pm * BM + wr * 64 + fr; constexpr float isc = 1.f / (S_U2 * S_W8);
        f32x4 bg[2], bl[2];
#pragma unroll
        for (int n = 0; n < 2; ++n) { const f32x4 b0 = *(const PG8_LAS f32x4*)(bp0 + 8 * n), b1 = *(const PG8_LAS f32x4*)(bp0 + 8 * n + 4); bg[n] = (f32x4){b0[0], b0[2], b1[0], b1[2]}; bl[n] = (f32x4){b0[1], b0[3], b1[1], b1[3]}; }
        unsigned char* const base = ACT + (size_t)(row0 + (fq & 1) * 16) * FF + jb - 8 * (fq & 1);
#pragma unroll
        for (int ai = 0; ai < 2; ++ai)
#pragma unroll
            for (int mp = 0; mp < 4; mp += 2) { u32x2 w[2];
#pragma unroll
                for (int mm = 0; mm < 2; ++mm) { const int m = mp + mm;
#pragma unroll
                    for (int n = 0; n < 2; ++n) { f32x4 o;
#pragma unroll
                        for (int i = 0; i < 4; ++i) { const float gate = fminf(acc[ai][0][m][n][i] * isc + bg[n][i], 7.f), lin = fminf(fmaxf(acc[ai][1][m][n][i] * isc + bl[n][i], -7.f), 7.f);
                            o[i] = (lin * gate + gate) * __builtin_amdgcn_rcpf(0.25f + 0.25f * __builtin_amdgcn_exp2f(-1.702f * 1.4426950408889634f * gate)); }
                        int q = 0; q = __builtin_amdgcn_cvt_pk_fp8_f32(o[0], o[1], q, false); q = __builtin_amdgcn_cvt_pk_fp8_f32(o[2], o[3], q, true); w[mm][n] = (unsigned)q; } }
                *(u32x4*)(base + (size_t)(ai * HALF + mp * 16) * FF) = widen16(w[0], w[1]); }
    }
};
struct EpiDown { static constexpr bool PERM = true, AFTER_DRAIN = false, IDEMPOTENT = true, MIDK = true; static constexpr int MIDT = 2; const float* bias; const int* list; unsigned char* Y; unsigned char* trash; PG8_LAS unsigned* stg;
    __device__ __forceinline__ void mid(f32x4 (&acc)[2][2][4][2], const Unit& u, int wr, int wc, int fr, int fq) const {
        const int w = wr * 4 + wc;
        const char* src = (const char*)(list + u.e * LIST_CAP + u.p0 + (w & 3) * 64) + (size_t)(w >> 2) * GLIST_DELTA; unsigned off = (unsigned)(fq * 16 + fr) * 4u; asm volatile("" : "+s"(src), "+v"(off));
        __builtin_amdgcn_global_load_lds((const unsigned*)(src + off), stg + w * 64, 4, 0, 0);
        if (w == 0) { const char* sb = (const char*)(bias + (size_t)u.e * D + u.pn * BM); unsigned ob = (unsigned)(fq * 16 + fr) * 16u; asm volatile("" : "+s"(sb), "+v"(ob));
            __builtin_amdgcn_global_load_lds((const unsigned*)(sb + ob), stg + 512, 16, 0, 0); }
    }
    __device__ __forceinline__ void operator()(const f32x4 (&acc)[2][2][4][2], const Unit& u, int wr, int wc, int fr, int fq) const {
        const int col0 = u.pn * BM + wc * 32 + 8 * fq; const PG8_LAS float* bp = (const PG8_LAS float*)(stg + 512) + wc * 32 + 8 * fq; constexpr float isc = 1.f / (S_ACT * S_W8);
        f32x4 bv[2][2];
#pragma unroll
        for (int bj = 0; bj < 2; ++bj)
#pragma unroll
            for (int n = 0; n < 2; ++n) bv[bj][n] = *(const PG8_LAS f32x4*)(bp + bj * HALF + 4 * n);
        int slot[8]; float gv[8];
#pragma unroll
        for (int q = 0; q < 8; ++q) { const int rl = (q >> 2) * HALF + wr * 64 + (q & 3) * 16 + fr; slot[q] = (int)stg[rl]; gv[q] = __uint_as_float(stg[256 + rl]) * S_Y; }
#pragma unroll
        for (int ai = 0; ai < 2; ++ai)
#pragma unroll
            for (int m = 0; m < 4; ++m) { const int q = ai * 4 + m, rl = ai * HALF + wr * 64 + m * 16 + fr; unsigned char* rowp = (rl < u.nv ? Y + (size_t)slot[q] * D : trash) + col0;
                u32x2 w[2];
#pragma unroll
                for (int bj = 0; bj < 2; ++bj) { const f32x4 v0 = (acc[ai][bj][m][0] * isc + bv[bj][0]) * gv[q], v1 = (acc[ai][bj][m][1] * isc + bv[bj][1]) * gv[q]; w[bj].x = pk4_fp8(v0[0], v0[1], v0[2], v0[3]); w[bj].y = pk4_fp8(v1[0], v1[1], v1[2], v1[3]); }
                *(u32x4*)(rowp + (fq & 1) * (HALF - 8)) = widen16(w[0], w[1]); }
    }
};
struct EpiPlain { static constexpr bool PERM = true, AFTER_DRAIN = false, IDEMPOTENT = true, MIDK = false; bf16_t* O;
    __device__ __forceinline__ void operator()(const f32x4 (&acc)[2][2][4][2], const Unit& u, int wr, int wc, int fr, int fq) const {
        const int row0 = u.pm * BM + wr * 64 + fr, col0 = u.pn * BM + wc * 32 + 8 * fq;
#pragma unroll
        for (int ai = 0; ai < 2; ++ai)
#pragma unroll
            for (int m = 0; m < 4; ++m)
#pragma unroll
                for (int bj = 0; bj < 2; ++bj) *(u32x4*)(O + (size_t)(row0 + ai * HALF + m * 16) * D + col0 + bj * HALF) = pack8(acc[ai][bj][m][0], acc[ai][bj][m][1]);
    }
};
struct EpiPleF { static constexpr bool PERM = true, AFTER_DRAIN = false, IDEMPOTENT = false, MIDK = true; static constexpr int MIDT = 2;     bf16_t* E1; bf16_t* H;
    __device__ __forceinline__ void mid(f32x4 (&acc)[2][2][4][2], const Unit& u, int wr, int wc, int fr, int fq) const {
        const int row0 = u.pm * BM + wr * 64 + fr, col0 = u.pn * BM + wc * 32 + 8 * fq;
#pragma unroll
        for (int ai = 0; ai < 2; ++ai)
#pragma unroll
            for (int m = 0; m < 4; ++m)
#pragma unroll
                for (int bj = 0; bj < 2; ++bj) { *(u32x4*)(E1 + (size_t)(row0 + ai * HALF + m * 16) * D + col0 + bj * HALF) = pack8(acc[ai][bj][m][0] * (1.f / (S_P * S_WPLE)), acc[ai][bj][m][1] * (1.f / (S_P * S_WPLE)));
                    acc[ai][bj][m][0] = (f32x4){0.f, 0.f, 0.f, 0.f}; acc[ai][bj][m][1] = (f32x4){0.f, 0.f, 0.f, 0.f}; }
        asm volatile("s_waitcnt vmcnt(0)" ::: "memory");
    }
    __device__ __forceinline__ void operator()(const f32x4 (&acc)[2][2][4][2], const Unit& u, int wr, int wc, int fr, int fq) const {
        const int row0 = u.pm * BM + wr * 64 + fr, col0 = u.pn * BM + wc * 32 + 8 * fq;
#pragma unroll
        for (int ai = 0; ai < 2; ++ai)
#pragma unroll
            for (int m = 0; m < 4; ++m)
#pragma unroll
                for (int bj = 0; bj < 2; ++bj) { const size_t o = (size_t)(row0 + ai * HALF + m * 16) * D + col0 + bj * HALF; f32x4 e0, e1, h0, h1; unpack8(*(const u32x4*)(E1 + o), e0, e1); unpack8(*(const u32x4*)(H + o), h0, h1);
                    const f32x4 a0 = acc[ai][bj][m][0] * (1.f / (S_U2 * S_W8)), a1 = acc[ai][bj][m][1] * (1.f / (S_U2 * S_W8));
#pragma unroll
                    for (int i = 0; i < 4; ++i) { h0[i] += e0[i] * fsig(a0[i]); h1[i] += e1[i] * fsig(a1[i]); }
                    *(u32x4*)(H + o) = pack8(h0, h1); }
    }
};

template <class Epi, class Sched, bool ALIGN_EPI, bool FP8 = false>
__device__ __forceinline__ void gemm_phase(PG8_LAS unsigned char* lds, int wave_s, const Gemm g, const Sched& S, const Epi& E, unsigned skew_ticks = 0u) {
    if (skew_ticks) { const unsigned xc = (unsigned)__builtin_amdgcn_s_getreg((3 << 11) | 20) & 0xFu, x = (skew_ticks >> 31) ? (xc & 1u) : xc;
        const unsigned long long t0 = __builtin_amdgcn_s_memrealtime(), dt = (unsigned long long)x * (skew_ticks & 0x7fffffffu);
        while (__builtin_amdgcn_s_memrealtime() - t0 < dt) __builtin_amdgcn_s_sleep(8); }
    const int wid = wave_s, lane = fresh_lane(), tid = wid * 64 + lane;
    const int wr = wid >> 2, wc = wid & 3, fr = lane & 15, fq = lane >> 4;
    const int K = g.K, nt = K / BK, lda = g.lda;
    unsigned voffA[2], voffB[2];
#pragma unroll
    for (int i = 0; i < 2; ++i) { int R, C; stage_rc(tid * 16 + i * 8192, R, C); const int Rb = Epi::PERM ? ((R & ~31) + perm32(R & 31)) : R;
        voffA[i] = (unsigned)(R * lda + C) * 2u; voffB[i] = (unsigned)(Rb * K + C) * 2u; }
    const size_t kstep = (size_t)(BK * 2);
    const size_t hstepA = (size_t)HALF * lda * 2, tstepA = 2 * hstepA, hstepB = (size_t)HALF * K * 2, tstepB = 2 * hstepB;
    const unsigned ldsw = (unsigned)wid * 1024u;
    const int aoff = lds_byte(wr * 64 + fr, fq * 8), boff = lds_byte(wc * 32 + fr, fq * 8);
#define PG8_SA(b, h) (((b) * 2 + (h)) * HTB)
#define PG8_SB(b, h) ((4 + (b) * 2 + (h)) * HTB)
#define PG8_DMA(bufoff, ptr, o0, o1) do { const char* _p = (const char*)(ptr); unsigned _q0 = (o0), _q1 = (o1); asm volatile("" : "+s"(_p), "+v"(_q0), "+v"(_q1));     \
        __builtin_amdgcn_global_load_lds((const unsigned*)(_p + _q0), (PG8_LAS unsigned*)(lds + (bufoff) + ldsw), 16, 0, 0); \
        __builtin_amdgcn_global_load_lds((const unsigned*)(_p + _q1), (PG8_LAS unsigned*)(lds + (bufoff) + ldsw + 8192), 16, 0, 0); } while (0)
#define PG8_STA(bufoff, h, koff, NX) do { if constexpr (Sched::GATHER) { \
        PG8_DMA(bufoff, (const char*)g.A + (koff), (h) ? cG1[0] : cG0[0], (h) ? cG1[1] : cG0[1]);     \
    } else { PG8_DMA(bufoff, ((NX) ? nA : cA) + (size_t)(h) * hstepA + (koff), voffA[0], voffA[1]); } } while (0)
#define PG8_STB(bufoff, h, koff, NX) PG8_DMA(bufoff, ((NX) ? nB : cB) + (size_t)(h) * hstepB + (koff), voffB[0], voffB[1])
#define PG8_LDA(dst, b, h) do { _Pragma("unroll") for (int m = 0; m < 4; ++m) _Pragma("unroll") for (int k = 0; k < 2; ++k) dst[m][k] = *(const PG8_LAS bf16x8*)(lds + PG8_SA(b, h) + aoff + m * 2048 + k * 1024); } while (0)
#define PG8_LDB(dst, b, h) do { _Pragma("unroll") for (int n = 0; n < 2; ++n) _Pragma("unroll") for (int k = 0; k < 2; ++k) dst[n][k] = *(const PG8_LAS bf16x8*)(lds + PG8_SB(b, h) + boff + n * 2048 + k * 1024); } while (0)
#define PG8_CAT(x) __builtin_shufflevector(__builtin_bit_cast(i32x4, x[0]), __builtin_bit_cast(i32x4, x[1]), 0, 1, 2, 3, 4, 5, 6, 7)
#define PG8_MMA(ai, bj, At, Bt) do { __builtin_amdgcn_s_setprio(1); _Pragma("unroll") for (int m = 0; m < 4; ++m) _Pragma("unroll") for (int n = 0; n < 2; ++n) { \
        if constexpr (FP8) acc[ai][bj][m][n] = __builtin_amdgcn_mfma_scale_f32_16x16x128_f8f6f4(PG8_CAT(Bt[n]), PG8_CAT(At[m]), acc[ai][bj][m][n], 0, 0, 0, 0x7f7f7f7f, 0, 0x7f7f7f7f); \
        else { _Pragma("unroll") for (int k = 0; k < 2; ++k) acc[ai][bj][m][n] = __builtin_amdgcn_mfma_f32_16x16x32_bf16(Bt[n][k], At[m][k], acc[ai][bj][m][n], 0, 0, 0); } } \
        __builtin_amdgcn_s_setprio(0); } while (0)
#define PG8_WAIT_V(n) asm volatile("s_waitcnt vmcnt(" #n ")" ::: "memory")
#define PG8_WAIT_L(n) asm volatile("s_waitcnt lgkmcnt(" #n ")" ::: "memory")
#define PG8_BAR __builtin_amdgcn_s_barrier()
#define PG8_SCHED __builtin_amdgcn_sched_barrier(0)
    Unit cur, nxt; int ui = 0;
    if (!S.next(0, cur)) return;
    f32x4 acc[2][2][4][2];
#pragma unroll
    for (int a = 0; a < 2; ++a)
#pragma unroll
        for (int b = 0; b < 2; ++b)
#pragma unroll
            for (int m = 0; m < 4; ++m)
#pragma unroll
                for (int n = 0; n < 2; ++n) acc[a][b][m][n] = (f32x4){0.f, 0.f, 0.f, 0.f};
    bf16x8 At[4][2], B0[2][2], B1[2][2];
    const char* cA = (const char*)g.A + (Sched::GATHER ? (size_t)0 : (size_t)cur.pm * tstepA);
    const char* cB = (const char*)g.Bt + (size_t)cur.e * g.b_estride * 2 + (size_t)cur.pn * tstepB;
    const char* nA = cA; const char* nB = cB;
    unsigned cG0[2] = {0u, 0u}, cG1[2] = {0u, 0u};
    const PG8_LAS int* const gidx = (const PG8_LAS int*)(lds + STAGE_BYTES + 512 + 1024);
    PG8_LAS u32x4* const park = (PG8_LAS u32x4*)(lds + STAGE_BYTES + 8192) + tid;
    if constexpr (Sched::GATHER) {
#pragma unroll
        for (int i = 0; i < 2; ++i) { int R, C; stage_rc((wid * 64 + fresh_lane()) * 16 + i * 8192, R, C); cG0[i] = (S.row_off(cur, R) + (unsigned)C) * 2u; cG1[i] = (S.row_off(cur, HALF + R) + (unsigned)C) * 2u; } }
    S.a_ready(cur);
    PG8_STB(PG8_SB(0, 0), 0, 0, false); PG8_STB(PG8_SB(0, 1), 1, 0, false); PG8_STA(PG8_SA(0, 0), 0, 0, false); PG8_STA(PG8_SA(0, 1), 1, 0, false);
    if (wr == 1) PG8_BAR;
    PG8_WAIT_V(2); PG8_BAR;
    PG8_STB(PG8_SB(1, 0), 0, kstep, false); PG8_STA(PG8_SA(1, 0), 0, kstep, false); PG8_STB(PG8_SB(1, 1), 1, kstep, false);
    PG8_WAIT_V(6); PG8_BAR;
    bool has_next = S.next(1, nxt);
    if constexpr (!Sched::GATHER) nA = has_next ? (const char*)g.A + (size_t)nxt.pm * tstepA : cA;
    nB = has_next ? (const char*)g.Bt + (size_t)nxt.e * g.b_estride * 2 + (size_t)nxt.pn * tstepB : cB;
    if constexpr (Sched::GATHER) {
        u32x4 pk; pk.x = cG0[0]; pk.y = cG0[1]; pk.z = cG1[0]; pk.w = cG1[1];
        if (has_next) {
            int R0, C0, R1, C1; stage_rc((wid * 64 + fresh_lane()) * 16, R0, C0); stage_rc((wid * 64 + fresh_lane()) * 16 + 8192, R1, C1);
            pk.x = (S.row_off(nxt, R0) + (unsigned)C0) * 2u; pk.y = (S.row_off(nxt, R1) + (unsigned)C1) * 2u; pk.z = (S.row_off(nxt, HALF + R0) + (unsigned)C0) * 2u; pk.w = (S.row_off(nxt, HALF + R1) + (unsigned)C1) * 2u; }
        *park = pk;
    }
    for (;;) {
#ifndef KREP
#define KREP 1
#endif
        for (int pass_ = 0; pass_ < KREP; ++pass_) {
        if (KREP > 1 && pass_ > 0) {
#pragma unroll
            for (int a = 0; a < 2; ++a)
#pragma unroll
                for (int b = 0; b < 2; ++b)
#pragma unroll
                    for (int m = 0; m < 4; ++m)
#pragma unroll
                        for (int n = 0; n < 2; ++n) acc[a][b][m][n] = (f32x4){0.f, 0.f, 0.f, 0.f}; }
#pragma unroll 1
        for (int t = 0; t < nt; t += 2) {
            const bool lastk = (t == nt - 2), last = lastk && (pass_ == KREP - 1);
            const size_t k1 = (size_t)(t + 1) * kstep, k2 = lastk ? (size_t)0 : (size_t)(t + 2) * kstep, k3 = k2 + kstep;
            if (last && has_next) S.a_ready(nxt);
            if constexpr (Sched::GATHER) { if (t == 2 && pass_ == KREP - 1 && has_next) { Unit n2;
                    if (S.next(ui + 2, n2) && wid < 4) { const char* src = (const char*)S.idx_src(n2) + wid * 256; unsigned off = (unsigned)fresh_lane() * 4u; asm volatile("" : "+s"(src), "+v"(off));
                        __builtin_amdgcn_global_load_lds((const unsigned*)(src + off), (PG8_LAS unsigned*)(lds + STAGE_BYTES + 512 + 1024) + wid * 64, 4, 0, 0); } } }
            if constexpr (Epi::MIDK) { if (t == Epi::MIDT && pass_ == KREP - 1) { const int el = fresh_lane(); E.mid(acc, cur, wr, wc, el & 15, el >> 4); } }
            PG8_LDB(B0, 0, 0); PG8_LDB(B1, 0, 1); PG8_SCHED; PG8_LDA(At, 0, 0); PG8_STA(PG8_SA(1, 1), 1, k1, false);
            if constexpr (Sched::GATHER) { if (last) { const u32x4 pk = *park; cG0[0] = pk.x; cG0[1] = pk.y; cG1[0] = pk.z; cG1[1] = pk.w; } }
            PG8_WAIT_V(8); PG8_WAIT_L(0); PG8_BAR; PG8_MMA(0, 0, At, B0); PG8_MMA(0, 1, At, B1); PG8_BAR; PG8_SCHED;
            PG8_LDA(At, 0, 1); PG8_STB(PG8_SB(0, 0), 0, k2, last); PG8_STB(PG8_SB(0, 1), 1, k2, last); PG8_STA(PG8_SA(0, 0), 0, k2, last);
            PG8_WAIT_V(8); PG8_WAIT_L(0); PG8_BAR; PG8_MMA(1, 0, At, B0); PG8_MMA(1, 1, At, B1); PG8_BAR; PG8_SCHED;
            PG8_LDB(B0, 1, 0); PG8_LDB(B1, 1, 1); PG8_SCHED; PG8_LDA(At, 1, 0); PG8_STA(PG8_SA(0, 1), 1, k2, last);
            PG8_WAIT_V(8); PG8_WAIT_L(0); PG8_BAR; PG8_MMA(0, 0, At, B0); PG8_MMA(0, 1, At, B1); PG8_BAR; PG8_SCHED;
            PG8_LDA(At, 1, 1); PG8_STB(PG8_SB(1, 0), 0, k3, last); PG8_STB(PG8_SB(1, 1), 1, k3, last); PG8_STA(PG8_SA(1, 0), 0, k3, last);
            PG8_WAIT_V(8); PG8_WAIT_L(0); PG8_BAR; PG8_MMA(1, 0, At, B0); PG8_MMA(1, 1, At, B1); PG8_BAR; PG8_SCHED;
        }
        }
        Unit nn; const bool has_nn = has_next && S.next(ui + 2, nn);
        u32x4 pkn = {0u, 0u, 0u, 0u};
        if constexpr (ALIGN_EPI) { if (wr == 0) PG8_BAR; }
#ifndef EREP
#define EREP 1
#endif
        { const int el = fresh_lane(); E(acc, cur, wr, wc, el & 15, el >> 4); }
        if constexpr (EREP > 1 && Epi::IDEMPOTENT) { asm volatile("s_waitcnt vmcnt(0)" ::: "memory"); const int el = fresh_lane(); E(acc, cur, wr, wc, el & 15, el >> 4); }
        S.done(cur);
        if (!has_next) break;
#pragma unroll
        for (int a = 0; a < 2; ++a)
#pragma unroll
            for (int b = 0; b < 2; ++b)
#pragma unroll
                for (int m = 0; m < 4; ++m)
#pragma unroll
                    for (int n = 0; n < 2; ++n) acc[a][b][m][n] = (f32x4){0.f, 0.f, 0.f, 0.f};
        cur = nxt; cA = nA; cB = nB; ++ui;
        nxt = nn; has_next = has_nn;
        if constexpr (!Sched::GATHER) nA = has_next ? (const char*)g.A + (size_t)nxt.pm * tstepA : cA;
        nB = has_next ? (const char*)g.Bt + (size_t)nxt.e * g.b_estride * 2 + (size_t)nxt.pn * tstepB : cB;
        if constexpr (Sched::GATHER) { int R0, C0, R1, C1; stage_rc((wid * 64 + fresh_lane()) * 16, R0, C0); stage_rc((wid * 64 + fresh_lane()) * 16 + 8192, R1, C1);
            const int nvm = (has_nn ? nn.nv : 1) - 1;
            const int q0 = R0 < nvm ? R0 : nvm, q1 = R1 < nvm ? R1 : nvm, q2 = HALF + R0 < nvm ? HALF + R0 : nvm, q3 = HALF + R1 < nvm ? HALF + R1 : nvm;
            pkn.x = (S.row_fin(gidx[q0]) + (unsigned)C0) * 2u; pkn.y = (S.row_fin(gidx[q1]) + (unsigned)C1) * 2u; pkn.z = (S.row_fin(gidx[q2]) + (unsigned)C0) * 2u; pkn.w = (S.row_fin(gidx[q3]) + (unsigned)C1) * 2u;
            if (!has_next) { pkn.x = cG0[0]; pkn.y = cG0[1]; pkn.z = cG1[0]; pkn.w = cG1[1]; } *park = pkn; }
        if constexpr (ALIGN_EPI) { if (wr == 1) PG8_BAR; }
    }
    PG8_WAIT_V(0);
    if constexpr (!ALIGN_EPI) { if (wr == 0) PG8_BAR; }
    PG8_BAR;
#undef PG8_SA
#undef PG8_SB
#undef PG8_DMA
#undef PG8_STA
#undef PG8_STB
#undef PG8_LDA
#undef PG8_LDB
#undef PG8_MMA
#undef PG8_CAT
#undef PG8_WAIT_V
#undef PG8_WAIT_L
#undef PG8_BAR
#undef PG8_SCHED
}
}
namespace attn_body {
using bf16=__hip_bfloat16;
using bf16x8=__attribute__((ext_vector_type(8)))short;
using s16x4=__attribute__((ext_vector_type(4)))short;
using f32x16=__attribute__((ext_vector_type(16)))float;
using u32x4=__attribute__((ext_vector_type(4)))unsigned;
constexpr int SEQ=2048,D=64,DM=512;
constexpr int NW=8,QBLK=32,QB=QBLK*NW,KVBLK=64,NQB=SEQ/QB;
constexpr int ATTN_PITCH=DM, ATTN_UNIT_ROWS=QB;
__device__ __forceinline__ int crow(int r,int hi){return (r&3)+8*(r>>2)+4*hi;}
#define SBAR() __builtin_amdgcn_sched_barrier(0)
__device__ __forceinline__ void cmask(f32x16&p0,f32x16&p1,int jb,int qrel,int hi){
  const float NEG=-INFINITY; int kb=64*jb+4*hi;
  #pragma unroll
  for(int r=0;r<16;++r){int kv=kb+(r&3)+8*(r>>2); if(kv>qrel)p0[r]=NEG; if(kv+32>qrel)p1[r]=NEG;}
}

constexpr int NSLOT=3, SLOTB=8192;
constexpr int LDS_K=0, LDS_V=NSLOT*SLOTB, LDS_WS=2*NSLOT*SLOTB, LDS_OST=LDS_WS+NW*64*4, LDS_BYTES=LDS_OST+NW*4096;
constexpr float C2=0.125f*1.4426950408889634f;
__device__ __forceinline__ void glds16(const void*gsrc,unsigned lds_dst){unsigned keep;
  asm volatile("s_mov_b32 %0, m0\n\ts_mov_b32 m0, %2\n\ts_nop 0\n\tglobal_load_lds_dwordx4 %1, off\n\ts_mov_b32 m0, %0":"=&s"(keep):"v"(gsrc),"s"(lds_dst):"memory");}
__device__ __forceinline__ float max3f(float a,float b,float c){float r;asm("v_max3_f32 %0, %1, %2, %3":"=v"(r):"v"(a),"v"(b),"v"(c));return r;}
__device__ __forceinline__ float max2f(float a,float b){float r;asm("v_max_f32_e32 %0, %1, %2":"=v"(r):"v"(a),"v"(b));return r;}
__device__ __forceinline__ float fadd_s(float a,float b){float r;asm("v_add_f32_e32 %0, %1, %2":"=v"(r):"v"(a),"v"(b));return r;}
__device__ __forceinline__ float fsub_s(float a,float b){float r;asm("v_sub_f32_e32 %0, %1, %2":"=v"(r):"v"(a),"v"(b));return r;}
typedef float f32x2_t __attribute__((ext_vector_type(2))); typedef __bf16 bf16x2_t __attribute__((ext_vector_type(2)));
__device__ __forceinline__ unsigned cvtpk_s(float lo,float hi){f32x2_t v={lo,hi};bf16x2_t b=__builtin_convertvector(v,bf16x2_t);return __builtin_bit_cast(unsigned,b);}
#define WAIT_BAR(N) asm volatile("s_waitcnt vmcnt(" #N ") lgkmcnt(0)\n\ts_barrier":::"memory")

__device__ __forceinline__ void qkt(f32x16&p0,f32x16&p1,const char*Kslot,const bf16x8*qr,const f32x16&negm,int r32,int hi){
  const char*kb=Kslot+hi*1024+r32*16;
  #pragma unroll
  for(int d0=0;d0<4;++d0){
    const bf16x8 b0=*reinterpret_cast<const bf16x8*>(kb+d0*2048);
    const bf16x8 b1=*reinterpret_cast<const bf16x8*>(kb+d0*2048+512);
    if(d0==0){p0=__builtin_amdgcn_mfma_f32_32x32x16_bf16(b0,qr[0],negm,0,0,0);p1=__builtin_amdgcn_mfma_f32_32x32x16_bf16(b1,qr[0],negm,0,0,0);}
    else{p0=__builtin_amdgcn_mfma_f32_32x32x16_bf16(b0,qr[d0],p0,0,0,0);p1=__builtin_amdgcn_mfma_f32_32x32x16_bf16(b1,qr[d0],p1,0,0,0);}}
}
typedef __attribute__((address_space(3))) const char* lds_cptr;
typedef short v4i16_t __attribute__((ext_vector_type(4)));
__device__ __forceinline__ void kload8(bf16x8*kf,lds_cptr kp){
  kf[0]=*(const __attribute__((address_space(3))) bf16x8*)(kp);      kf[1]=*(const __attribute__((address_space(3))) bf16x8*)(kp+512);
  kf[2]=*(const __attribute__((address_space(3))) bf16x8*)(kp+2048); kf[3]=*(const __attribute__((address_space(3))) bf16x8*)(kp+2560);
  kf[4]=*(const __attribute__((address_space(3))) bf16x8*)(kp+4096); kf[5]=*(const __attribute__((address_space(3))) bf16x8*)(kp+4608);
  kf[6]=*(const __attribute__((address_space(3))) bf16x8*)(kp+6144); kf[7]=*(const __attribute__((address_space(3))) bf16x8*)(kp+6656);
}
__device__ __forceinline__ void kload2(bf16x8*kf,lds_cptr kp,int j){ kf[2*j]=*(const __attribute__((address_space(3))) bf16x8*)(kp+j*2048); kf[2*j+1]=*(const __attribute__((address_space(3))) bf16x8*)(kp+j*2048+512); }
__device__ __forceinline__ s16x4 vtr(lds_cptr p){ return __builtin_bit_cast(s16x4,__builtin_amdgcn_ds_read_tr16_b64_v4i16((__attribute__((address_space(3))) v4i16_t*)p)); }
__device__ __forceinline__ float rowmax(const f32x16&p0,const f32x16&p1){
  float a=max3f(p0[0],p0[1],p1[0]),b=max3f(p0[2],p0[3],p1[1]);a=max3f(a,p1[2],p1[3]);
  #pragma unroll
  for(int r=4;r<16;r+=4){a=max3f(a,p0[r],p0[r+1]);b=max3f(b,p0[r+2],p0[r+3]);a=max3f(a,p1[r],p1[r+1]);b=max3f(b,p1[r+2],p1[r+3]);}
  const float m=max2f(a,b);
  auto rr=__builtin_amdgcn_permlane32_swap(__float_as_uint(m),__float_as_uint(m),false,false);
  return max2f(__uint_as_float(rr[0]),__uint_as_float(rr[1]));
}
__device__ __forceinline__ void pv(f32x16*o,int vb,bf16x8 pa0,bf16x8 pa1,bf16x8 pa2,bf16x8 pa3){
  #pragma unroll
  for(int d0=0;d0<2;++d0){s16x4 lo[4],hi[4];
    #pragma unroll
    for(int ks=0;ks<4;++ks){
      asm volatile("ds_read_b64_tr_b16 %0,%1 offset:%c2":"=&v"(lo[ks]):"v"(vb),"i"(d0*4096+ks*1024):"memory");
      asm volatile("ds_read_b64_tr_b16 %0,%1 offset:%c2":"=&v"(hi[ks]):"v"(vb),"i"(d0*4096+ks*1024+512):"memory");}
    asm volatile("s_waitcnt lgkmcnt(0)":::"memory");SBAR();
    #define PK(k) (bf16x8){lo[k][0],lo[k][1],lo[k][2],lo[k][3],hi[k][0],hi[k][1],hi[k][2],hi[k][3]}
    o[d0]=__builtin_amdgcn_mfma_f32_32x32x16_bf16(pa0,PK(0),o[d0],0,0,0);
    o[d0]=__builtin_amdgcn_mfma_f32_32x32x16_bf16(pa1,PK(1),o[d0],0,0,0);
    o[d0]=__builtin_amdgcn_mfma_f32_32x32x16_bf16(pa2,PK(2),o[d0],0,0,0);
    o[d0]=__builtin_amdgcn_mfma_f32_32x32x16_bf16(pa3,PK(3),o[d0],0,0,0);
    #undef PK
  }
}

#ifndef ATTN_STORE16
#define ATTN_STORE16(p,v) (*(u32x4*)(p)=(v))
#endif
template<int THRL> __device__ __forceinline__ void attn_unit(bool pre,bool has_nx,int nb,int nqkc,int nqb,bf16x8(&qr)[4],int wid_s,int b,int qkc,int voc,int qb,const bf16*Q,const bf16*__restrict__ K,const bf16*__restrict__ V,bf16*O,char*shm){
  const int wid=wid_s,lane=fresh_lane(),tid=wid*64+lane,r32=lane&31,hi=lane>>5;
  const long rowbase=(long)b*SEQ; const int q0=qb*QB;
  const bf16*Qw=Q+(rowbase+q0+wid*QBLK)*DM+qkc;
  const bf16*Kh=K+rowbase*DM+qkc,*Vh=V+rowbase*DM+voc;
  const unsigned lds0=(unsigned)(uintptr_t)shm;
  float*wsf=(float*)(shm+LDS_WS)+wid*64;
  const bf16*ksrc=Kh+(long)lane*DM+wid*8;
  const bf16*vsrc=Vh+(long)(16*(wid&3)+(lane>>2))*DM+(wid>>2)*32+(lane&3)*8;
  const unsigned kdst=lds0+LDS_K+wid*1024, vdst=lds0+LDS_V+wid*1024;
  #define DMA_K(t,slot) glds16(ksrc+(long)(t)*KVBLK*DM,(unsigned)__builtin_amdgcn_readfirstlane(kdst+(slot)))
  #define DMA_V(t,slot) glds16(vsrc+(long)(t)*KVBLK*DM,(unsigned)__builtin_amdgcn_readfirstlane(vdst+(slot)))
  const int vb0=(int)(lds0+LDS_V)+((lane>>4)&1)*32+(lane&3)*8+(4*hi+((lane&15)>>2))*64;
  const char*Kbase=shm+LDS_K; bf16x8 kf[8];
  const lds_cptr shm3=(lds_cptr)shm; const lds_cptr kp0=shm3+LDS_K+hi*1024+r32*16; const lds_cptr vp0=shm3+LDS_V+((lane>>4)&1)*32+(lane&3)*8+(4*hi+((lane&15)>>2))*64;
  const int NT=(q0+QB)/KVBLK;
  if(!pre){DMA_K(0,0);} DMA_V(0,0); if(!pre){DMA_K(1,SLOTB);}
  #pragma unroll
  for(int d0=0;d0<4;++d0){ if(!pre)qr[d0]=*reinterpret_cast<const bf16x8*>(&Qw[(long)r32*DM+d0*16+hi*8]); }
  float mhat=0.f,l_reg=0.f;f32x16 o[2];o[0]=f32x16{};o[1]=f32x16{};f32x16 negm=f32x16{};asm volatile("":"+v"(negm));
  const int qrel=wid*QBLK+r32;
  #define CMASK(P0,P1,t) do{int jb_=(t)-(NT-4); if(jb_>=0)cmask(P0,P1,jb_,qrel,hi);}while(0)
  bool resc=false;
  #define START(P0,P1) do{ const float rm=rowmax(P0,P1); resc=false; \
    { const float dl=rm; mhat=fadd_s(mhat,dl); \
      _Pragma("unroll") for(int r=0;r<16;++r){P0[r]=fsub_s(P0[r],dl);P1[r]=fsub_s(P1[r],dl);} \
      _Pragma("unroll") for(int r=0;r<16;++r)negm[r]=-mhat; asm volatile("":"+v"(negm)); } \
    _Pragma("unroll") for(int r=0;r<16;++r)P0[r]=__builtin_amdgcn_exp2f(P0[r]); }while(0)
  #define RESC() do{ if(resc){ asm volatile("s_waitcnt lgkmcnt(0)":::"memory"); \
      _Pragma("unroll") for(int d_=0;d_<2;++d_) _Pragma("unroll") for(int r=0;r<16;++r)o[d_][r]*=wsf[crow(r,hi)]; } }while(0)
  f32x16 pA0,pA1,pB0,pB1;
  int sl_prev=0,sl_cur=0,sl_next=SLOTB;
  #define ROT() do{sl_prev=sl_cur;sl_cur=sl_next;sl_next=(sl_next==(NSLOT-1)*SLOTB)?0:sl_next+SLOTB;}while(0)
  if(!pre){ DMA_K(2,2*SLOTB); WAIT_BAR(3); } else { WAIT_BAR(1); }
  qkt(pA0,pA1,Kbase,qr,negm,r32,hi);asm volatile("s_nop 15\n\ts_nop 7":"+v"(pA0),"+v"(pA1));CMASK(pA0,pA1,0);
  START(pA0,pA1);
  _Pragma("unroll") for(int r=0;r<16;++r)pA1[r]=__builtin_amdgcn_exp2f(pA1[r]);
  WAIT_BAR(0);
  DMA_K(3,0);DMA_V(1,SLOTB);
  ROT();
  kload8(kf,kp0+sl_cur);
  WAIT_BAR(2);
  s16x4 vlo[8],vhi[8]; u32x4 pw0,pw1,pw2,pw3;
  #define PKW(P,B) cvtpk_s(P[B],P[B+1])
  #define PAF(k) __builtin_bit_cast(bf16x8,pw##k)
  #define VFR(i) (bf16x8){vlo[i][0],vlo[i][1],vlo[i][2],vlo[i][3],vhi[i][0],vhi[i][1],vhi[i][2],vhi[i][3]}
  #define PIN(x) asm volatile("":"+v"(x))
  #define MX3(a,b,c) __builtin_fmaxf(__builtin_fmaxf((a),(b)),(c))
  #define GAPA(MF,A0,A1,A2,A3,W0,W1,PW) do{ MF; sacc+=A0; sacc+=A1; sacc+=A2; sacc+=A3; PIN(sacc); W0; W1; PIN(PW); SBAR(); }while(0)
  #define EX(v) __builtin_amdgcn_exp2f(v)
  #define GAPB(MF,X,B) do{ MF; X[B]=EX(X[B]); X[B+1]=EX(X[B+1]); X[B+2]=EX(X[B+2]); X[B+3]=EX(X[B+3]); PIN(X); SBAR(); }while(0)
  #define VRD(i) do{ vlo[i]=vtr(vp_+(((i)>>2)*4096+((i)&3)*1024)); vhi[i]=vtr(vp_+(((i)>>2)*4096+((i)&3)*1024+512)); }while(0)
  #define KRD(G,j) do{ if(G){ kload2(kf,kp0+sl_next,j); SBAR(); } }while(0)
  #define STEP(C0,C1,P0,P1,t,GK,GV,GL) do{ SBAR(); \
    const lds_cptr vp_=vp0+sl_prev; \
    VRD(0); SBAR(); float sacc=(P0[0]+P0[1]); \
    GAPA(C0=__builtin_amdgcn_mfma_f32_32x32x16_bf16(kf[0],qr[0],negm,0,0,0), P0[2],P0[3],P0[4],P0[5],     pw0[0]=PKW(P0,0), pw0[1]=PKW(P0,2), pw0); \
    VRD(4); SBAR(); GAPA(C1=__builtin_amdgcn_mfma_f32_32x32x16_bf16(kf[1],qr[0],negm,0,0,0), P0[6],P0[7],P0[8],P0[9],     pw0[2]=PKW(P0,4), pw0[3]=PKW(P0,6), pw0); \
    VRD(1); SBAR(); GAPA(C0=__builtin_amdgcn_mfma_f32_32x32x16_bf16(kf[2],qr[1],C0,0,0,0),   P0[10],P0[11],P0[12],P0[13], pw1[0]=PKW(P0,8), pw1[1]=PKW(P0,10), pw1); \
    VRD(5); SBAR(); GAPA(C1=__builtin_amdgcn_mfma_f32_32x32x16_bf16(kf[3],qr[1],C1,0,0,0),   P0[14],P0[15],P1[0],P1[1],   pw1[2]=PKW(P0,12),pw1[3]=PKW(P0,14), pw1); \
    VRD(2); SBAR(); GAPA(C0=__builtin_amdgcn_mfma_f32_32x32x16_bf16(kf[4],qr[2],C0,0,0,0),   P1[2],P1[3],P1[4],P1[5],     pw2[0]=PKW(P1,0), pw2[1]=PKW(P1,2), pw2); \
    VRD(6); SBAR(); GAPA(C1=__builtin_amdgcn_mfma_f32_32x32x16_bf16(kf[5],qr[2],C1,0,0,0),   P1[6],P1[7],P1[8],P1[9],     pw2[2]=PKW(P1,4), pw2[3]=PKW(P1,6), pw2); \
    VRD(3); SBAR(); GAPA(C0=__builtin_amdgcn_mfma_f32_32x32x16_bf16(kf[6],qr[3],C0,0,0,0),   P1[10],P1[11],P1[12],P1[13], pw3[0]=PKW(P1,8), pw3[1]=PKW(P1,10), pw3); \
    VRD(7); SBAR(); GAPA(C1=__builtin_amdgcn_mfma_f32_32x32x16_bf16(kf[7],qr[3],C1,0,0,0),   P1[14],P1[15],0.f,0.f,       pw3[2]=PKW(P1,12),pw3[3]=PKW(P1,14), pw3); \
    l_reg+=sacc; \
    if(GK){DMA_K((t)+3,sl_cur);} if(GV){DMA_V((t)+1,sl_next);} \
    CMASK(C0,C1,t); \
    { float a=MX3(C0[0],C0[1],C1[0]),b=MX3(C0[2],C0[3],C1[1]); a=MX3(a,C1[2],C1[3]); \
      _Pragma("unroll") for(int r=4;r<16;r+=4){a=MX3(a,C0[r],C0[r+1]);b=MX3(b,C0[r+2],C0[r+3]);a=MX3(a,C1[r],C1[r+1]);b=MX3(b,C1[r+2],C1[r+3]);} \
      float rm=__builtin_fmaxf(a,b); { auto rr=__builtin_amdgcn_permlane32_swap(__float_as_uint(rm),__float_as_uint(rm),false,false); rm=__builtin_fmaxf(__uint_as_float(rr[0]),__uint_as_float(rr[1])); } \
      resc=false; \
      if(__builtin_expect(__any(rm>(float)THRL),0)){ const float dl=__builtin_fmaxf(rm,0.f); mhat+=dl; \
        _Pragma("unroll") for(int r=0;r<16;++r){C0[r]-=dl;C1[r]-=dl;} \
        _Pragma("unroll") for(int r=0;r<16;++r)negm[r]=-mhat; asm volatile("":"+v"(negm)); \
        const float f=__builtin_amdgcn_exp2f(-dl); l_reg*=f; if(hi==0)wsf[r32]=f; resc=true; } } \
    SBAR(); \
    GAPB(o[0]=__builtin_amdgcn_mfma_f32_32x32x16_bf16(PAF(0),VFR(0),o[0],0,0,0), C0,0); \
    GAPB(o[1]=__builtin_amdgcn_mfma_f32_32x32x16_bf16(PAF(0),VFR(4),o[1],0,0,0), C0,4); \
    KRD(GL,0); GAPB(o[0]=__builtin_amdgcn_mfma_f32_32x32x16_bf16(PAF(1),VFR(1),o[0],0,0,0), C0,8); \
    KRD(GL,1); GAPB(o[1]=__builtin_amdgcn_mfma_f32_32x32x16_bf16(PAF(1),VFR(5),o[1],0,0,0), C0,12); \
    KRD(GL,2); GAPB(o[0]=__builtin_amdgcn_mfma_f32_32x32x16_bf16(PAF(2),VFR(2),o[0],0,0,0), C1,0); \
    KRD(GL,3); GAPB(o[1]=__builtin_amdgcn_mfma_f32_32x32x16_bf16(PAF(2),VFR(6),o[1],0,0,0), C1,4); \
    GAPB(o[0]=__builtin_amdgcn_mfma_f32_32x32x16_bf16(PAF(3),VFR(3),o[0],0,0,0), C1,8); \
    GAPB(o[1]=__builtin_amdgcn_mfma_f32_32x32x16_bf16(PAF(3),VFR(7),o[1],0,0,0), C1,12); \
    }while(0)
  int t=1;
  #undef CMASK
  #define CMASK(P0,P1,t) do{}while(0)
  for(;t+5<NT;t+=2){
    STEP(pB0,pB1,pA0,pA1,t,true,true,true);     WAIT_BAR(2); RESC(); ROT();
    STEP(pA0,pA1,pB0,pB1,t+1,true,true,true);   WAIT_BAR(2); RESC(); ROT();
  }
  #undef CMASK
  #define CMASK(P0,P1,t) do{int jb_=(t)-(NT-4); if(jb_>=0)cmask(P0,P1,jb_,qrel,hi);}while(0)
  #define ENDW(tt) do{ if((tt)+3<NT){WAIT_BAR(2);} else if((tt)+2<NT){WAIT_BAR(1);} else {WAIT_BAR(0);} }while(0)
  for(;t+1<NT;t+=2){
    STEP(pB0,pB1,pA0,pA1,t,(t+3<NT),(t+1<NT),(t+1<NT));       ENDW(t);   RESC(); ROT();
    STEP(pA0,pA1,pB0,pB1,t+1,(t+4<NT),(t+2<NT),(t+2<NT));     ENDW(t+1); RESC(); ROT();
  }
  STEP(pB0,pB1,pA0,pA1,NT-1,false,false,false); RESC();
  if(has_nx){ const bf16*kn=ksrc+((long)(nb-b)*SEQ*DM+(nqkc-qkc));
    glds16(kn,(unsigned)__builtin_amdgcn_readfirstlane(kdst)); glds16(kn+(long)KVBLK*DM,(unsigned)__builtin_amdgcn_readfirstlane(kdst+SLOTB)); glds16(kn+(long)2*KVBLK*DM,(unsigned)__builtin_amdgcn_readfirstlane(kdst+2*SLOTB));
    const bf16*Qn=Q+((long)nb*SEQ+nqb*QB+wid*QBLK)*DM+nqkc; const int ln_=fresh_lane(); const unsigned qo_=(unsigned)((ln_&31)*DM+(ln_>>5)*8);
    #pragma unroll
    for(int d0=0;d0<4;++d0)qr[d0]=*reinterpret_cast<const bf16x8*>(&Qn[qo_+d0*16]); }
  { float sacc=pB0[0]+pB0[1]; _Pragma("unroll") for(int r=2;r<16;++r)sacc+=pB0[r]; _Pragma("unroll") for(int r=0;r<16;++r)sacc+=pB1[r]; l_reg+=sacc;
    pw0=(u32x4){PKW(pB0,0),PKW(pB0,2),PKW(pB0,4),PKW(pB0,6)};pw1=(u32x4){PKW(pB0,8),PKW(pB0,10),PKW(pB0,12),PKW(pB0,14)};pw2=(u32x4){PKW(pB1,0),PKW(pB1,2),PKW(pB1,4),PKW(pB1,6)};pw3=(u32x4){PKW(pB1,8),PKW(pB1,10),PKW(pB1,12),PKW(pB1,14)};
    SBAR(); pv(o,vb0+sl_cur,PAF(0),PAF(1),PAF(2),PAF(3)); }
  #undef PKW
  #undef PAF
  #undef VFR
  #undef PIN
  #undef MX3
  #undef GAPA
  #undef GAPB
  #undef EX
  #undef VRD
  #undef KRD
  #undef STEP
  #undef ENDW
  {auto rr=__builtin_amdgcn_permlane32_swap(__float_as_uint(l_reg),__float_as_uint(l_reg),false,false);l_reg=__uint_as_float(rr[0])+__uint_as_float(rr[1]);}
  if(hi==0)wsf[32+r32]=l_reg;asm volatile("s_waitcnt lgkmcnt(0)":::"memory");
  float rli[16];
  #pragma unroll
  for(int r=0;r<16;++r)rli[r]=__builtin_amdgcn_rcpf(wsf[32+crow(r,hi)]);
  bf16*Ow=O+(rowbase+q0+wid*QBLK)*DM+voc;
  { bf16*stg=(bf16*)(shm+LDS_OST)+wid*2048;
    #pragma unroll
    for(int r=0;r<16;++r){const int orow=crow(r,hi);
      #pragma unroll
      for(int d0=0;d0<2;++d0)stg[orow*64+d0*32+r32]=__float2bfloat16(o[d0][r]*rli[r]);}
    asm volatile("s_waitcnt lgkmcnt(0)":::"memory");
    #pragma unroll
    for(int i=0;i<4;++i){const int row=i*8+(lane>>3),ch=lane&7; const u32x4 v=*(const u32x4*)(stg+row*64+ch*8); ATTN_STORE16(Ow+(long)row*DM+ch*8,v);} }
  asm volatile("s_waitcnt lgkmcnt(0)\n\ts_barrier":::"memory");
  #undef DMA_K
  #undef DMA_V
  #undef CMASK
  #undef START
  #undef RESC
  #undef ROT
}
constexpr int ATTN_LDS_BYTES=LDS_BYTES;
struct AttnPtrs { const bf16* Q; const bf16* K; const bf16* V; bf16* O1; bf16* O2; };
template<int THRL> __device__ __forceinline__ void attn_phase(char*lds,const AttnPtrs&T,int G,int vcu,int wid_s){
  #define ATTN_UNIT_OF(i,combo,qb,ok) do{ if(G==256){ ok=(i)<8; const int j=vcu&31; combo=(vcu&~31)+(j>>3)*8+(i); qb=((j&7)+(i))&7; } else { const int U=(i)*G+vcu; ok=U<2048; combo=U>>3; qb=7-(U&7); } }while(0)
  bf16x8 qr[4]={}; bool pre=false;
  for(int i=0;;++i){
    int combo,qb,ncombo,nqb; bool ok,nok; ATTN_UNIT_OF(i,combo,qb,ok); if(!ok)break; ATTN_UNIT_OF(i+1,ncombo,nqb,nok);
    const int vh=combo&1, c=(combo>>1)&1, h=(combo>>2)&3, b=combo>>4, nc=(ncombo>>1)&1, nh=(ncombo>>2)&3, nb=ncombo>>4;
    attn_unit<THRL>(pre,nok,nb,(2*nh+nc)*64,nqb,qr,wid_s,b,(2*h+c)*64,h*128+vh*64,qb,T.Q,T.K,T.V,c?T.O2:T.O1,lds);
    pre=nok;
  }
  #undef ATTN_UNIT_OF
}
#undef SBAR
#undef WAIT_BAR
}

#define GAS __attribute__((address_space(1)))
#define LAS __attribute__((address_space(3)))
typedef unsigned v4u __attribute__((ext_vector_type(4)));
typedef GAS unsigned gu32;
typedef GAS unsigned long long gu64;
#define RLX_AGENT __ATOMIC_RELAXED, __HIP_MEMORY_SCOPE_AGENT
#define LDS_WAIT() asm volatile("s_waitcnt lgkmcnt(0)" ::: "memory")
#define VM_WAIT() asm volatile("s_waitcnt vmcnt(0)" ::: "memory")
__device__ __forceinline__ unsigned long long rt() { return __builtin_amdgcn_s_memrealtime(); }

#define XB_TMO      128
#define XB_XCNT(j)  (256  + 64 * (j))
#define XB_XSUB(j)  (1280 + 64 * (j))
#define XB_XGEN(j)  (2304 + 64 * (j))
#define XB_TOP      3328
#define XB_TOPGEN   3392
#define XCD_BAR_WORDS 3456
#define XB_SPIN_CAP (1u << 18)

__device__ __forceinline__ unsigned xb_ld(unsigned* p)              { return __hip_atomic_load(p, __ATOMIC_RELAXED, __HIP_MEMORY_SCOPE_AGENT); }
__device__ __forceinline__ unsigned xb_add(unsigned* p, unsigned v) { return __hip_atomic_fetch_add(p, v, __ATOMIC_RELAXED, __HIP_MEMORY_SCOPE_AGENT); }
__device__ __forceinline__ unsigned xb_xcc_id() { return (unsigned)__builtin_amdgcn_s_getreg((3 << 11) | 20) & 0xFu; }
#define XB_SPIN(cond, bar) do { unsigned _sp = 0; while (cond) { __builtin_amdgcn_s_sleep(1); \
    if ((++_sp & 255u) == 0u) { if (xb_ld(&(bar)[XB_TMO])) break; if (_sp > XB_SPIN_CAP) { atomicAdd(&(bar)[XB_TMO], 1u); break; } } } } while (0)

struct XcdBarrier {
    int w;
    unsigned* bar; unsigned x;
    volatile LAS unsigned* st;
};

__device__ __forceinline__ XcdBarrier xcd_barrier_post(unsigned* bar, volatile LAS unsigned* st, int wave_s) {
    XcdBarrier b; b.w = wave_s; b.bar = bar; b.x = xb_xcc_id(); b.st = st;
    if (wave_s == 0 && fresh_lane() == 0) (void)xb_add(&bar[XB_XCNT(b.x)], 1u);
    return b;
}
__device__ __forceinline__ void xcd_barrier_complete(unsigned* bar, unsigned x, unsigned& nloc, unsigned& nx) {
    const unsigned G = gridDim.x * gridDim.y * gridDim.z;
    unsigned sum, cnt, mine, sp = 0u;
    for (;;) {
        sum = 0u; cnt = 0u; mine = 0u;
#pragma unroll
        for (unsigned j = 0; j < 16; ++j) { const unsigned c = xb_ld(&bar[XB_XCNT(j)]); sum += c; cnt += (c > 0u) ? 1u : 0u; mine = (j == x) ? c : mine; }
        if (sum == G) break;
        __builtin_amdgcn_s_sleep(1);
        if ((++sp & 255u) == 0u) { if (xb_ld(&bar[XB_TMO])) break; if (sp > XB_SPIN_CAP) { atomicAdd(&bar[XB_TMO], 1u); break; } }
    }
    nloc = mine > 0u ? mine : 1u; nx = cnt > 0u ? cnt : 1u;
}

__device__ __forceinline__ void xcd_barrier(const XcdBarrier& b) {
    asm volatile("s_waitcnt vmcnt(0)" ::: "memory");
    __syncthreads();
    if (b.w == 0 && fresh_lane() == 0) {
        unsigned* bar = b.bar;
        __builtin_amdgcn_s_waitcnt(0);
        unsigned nloc = b.st[0], nx = b.st[1];
        if (nloc == 0u) { xcd_barrier_complete(bar, b.x, nloc, nx); b.st[0] = nloc; b.st[1] = nx; }
        const unsigned old = xb_add(&bar[XB_XSUB(b.x)], 1u);
        const unsigned gen = old / nloc;
        if (old + 1u == (gen + 1u) * nloc) {
            __builtin_amdgcn_fence(__ATOMIC_RELEASE, "agent");
            asm volatile("s_waitcnt vmcnt(0)" ::: "memory");
            const unsigned og = xb_add(&bar[XB_TOP], 1u);
            const unsigned tg = og / nx;
            if (og + 1u == (tg + 1u) * nx) xb_add(&bar[XB_TOPGEN], 1u);
            else XB_SPIN(xb_ld(&bar[XB_TOPGEN]) == tg, bar);
            __builtin_amdgcn_fence(__ATOMIC_ACQUIRE, "agent");
            xb_add(&bar[XB_XGEN(b.x)], 1u);
            asm volatile("s_waitcnt vmcnt(0)" ::: "memory");
        } else {
            XB_SPIN(xb_ld(&bar[XB_XGEN(b.x)]) == gen, bar);
            __builtin_amdgcn_fence(__ATOMIC_ACQUIRE, "agent");
            asm volatile("s_waitcnt vmcnt(0)" ::: "memory");
        }
    }
    __syncthreads();
}

constexpr int NWAVES = 8;
constexpr int RING_OFF = 0, RING_BYTES = 131072;
constexpr int LDSCTL_OFF = RING_BYTES, MISC_OFF = LDSCTL_OFF + 320;
constexpr int RCTL_OFF = LDSCTL_OFF + 512;
constexpr int MOE_OFF = LDSCTL_OFF + 5120;
constexpr int CONV_OFF = LDSCTL_OFF + 6144;
constexpr int LDS_BYTES = 147456;
constexpr int CW_TMO = 0, CW_CODE = 1, CW_BAR = 4096;
constexpr int NPHASE = 12;
constexpr unsigned SKEW_P1 = 0u, SKEW_P7 = 0u, SKEW_P8 = 0u, SKEW_P4 = 0u, SKEW_P5 = 0u, SKEW_P10 = 0u;

struct Frame {
    LAS unsigned char* lds; volatile LAS unsigned* MISC; gu32* ctl;
    int wave, vcu, G;
    int local_ok;
};

template <int MODE> __device__ __forceinline__ int dst_row(int n) {
    if (MODE == 1) {
        if (n < 1536 || n >= 2560) return n;
        const int j = n - 1536; return j < 512 ? (6 + (j >> 7)) * 256 + (j & 127) : (6 + ((j - 512) >> 7)) * 256 + 128 + ((j - 512) & 127);
    } else if (MODE == 2) {
        const int j = n >> 1; return (j >> 7) * 256 + (n & 1) * 128 + (j & 127);
    }
    return n;
}
template <int MODE> __device__ __forceinline__ void p0_transpose_item(const float* __restrict__ W, int K, int N, bf16_t* __restrict__ WT, LAS float* scr, int item, int lane, int ldk = 0, int koff = 0) {
    if (ldk == 0) ldk = K;
    const int nblk = N / 32, kb = item / nblk, nb = item % nblk, k0 = 64 * kb, n0 = 32 * nb;
#pragma unroll 8
    for (int i = 0; i < 32; ++i) { const int kk = 2 * i + (lane >> 5); scr[kk * 33 + (lane & 31)] = W[(size_t)(k0 + kk) * N + n0 + (lane & 31)]; }
    LDS_WAIT(); asm volatile("" ::: "memory");
    const int c = lane & 7;
#pragma unroll
    for (int j = 0; j < 4; ++j) { const int n = (lane >> 3) + 8 * j; const LAS float* s = scr + (8 * c) * 33 + n;
        v4u o; o.x = pk2(s[0 * 33], s[1 * 33]); o.y = pk2(s[2 * 33], s[3 * 33]); o.z = pk2(s[4 * 33], s[5 * 33]); o.w = pk2(s[6 * 33], s[7 * 33]);
        *(GAS v4u*)(WT + (size_t)dst_row<MODE>(n0 + n) * ldk + koff + k0 + 8 * c) = o; }
    LDS_WAIT(); asm volatile("" ::: "memory");
}
template <int MODE> __device__ __forceinline__ void p0_transpose_item_fp8(const float* __restrict__ W, int K, int N, unsigned char* __restrict__ WT, LAS float* scr, int item, int lane, float S_W8, int ldk, int koff) {
    const int nblk = N / 32, kb = item / nblk, nb = item % nblk, k0 = 64 * kb, n0 = 32 * nb;
#pragma unroll 8
    for (int i = 0; i < 32; ++i) { const int kk = 2 * i + (lane >> 5); scr[kk * 33 + (lane & 31)] = W[(size_t)(k0 + kk) * N + n0 + (lane & 31)]; }
    LDS_WAIT(); asm volatile("" ::: "memory");
    const int c = lane & 3;
#pragma unroll
    for (int j = 0; j < 2; ++j) { const int n = (lane >> 2) + 16 * j; const LAS float* s = scr + (16 * c) * 33 + n;
        v4u o; o.x = pk4_fp8(s[0 * 33] * S_W8, s[1 * 33] * S_W8, s[2 * 33] * S_W8, s[3 * 33] * S_W8); o.y = pk4_fp8(s[4 * 33] * S_W8, s[5 * 33] * S_W8, s[6 * 33] * S_W8, s[7 * 33] * S_W8);
        o.z = pk4_fp8(s[8 * 33] * S_W8, s[9 * 33] * S_W8, s[10 * 33] * S_W8, s[11 * 33] * S_W8); o.w = pk4_fp8(s[12 * 33] * S_W8, s[13 * 33] * S_W8, s[14 * 33] * S_W8, s[15 * 33] * S_W8);
        *(GAS v4u*)(WT + (size_t)dst_row<MODE>(n0 + n) * ldk + koff + k0 + 16 * c) = o; }
    LDS_WAIT(); asm volatile("" ::: "memory");
}
struct MoeWTile { const float* W; unsigned char* WT; int K, N, k0, n0, mode; };
__device__ __forceinline__ MoeWTile moe_w_tile(int ti, const float* w_gu, const float* w_dn, unsigned char* Wgu_t, unsigned char* Wdn_t) {
    const int e = ti / 96, r = ti % 96; MoeWTile t;
    if (r < 64) { t.W = w_gu + (size_t)e * D * 2 * FF; t.WT = Wgu_t + (size_t)e * 2 * FF * D; t.K = D; t.N = 2 * FF; t.k0 = 64 * (r >> 2); t.n0 = 512 * (r & 3); t.mode = 2; }
    else { const int q = r - 64; t.W = w_dn + (size_t)e * FF * D; t.WT = Wdn_t + (size_t)e * D * FF; t.K = FF; t.N = D; t.k0 = 64 * (q >> 1); t.n0 = 512 * (q & 1); t.mode = 0; }
    return t;
}
struct P0Args { const float *x, *p, *g_mix, *w_in, *w_ao, *w_co, *w_o, *w_pg, *w_ple, *w_gu, *w_dn; bf16_t *Win_t, *Wao_t, *Wco_t, *Wo_t, *Wpg_t, *Wple_t; unsigned char *Wgu_t, *Wdn_t; bf16_t *XN, *PP; };
template <int PART>
__device__ __forceinline__ void p0_prologue(Frame& F, const P0Args& a) {
    LAS float* scr = (LAS float*)(F.lds + RING_OFF + F.wave * 16384);
    const int lane = fresh_lane(), tid = F.wave * 64 + lane;
    const int gw = F.vcu * NWAVES + F.wave, NGW = F.G * NWAVES;
    constexpr int I_IN = (D / 64) * (INC / 32), I_AO = (AW / 64) * (D / 32), I_O = (D / 64) * (D / 32), I_PLE = (PLE / 64) * (D / 32), I_GU = (D / 64) * (2 * FF / 32), I_DN = (FF / 64) * (D / 32);
    constexpr int NSMALL = I_IN + 2 * I_AO + 2 * I_O + I_PLE;
    if constexpr (PART & 1) { LAS float* tile = (LAS float*)(F.lds + RING_OFF); constexpr int PITCH = 513, NT = NE * 96;
      const int t = tid, kr = t >> 7, n4 = (t & 127) * 4, nl = t >> 2, c = t & 3;
      f32x4 r[16]; int ti = blockIdx.x;
      if (ti < NT) { const MoeWTile w = moe_w_tile(ti, a.w_gu, a.w_dn, a.Wgu_t, a.Wdn_t);
#pragma unroll
          for (int i = 0; i < 16; ++i) r[i] = *(const f32x4*)(w.W + (size_t)(w.k0 + 4 * i + kr) * w.N + w.n0 + n4); }
      for (; ti < NT; ti += F.G) {
          const MoeWTile w = moe_w_tile(ti, a.w_gu, a.w_dn, a.Wgu_t, a.Wdn_t);
#pragma unroll
          for (int i = 0; i < 16; ++i) { LAS float* p = tile + (4 * i + kr) * PITCH + n4; p[0] = r[i][0]; p[1] = r[i][1]; p[2] = r[i][2]; p[3] = r[i][3]; }
          __syncthreads();
          if (ti + F.G < NT) { const MoeWTile wn = moe_w_tile(ti + F.G, a.w_gu, a.w_dn, a.Wgu_t, a.Wdn_t);
#pragma unroll
              for (int i = 0; i < 16; ++i) r[i] = *(const f32x4*)(wn.W + (size_t)(wn.k0 + 4 * i + kr) * wn.N + wn.n0 + n4); }
#pragma unroll
          for (int q = 0; q < 4; ++q) { const int n = nl + 128 * q; const LAS float* s = tile + (16 * c) * PITCH + n; v4u o;
              o.x = pk4_fp8(s[0 * PITCH] * S_W8, s[1 * PITCH] * S_W8, s[2 * PITCH] * S_W8, s[3 * PITCH] * S_W8); o.y = pk4_fp8(s[4 * PITCH] * S_W8, s[5 * PITCH] * S_W8, s[6 * PITCH] * S_W8, s[7 * PITCH] * S_W8);
              o.z = pk4_fp8(s[8 * PITCH] * S_W8, s[9 * PITCH] * S_W8, s[10 * PITCH] * S_W8, s[11 * PITCH] * S_W8); o.w = pk4_fp8(s[12 * PITCH] * S_W8, s[13 * PITCH] * S_W8, s[14 * PITCH] * S_W8, s[15 * PITCH] * S_W8);
              const int ns = w.n0 + n, dr = w.mode == 2 ? dst_row<2>(ns) : ns;
              *(GAS v4u*)(w.WT + (size_t)dr * w.K + w.k0 + 16 * c) = o; }
          __syncthreads();
      } }
    if constexpr ((PART & 2) == 0) return;
    for (int it = gw; it < NSMALL; it += NGW) {
        int r = it;
        if (r < I_IN) { p0_transpose_item<1>(a.w_in, D, INC, a.Win_t, scr, r, lane); continue; } r -= I_IN;
        if (r < I_AO) { p0_transpose_item<0>(a.w_ao, AW, D, a.Wao_t, scr, r, lane, D, 0); continue; } r -= I_AO;
        if (r < I_AO) { p0_transpose_item<0>(a.w_co, CW, D, a.Wao_t, scr, r, lane, D, AW); continue; } r -= I_AO;
        if (r < I_O) { p0_transpose_item<0>(a.w_o, D, D, a.Wo_t, scr, r, lane); continue; } r -= I_O;
        if (r < I_O) { p0_transpose_item_fp8<0>(a.w_pg, D, D, (unsigned char*)a.Wpg_t, scr, r, lane, S_W8, UCW, PLE); continue; } r -= I_O;
        p0_transpose_item_fp8<0>(a.w_ple, PLE, D, (unsigned char*)a.Wpg_t, scr, r, lane, S_WPLE, UCW, 0);
    }
    { f32x4 gq[4];
#pragma unroll
      for (int j = 0; j < 4; ++j) gq[j] = ((const f32x4*)a.g_mix)[lane + 64 * j];
      f32x4 v[4], pv, vn[4], pn; int m = gw;
      if (m < M) { const f32x4* xr = (const f32x4*)(a.x + (size_t)m * D) + lane;
#pragma unroll
          for (int j = 0; j < 4; ++j) vn[j] = xr[64 * j];
          pn = ((const f32x4*)(a.p + (size_t)m * PLE))[lane]; }
      for (; m < M; m += NGW) {
#pragma unroll
          for (int j = 0; j < 4; ++j) v[j] = vn[j];
          pv = pn;
          if (m + NGW < M) { const f32x4* xr = (const f32x4*)(a.x + (size_t)(m + NGW) * D) + lane;
#pragma unroll
              for (int j = 0; j < 4; ++j) vn[j] = xr[64 * j];
              pn = ((const f32x4*)(a.p + (size_t)(m + NGW) * PLE))[lane]; }
          float s = 0.f;
#pragma unroll
          for (int j = 0; j < 4; ++j) s += v[j].x * v[j].x + v[j].y * v[j].y + v[j].z * v[j].z + v[j].w * v[j].w;
          const float rstd = rsqrtf(wave_sum(s) * (1.f / D) + EPS);
          u32x2* o8 = (u32x2*)(a.XN + (size_t)m * D) + lane;
#pragma unroll
          for (int j = 0; j < 4; ++j) { u32x2 w; w.x = pk2(v[j].x * rstd * gq[j].x, v[j].y * rstd * gq[j].y); w.y = pk2(v[j].z * rstd * gq[j].z, v[j].w * rstd * gq[j].w); o8[64 * j] = w; }
          ((unsigned*)((unsigned char*)a.PP + (size_t)m * UCW))[lane] = pk4_fp8(pv.x * S_P, pv.y * S_P, pv.z * S_P, pv.w * S_P);
      } }
}

template <int N> __device__ __forceinline__ void foldn(float (&v)[32], bool up, int mask) {
#pragma unroll
    for (int i = 0; i < N / 2; ++i) { const float mine = up ? v[i + N / 2] : v[i], other = up ? v[i] : v[i + N / 2]; v[i] = mine + __shfl_xor(other, mask); }
}
struct P3Args { const bf16_t *O1, *O2, *Z; const float *lq1, *lk1, *lq2, *lk2, *g_subln, *w_dw, *b_dw, *g_ln, *b_ln; bf16_t* AC; };
__device__ __forceinline__ void p3_combine_conv(Frame& F, const P3Args& a) {
    const int lane = fresh_lane(), wave = F.wave;
    const float lam = __expf(wave_sum(a.lq1[lane] * a.lk1[lane])) - __expf(wave_sum(a.lq2[lane] * a.lk2[lane])) + LAM_INIT;
    const int cg = wave & 3, th = wave >> 2, ch0 = cg * 128 + 2 * lane;
    f32x2 wk[KC];
#pragma unroll
    for (int k = 0; k < KC; ++k) wk[k] = *(const f32x2*)(a.w_dw + k * CW + ch0);
    const f32x2 bdw = *(const f32x2*)(a.b_dw + ch0), gl = *(const f32x2*)(a.g_ln + ch0), bl = *(const f32x2*)(a.b_ln + ch0);
    LAS float* part = (LAS float*)(F.lds + CONV_OFF);
    for (int chn = F.vcu; chn < M / 128; chn += F.G) {
        { const int c0 = lane * 8; const f32x4 g0 = *(const f32x4*)(a.g_subln + (c0 & 127)), g1 = *(const f32x4*)(a.g_subln + (c0 & 127) + 4);
          for (int q = 0; q < 16; q += 4) { const int m0 = chn * 128 + wave * 16 + q; u32x4 x1[4], x2[4];
#pragma unroll
            for (int u = 0; u < 4; ++u) { x1[u] = *(const u32x4*)(a.O1 + (size_t)(m0 + u) * AW + c0); x2[u] = *(const u32x4*)(a.O2 + (size_t)(m0 + u) * AW + c0); }
#pragma unroll
            for (int u = 0; u < 4; ++u) { float d[8]; float ss = 0.f;
#pragma unroll
                for (int i = 0; i < 4; ++i) { const unsigned ua = x1[u][i], ub = x2[u][i];
                    d[2 * i] = __uint_as_float(ua << 16) - lam * __uint_as_float(ub << 16); d[2 * i + 1] = __uint_as_float(ua & 0xffff0000u) - lam * __uint_as_float(ub & 0xffff0000u);
                    ss += d[2 * i] * d[2 * i] + d[2 * i + 1] * d[2 * i + 1]; }
                ss += __shfl_xor(ss, 1); ss += __shfl_xor(ss, 2); ss += __shfl_xor(ss, 4); ss += __shfl_xor(ss, 8);
                const float rstd = rsqrtf(ss * (1.f / 128.f) + EPS) * (1.f - LAM_INIT); u32x4 w;
                w.x = pk2(d[0] * rstd * g0.x, d[1] * rstd * g0.y); w.y = pk2(d[2] * rstd * g0.z, d[3] * rstd * g0.w); w.z = pk2(d[4] * rstd * g1.x, d[5] * rstd * g1.y); w.w = pk2(d[6] * rstd * g1.z, d[7] * rstd * g1.w);
                *(u32x4*)(a.AC + (size_t)(m0 + u) * D + c0) = w; } } }
        { const int ts = chn * 128 + th * 64, tseq = ts % SEQ;
          f32x2 zr[16 + KC - 1];
#pragma unroll
          for (int i = 0; i < 16 + KC - 1; ++i) { const bool ok = (tseq - (KC - 1) + i) >= 0; const unsigned v = ok ? *(const unsigned*)(a.Z + (size_t)(ts - (KC - 1) + i) * CW + ch0) : 0u; zr[i] = (f32x2){__uint_as_float(v << 16), __uint_as_float(v & 0xffff0000u)}; }
#pragma unroll 1
          for (int blk = 0; blk < 4; ++blk) {
            const int tok0 = ts + blk * 16;
            unsigned zn[16];
#pragma unroll
            for (int i = 0; i < 16; ++i) zn[i] = *(const unsigned*)(a.Z + (size_t)(blk < 3 ? tok0 + 16 + i : tok0) * CW + ch0);
            f32x2 y[16];
#pragma unroll
            for (int o = 0; o < 16; ++o) { f32x2 s = bdw;
#pragma unroll
                for (int k = 0; k < KC; ++k) s = wk[k] * zr[o + k] + s;
                y[o] = s; }
            float st[32];
#pragma unroll
            for (int o = 0; o < 16; ++o) { const f32x2 q = y[o] * y[o]; st[2 * o] = y[o].x + y[o].y; st[2 * o + 1] = q.x + q.y; }
            foldn<32>(st, lane & 32, 32); foldn<16>(st, lane & 16, 16); foldn<8>(st, lane & 8, 8); foldn<4>(st, lane & 4, 4); foldn<2>(st, lane & 2, 2);
            const float tot = st[0] + __shfl_xor(st[0], 1);
            LAS float* pb = part + (blk & 1) * 256 + th * 128;
            if ((lane & 1) == 0) pb[cg * 32 + (lane >> 1)] = tot;
            __syncthreads();
            float mean_l = 0.f, rstd_l = 0.f;
            if (lane < 16) { const float s1 = pb[2 * lane] + pb[32 + 2 * lane] + pb[64 + 2 * lane] + pb[96 + 2 * lane], s2 = pb[2 * lane + 1] + pb[32 + 2 * lane + 1] + pb[64 + 2 * lane + 1] + pb[96 + 2 * lane + 1];
                mean_l = s1 * (1.f / CW); const float var = fmaxf(s2 * (1.f / CW) - mean_l * mean_l, 0.f); rstd_l = rsqrtf(var + EPS); }
#pragma unroll
            for (int o = 0; o < 16; ++o) { const float mu = __builtin_bit_cast(float, __builtin_amdgcn_readlane(__builtin_bit_cast(int, mean_l), o)), rs = __builtin_bit_cast(float, __builtin_amdgcn_readlane(__builtin_bit_cast(int, rstd_l), o));
                f32x2 v = (y[o] - mu) * rs * gl + bl; v.x = v.x * pg8::fsig(v.x); v.y = v.y * pg8::fsig(v.y);
                *(unsigned*)(a.AC + (size_t)(tok0 + o) * D + AW + ch0) = pk2(v.x, v.y); }
#pragma unroll
            for (int i = 0; i < KC - 1; ++i) zr[i] = zr[i + 16];
#pragma unroll
            for (int i = 0; i < 16; ++i) zr[KC - 1 + i] = (f32x2){__uint_as_float(zn[i] << 16), __uint_as_float(zn[i] & 0xffff0000u)};
          } }
        __syncthreads();
    }
}

struct P6Args { const bf16_t* H; const float *g_ffn, *w_router, *b_router; unsigned char* U2;     int* topk_e; float* topk_g; int* list; unsigned* gcnt; };
__device__ __forceinline__ void p6_ins(unsigned long long (&v)[4], unsigned long long x) {
    const bool c0 = x > v[0], c1 = x > v[1], c2 = x > v[2], c3 = x > v[3];
    v[3] = c2 ? v[2] : (c3 ? x : v[3]); v[2] = c1 ? v[1] : (c2 ? x : v[2]); v[1] = c0 ? v[0] : (c1 ? x : v[1]); v[0] = c0 ? x : v[0];
}
__device__ __forceinline__ float p6_sumsq(unsigned w, float s) { const float lo = __uint_as_float(w << 16), hi = __uint_as_float(w & 0xffff0000u); return s + lo * lo + hi * hi; }
__device__ __forceinline__ void p6_router(Frame& F, const P6Args& a) {
    LAS unsigned* wT = (LAS unsigned*)(F.lds + RING_OFF); LAS int* lcnt = (LAS int*)(F.lds + RCTL_OFF); LAS int* lbase = lcnt + 32; LAS int* sl_e = lbase + 32; LAS int* sl_r = sl_e + 512; LAS float* sl_g = (LAS float*)(F.lds + CONV_OFF);
    const int lane = fresh_lane(), wave = F.wave, tid = wave * 64 + lane;
    for (int it = tid; it < (D / 2) * 8; it += 512) { const int k2 = it >> 3, c4 = it & 7; const float g0 = a.g_ffn[2 * k2], g1 = a.g_ffn[2 * k2 + 1];
        const f32x4 v0 = ((const f32x4*)a.w_router)[(2 * k2) * 8 + c4] * g0, v1 = ((const f32x4*)a.w_router)[(2 * k2 + 1) * 8 + c4] * g1;
#pragma unroll
        for (int i = 0; i < 4; ++i) { const int e = c4 * 4 + i; const unsigned h0 = f2bf(v0[i]), h1 = f2bf(v1[i]); const float r0 = v0[i] - __uint_as_float(h0 << 16), r1 = v1[i] - __uint_as_float(h1 << 16);
            const int w = e * (D / 2) + (k2 ^ (4 * (e & 15))); wT[w] = h0 | (h1 << 16); wT[NE * D / 2 + w] = f2bf(r0) | (f2bf(r1) << 16); } }
    if (tid < 32) lcnt[tid] = 0;
    __syncthreads();
    const int fr = lane & 15, fg = lane >> 4;
    f32x4 gg[4];
#pragma unroll
    for (int j = 0; j < 4; ++j) gg[j] = ((const f32x4*)a.g_ffn)[lane + 64 * j] * S_U2;
    const f32x4 bA = *(const f32x4*)(a.b_router + 4 * fg), bB = *(const f32x4*)(a.b_router + 16 + 4 * fg);
    for (int chn = F.vcu; chn < M / 128; chn += F.G) {
        const int t0 = chn * 128, tw = t0 + wave * 16;
        const bf16_t* hp = a.H + (size_t)(tw + fr) * D + fg * 8;
        const LAS unsigned* wp = wT + fr * (D / 2); const int sw = 4 * fr;
        f32x4 acc[2][2]; acc[0][0] = acc[0][1] = acc[1][0] = acc[1][1] = (f32x4){0.f, 0.f, 0.f, 0.f}; float ss = 0.f;
        u32x4 hv[8];
#pragma unroll
        for (int u = 0; u < 8; ++u) hv[u] = *(const u32x4*)(hp + 32 * u);
#pragma unroll 1
        for (int sb = 0; sb < 32; sb += 8) {
#pragma unroll
            for (int u = 0; u < 8; ++u) { const int s = sb + u; const u32x4 h = hv[u];
                if (sb + 8 < 32) hv[u] = *(const u32x4*)(hp + 32 * (s + 8));
                const int wo = (16 * s + 4 * fg) ^ sw;
                const pg8::bf16x8 w00 = *(const LAS pg8::bf16x8*)(wp + wo), w01 = *(const LAS pg8::bf16x8*)(wp + NE * D / 2 + wo), w10 = *(const LAS pg8::bf16x8*)(wp + 16 * (D / 2) + wo), w11 = *(const LAS pg8::bf16x8*)(wp + NE * D / 2 + 16 * (D / 2) + wo);
                ss = p6_sumsq(h.x, ss); ss = p6_sumsq(h.y, ss); ss = p6_sumsq(h.z, ss); ss = p6_sumsq(h.w, ss);
                const pg8::bf16x8 hb = __builtin_bit_cast(pg8::bf16x8, h);
                acc[0][0] = __builtin_amdgcn_mfma_f32_16x16x32_bf16(w00, hb, acc[0][0], 0, 0, 0); acc[0][1] = __builtin_amdgcn_mfma_f32_16x16x32_bf16(w01, hb, acc[0][1], 0, 0, 0);
                acc[1][0] = __builtin_amdgcn_mfma_f32_16x16x32_bf16(w10, hb, acc[1][0], 0, 0, 0); acc[1][1] = __builtin_amdgcn_mfma_f32_16x16x32_bf16(w11, hb, acc[1][1], 0, 0, 0); }
        }
        ss += __shfl_xor(ss, 16); ss += __shfl_xor(ss, 32);
        const float rn = rsqrtf(ss * (1.f / D) + EPS);
        unsigned long long v[4] = {0ull, 0ull, 0ull, 0ull};
#pragma unroll
        for (int blk = 0; blk < 2; ++blk)
#pragma unroll
            for (int i = 0; i < 4; ++i) { const float lg = (acc[blk][0][i] + acc[blk][1][i]) * rn + (blk ? bB[i] : bA[i]); const int e = 16 * blk + 4 * fg + i;
                unsigned ub = __float_as_uint(lg); ub = (ub & 0x80000000u) ? ~ub : (ub | 0x80000000u);
                p6_ins(v, ((unsigned long long)ub << 32) | (unsigned)(31 - e)); }
#pragma unroll
        for (int o = 16; o <= 32; o <<= 1) { unsigned long long p[4];
#pragma unroll
            for (int q = 0; q < 4; ++q) { const unsigned lo = __shfl_xor((unsigned)v[q], o), hi = __shfl_xor((unsigned)(v[q] >> 32), o); p[q] = ((unsigned long long)hi << 32) | lo; }
#pragma unroll
            for (int q = 0; q < 4; ++q) p6_ins(v, p[q]); }
        float tv[4];
#pragma unroll
        for (int q = 0; q < 4; ++q) { unsigned vb = (unsigned)(v[q] >> 32); vb = (vb & 0x80000000u) ? (vb & 0x7fffffffu) : ~vb; tv[q] = __uint_as_float(vb); }
        const float e1 = __expf(tv[1] - tv[0]), e2 = __expf(tv[2] - tv[0]), e3 = __expf(tv[3] - tv[0]), inv = 1.f / (1.f + e1 + e2 + e3);
        { const unsigned long long kk = fg == 0 ? v[0] : fg == 1 ? v[1] : fg == 2 ? v[2] : v[3]; const int e = 31 - (int)((unsigned)kk & 63u); const float gv = (fg == 0 ? 1.f : fg == 1 ? e1 : fg == 2 ? e2 : e3) * inv;
            const int m = tw + fr, sl = (wave * 16 + fr) * 4 + fg;
            a.topk_e[m * 4 + fg] = e; a.topk_g[m * 4 + fg] = gv;
            const int r = __hip_atomic_fetch_add(lcnt + e, 1, __ATOMIC_RELAXED, __HIP_MEMORY_SCOPE_WORKGROUP); sl_e[sl] = e; sl_r[sl] = r; sl_g[sl] = gv; }
#pragma unroll 1
        for (int hb8 = 0; hb8 < 16; hb8 += 8) { u32x2 raw[8][4];
#pragma unroll
            for (int q = 0; q < 8; ++q)
#pragma unroll
                for (int j = 0; j < 4; ++j) raw[q][j] = ((const u32x2*)(a.H + (size_t)(tw + hb8 + q) * D))[lane + 64 * j];
#pragma unroll
            for (int q = 0; q < 8; ++q) { const float rq = __int_as_float(__builtin_amdgcn_readlane(__float_as_int(rn), hb8 + q));
#pragma unroll
                for (int j = 0; j < 4; ++j) { const f32x4 sc = gg[j] * rq; const u32x2 w = raw[q][j];
                    ((unsigned*)(a.U2 + (size_t)(tw + hb8 + q) * D))[lane + 64 * j] = pk4_fp8(__uint_as_float(w.x << 16) * sc.x, __uint_as_float(w.x & 0xffff0000u) * sc.y, __uint_as_float(w.y << 16) * sc.z, __uint_as_float(w.y & 0xffff0000u) * sc.w); } } }
        __syncthreads();
        if (tid < 32) lbase[tid] = (int)__hip_atomic_fetch_add(a.gcnt + tid, (unsigned)lcnt[tid], __ATOMIC_RELAXED, __HIP_MEMORY_SCOPE_AGENT);
        __syncthreads();
        { const int e = sl_e[tid], pos = lbase[e] + sl_r[tid]; a.list[e * LIST_CAP + pos] = t0 * 4 + tid; ((float*)((char*)a.list + GLIST_DELTA))[e * LIST_CAP + pos] = sl_g[tid]; }
        __syncthreads();
        if (tid < 32) lcnt[tid] = 0;
        __syncthreads();
    }
}
__device__ __forceinline__ void moe_tables(Frame& F, const unsigned* gcnt) {
    LAS int* pmb = (LAS int*)(F.lds + MOE_OFF); LAS int* cnt = pmb + 64; LAS int* tu = pmb + 128; LAS unsigned short* ent = (LAS unsigned short*)(F.lds + CONV_OFF);
    const int tid = F.wave * 64 + fresh_lane();
    if (tid == 0) { int acc = 0; for (int e = 0; e < NE; ++e) { const int c = (int)__hip_atomic_load(gcnt + e, __ATOMIC_RELAXED, __HIP_MEMORY_SCOPE_AGENT); pmb[e] = acc; cnt[e] = c; acc += (c + 255) >> 8; } pmb[NE] = acc; tu[0] = acc; }
    __syncthreads();
    const int TU = tu[0];
    for (int mt = tid; mt < TU; mt += NWAVES * 64) { int e = 0;
#pragma unroll 1
        for (int k = 1; k < NE; ++k) if (pmb[k] <= mt) e = k;
        ent[mt] = (unsigned short)(e | ((mt - pmb[e]) << 5)); }
    __syncthreads();
}

__device__ __forceinline__ void p9_moe_combine(Frame& F, bf16_t* __restrict__ H, const unsigned char* __restrict__ Y, const float* __restrict__ g, unsigned char* __restrict__ U3) {
    const int NGW_ = F.G * NWAVES, own = (M % NGW_ == 0), gw = (F.vcu * NWAVES + F.wave) * (own ? M / NGW_ : 1), NGW = own ? 1 : NGW_, MEND = own ? gw + M / NGW_ : M, lane = fresh_lane(); constexpr float isy = 1.f / S_Y;
    f32x4 gg[4];
#pragma unroll
    for (int j = 0; j < 4; ++j) gg[j] = *(const f32x4*)(g + 16 * lane + 4 * j);
    u32x4 nh0 = {0u, 0u, 0u, 0u}, nh1 = nh0, ny[TOPK];
#pragma unroll
    for (int k = 0; k < TOPK; ++k) ny[k] = nh0;
    if (gw < MEND) { const u32x4* hr = (const u32x4*)(H + (size_t)gw * D + 16 * lane); nh0 = hr[0]; nh1 = hr[1];
#pragma unroll
        for (int k = 0; k < TOPK; ++k) ny[k] = *(const u32x4*)(Y + ((size_t)gw * TOPK + k) * D + 16 * lane); }
    for (int m = gw; m < MEND; m += NGW) {
        u32x4* hr = (u32x4*)(H + (size_t)m * D + 16 * lane); const u32x4 h0 = nh0, h1 = nh1; u32x4 y[TOPK];
#pragma unroll
        for (int k = 0; k < TOPK; ++k) y[k] = ny[k];
        if (m + NGW < MEND) { const u32x4* hn = (const u32x4*)(H + (size_t)(m + NGW) * D + 16 * lane); nh0 = hn[0]; nh1 = hn[1];
#pragma unroll
            for (int k = 0; k < TOPK; ++k) ny[k] = *(const u32x4*)(Y + ((size_t)(m + NGW) * TOPK + k) * D + 16 * lane); }
        f32x4 v[4]; pg8::unpack8(h0, v[0], v[1]); pg8::unpack8(h1, v[2], v[3]);
#pragma unroll
        for (int k = 0; k < TOPK; ++k)
#pragma unroll
            for (int j = 0; j < 4; ++j) { float a, b, c, d; unpk4_fp8(y[k][j], a, b, c, d); v[j][0] += a * isy; v[j][1] += b * isy; v[j][2] += c * isy; v[j][3] += d * isy; }
        hr[0] = pg8::pack8(v[0], v[1]); hr[1] = pg8::pack8(v[2], v[3]);
        float s = 0.f;
#pragma unroll
        for (int j = 0; j < 4; ++j) s += v[j][0] * v[j][0] + v[j][1] * v[j][1] + v[j][2] * v[j][2] + v[j][3] * v[j][3];
        const float rstd = rsqrtf(wave_sum(s) * (1.f / D) + EPS);
        u32x4 o;
#pragma unroll
        for (int j = 0; j < 4; ++j) { const f32x4 t = v[j] * (rstd * S_U2) * gg[j]; o[j] = pk4_fp8(t[0], t[1], t[2], t[3]); }
        *(u32x4*)(U3 + (size_t)m * UCW + PLE + 16 * lane) = o;
    }
}
__device__ __forceinline__ void p11_final(Frame& F, const bf16_t* __restrict__ H, const float* __restrict__ g, float* __restrict__ O) {
    const int NGW_ = F.G * NWAVES, own = (M % NGW_ == 0), gw = (F.vcu * NWAVES + F.wave) * (own ? M / NGW_ : 1), NGW = own ? 1 : NGW_, MEND = own ? gw + M / NGW_ : M, lane = fresh_lane();
    f32x4 gg[4];
#pragma unroll
    for (int j = 0; j < 4; ++j) gg[j] = *(const f32x4*)(g + 16 * lane + 4 * j);
    u32x4 n0a = {0u, 0u, 0u, 0u}, n0b = n0a, n1a = n0a, n1b = n0a;
    if (gw < MEND) { const u32x4* hr = (const u32x4*)(H + (size_t)gw * D + 16 * lane); n0a = hr[0]; n0b = hr[1]; }
    if (gw + NGW < MEND) { const u32x4* hr = (const u32x4*)(H + (size_t)(gw + NGW) * D + 16 * lane); n1a = hr[0]; n1b = hr[1]; }
    for (int m = gw; m < MEND; m += NGW) {
        const u32x4 ca = n0a, cb = n0b; n0a = n1a; n0b = n1b;
        if (m + 2 * NGW < MEND) { const u32x4* hn = (const u32x4*)(H + (size_t)(m + 2 * NGW) * D + 16 * lane); n1a = hn[0]; n1b = hn[1]; }
        f32x4 v[4]; pg8::unpack8(ca, v[0], v[1]); pg8::unpack8(cb, v[2], v[3]);
        float s = 0.f;
#pragma unroll
        for (int j = 0; j < 4; ++j) s += v[j][0] * v[j][0] + v[j][1] * v[j][1] + v[j][2] * v[j][2] + v[j][3] * v[j][3];
        const float rstd = rsqrtf(wave_sum(s) * (1.f / D) + EPS);
        f32x4* o = (f32x4*)(O + (size_t)m * D + 16 * lane);
#pragma unroll
        for (int j = 0; j < 4; ++j) o[j] = v[j] * rstd * gg[j];
    }
}

__device__ __forceinline__ void xcd_barrier_local(const XcdBarrier& b) {
    asm volatile("s_waitcnt vmcnt(0)" ::: "memory");
    __syncthreads();
    if (b.w == 0 && fresh_lane() == 0) {
        unsigned* bar = b.bar;
        __builtin_amdgcn_s_waitcnt(0);
        const unsigned nloc = b.st[0];
        const unsigned old = xb_add(&bar[XB_XSUB(b.x)], 1u), gen = old / nloc;
        if (old + 1u == (gen + 1u) * nloc) xb_add(&bar[XB_XGEN(b.x)], 1u);
        else XB_SPIN(xb_ld(&bar[XB_XGEN(b.x)]) == gen, bar);
        __builtin_amdgcn_fence(__ATOMIC_ACQUIRE, "agent");
        asm volatile("s_waitcnt vmcnt(0)" ::: "memory");
    }
    __syncthreads();
}
struct Args { const float* in[27]; float* out; unsigned char* ws; int ph_lo, ph_hi, li, pad; };
__global__ void __launch_bounds__(NWAVES * 64, 2) mega_fwd(Args args) {
    extern __shared__ __attribute__((aligned(16))) unsigned char lds[];
    Frame F;
    F.lds = (LAS unsigned char*)lds; F.MISC = (volatile LAS unsigned*)(F.lds + MISC_OFF);
    F.wave = __builtin_amdgcn_readfirstlane((int)threadIdx.x >> 6);
    F.G = gridDim.x; { const int bx = blockIdx.x; F.vcu = (F.G % 8 == 0) ? (bx % 8) * (F.G / 8) + bx / 8 : bx; }
    F.ctl = (gu32*)(args.ws + WS_CTL);
#define PHASE_ARGS() const __attribute__((address_space(4))) Args* ap_ = (const __attribute__((address_space(4))) Args*)__builtin_amdgcn_kernarg_segment_ptr(); asm volatile("" : "+s"(ap_)); unsigned char* const ws = ap_->ws
#define INP(i) (ap_->in[i])
#define WSP(T_, off) ((T_*)(ws + (off)))
    for (int u = F.wave * 64 + fresh_lane(); u < (LDS_BYTES - LDSCTL_OFF) / 4; u += NWAVES * 64) ((LAS unsigned*)(F.lds + LDSCTL_OFF))[u] = 0u;
    __syncthreads();
    XcdBarrier bar = xcd_barrier_post((unsigned*)(F.ctl + CW_BAR) + args.li * XCD_BAR_WORDS, F.MISC + 8, F.wave);
    if (F.wave == 0 && fresh_lane() == 0 && (bar.x != (unsigned)blockIdx.x % 8u || gridDim.x != 256u)) (void)__hip_atomic_fetch_or((unsigned*)(F.ctl + CW_MODE), 1u, __ATOMIC_RELAXED, __HIP_MEMORY_SCOPE_AGENT);
    F.local_ok = 0;
    const int lo = args.ph_lo, hi = args.ph_hi;
#ifndef PH_COMPILED
#define PH_COMPILED 0xFFF
#endif
#define IN(k) ((((PH_COMPILED) >> (k)) & 1) && lo <= (k) && (k) < hi)
#ifndef DUP_MASK
#define DUP_MASK 0
#endif
#define REPS(k) ((((DUP_MASK) >> (k)) & 1) + 1)
#ifndef LOCAL_SEAMS
#define LOCAL_SEAMS 0x6BE
#endif
#define SEAM(k) do { if (IN(k) && IN((k) + 1)) { if ((((LOCAL_SEAMS) >> (k)) & 1) && F.local_ok) xcd_barrier_local(bar); else xcd_barrier(bar); \
        if ((k) == 0) F.local_ok = __builtin_amdgcn_readfirstlane((int)(__hip_atomic_load((unsigned*)(F.ctl + CW_MODE), __ATOMIC_RELAXED, __HIP_MEMORY_SCOPE_AGENT) == 0u)); } } while (0)

    for (int r_ = 0; r_ < REPS(0); ++r_) { if (r_) xcd_barrier(bar);
    if (IN(0)) { PHASE_ARGS(); const P0Args a{INP(0), INP(1), INP(2), INP(3), INP(9), INP(14), INP(15), INP(25), INP(23), INP(19), INP(21),
            WSP(bf16_t, WS_WIN), WSP(bf16_t, WS_WSM), WSP(bf16_t, WS_WSM + 1 * MiB), WSP(bf16_t, WS_WSM + 2 * MiB), WSP(bf16_t, WS_WSM + 4 * MiB), WSP(bf16_t, WS_WSM + 6 * MiB), WSP(unsigned char, WS_WGU), WSP(unsigned char, WS_WDN), WSP(bf16_t, WS_XN), WSP(bf16_t, WS_UC)};
        p0_prologue<2>(F, a); }
    }
    SEAM(0);
    for (int r_ = 0; r_ < REPS(1); ++r_) { if (r_) xcd_barrier(bar);
    if (IN(1) && (blockIdx.x & 1) == 0) { PHASE_ARGS(); const P0Args a{INP(0), INP(1), INP(2), INP(3), INP(9), INP(14), INP(15), INP(25), INP(23), INP(19), INP(21),
            WSP(bf16_t, WS_WIN), WSP(bf16_t, WS_WSM), WSP(bf16_t, WS_WSM + 1 * MiB), WSP(bf16_t, WS_WSM + 2 * MiB), WSP(bf16_t, WS_WSM + 4 * MiB), WSP(bf16_t, WS_WSM + 6 * MiB), WSP(unsigned char, WS_WGU), WSP(unsigned char, WS_WDN), WSP(bf16_t, WS_XN), WSP(bf16_t, WS_UC)}; p0_prologue<1>(F, a); __syncthreads(); }
    if (IN(1)) { PHASE_ARGS(); const pg8::Gemm g{WSP(bf16_t, WS_XN), WSP(bf16_t, WS_WIN), D, D, 0}; pg8::InProjOrder S; S.init(M, INC, F.G, (int)blockIdx.x);
        const pg8::EpiIn E{WSP(bf16_t, WS_Q), WSP(bf16_t, WS_K), WSP(bf16_t, WS_V), WSP(bf16_t, WS_Z), WSP(bf16_t, WS_SGA), WSP(bf16_t, WS_SGB)};
        pg8::gemm_phase<pg8::EpiIn, pg8::InProjOrder, true>(F.lds + RING_OFF, F.wave, g, S, E, SKEW_P1); }
    }
    SEAM(1);
    for (int r_ = 0; r_ < REPS(2); ++r_) { if (r_) xcd_barrier(bar);
    if (IN(2)) { PHASE_ARGS(); const attn_body::AttnPtrs AT{WSP(const attn_body::bf16, WS_Q), WSP(const attn_body::bf16, WS_K), WSP(const attn_body::bf16, WS_V), WSP(attn_body::bf16, WS_O1), WSP(attn_body::bf16, WS_O2)};
        attn_body::attn_phase<8>((char*)lds + RING_OFF, AT, F.G, F.vcu, F.wave); }
    }
    SEAM(2);
    for (int r_ = 0; r_ < REPS(3); ++r_) { if (r_) xcd_barrier(bar);
    if (IN(3)) { PHASE_ARGS(); const P3Args a{WSP(bf16_t, WS_O1), WSP(bf16_t, WS_O2), WSP(bf16_t, WS_Z), INP(4), INP(5), INP(6), INP(7), INP(8), INP(10), INP(11), INP(12), INP(13), WSP(bf16_t, WS_AC)}; p3_combine_conv(F, a); }
    }
    SEAM(3);
    for (int r_ = 0; r_ < REPS(4); ++r_) { if (r_) xcd_barrier(bar);
    if (IN(4)) { PHASE_ARGS(); pg8::StaticOrder S; S.init(M, D, F.G, (int)blockIdx.x);
        const pg8::Gemm g{WSP(bf16_t, WS_AC), WSP(bf16_t, WS_WSM), D, D, 0}; const pg8::EpiMixF E{WSP(unsigned char, WS_SGA), WSP(unsigned char, WS_SGB), WSP(bf16_t, WS_M1)};
        pg8::gemm_phase<pg8::EpiMixF, pg8::StaticOrder, true>(F.lds + RING_OFF, F.wave, g, S, E, SKEW_P4); }
    }
    SEAM(4);
    for (int r_ = 0; r_ < REPS(5); ++r_) { if (r_) xcd_barrier(bar);
    if (IN(5)) { PHASE_ARGS(); const pg8::Gemm g{WSP(bf16_t, WS_M1), WSP(bf16_t, WS_WSM + 2 * MiB), D, D, 0}; pg8::StaticOrder S; S.init(M, D, F.G, (int)blockIdx.x); const pg8::EpiWo E{INP(0), WSP(bf16_t, WS_H)};
        pg8::gemm_phase<pg8::EpiWo, pg8::StaticOrder, true>(F.lds + RING_OFF, F.wave, g, S, E, SKEW_P5); }
    }
    SEAM(5);
    for (int r_ = 0; r_ < REPS(6); ++r_) { if (r_) xcd_barrier(bar);
    if (IN(6)) { PHASE_ARGS(); const P6Args a{WSP(bf16_t, WS_H), INP(16), INP(17), INP(18), WSP(unsigned char, WS_U2), WSP(int, WS_TOPK_E), WSP(float, WS_TOPK_G), WSP(int, WS_LIST), WSP(unsigned, WS_CTL) + CW_GCNT}; p6_router(F, a); }
    if (IN(6) && (blockIdx.x & 1) != 0) { __syncthreads(); PHASE_ARGS(); const P0Args a{INP(0), INP(1), INP(2), INP(3), INP(9), INP(14), INP(15), INP(25), INP(23), INP(19), INP(21),
            WSP(bf16_t, WS_WIN), WSP(bf16_t, WS_WSM), WSP(bf16_t, WS_WSM + 1 * MiB), WSP(bf16_t, WS_WSM + 2 * MiB), WSP(bf16_t, WS_WSM + 4 * MiB), WSP(bf16_t, WS_WSM + 6 * MiB), WSP(unsigned char, WS_WGU), WSP(unsigned char, WS_WDN), WSP(bf16_t, WS_XN), WSP(bf16_t, WS_UC)}; p0_prologue<1>(F, a); }
    }
    SEAM(6);
    if (IN(7) || IN(8)) { PHASE_ARGS(); moe_tables(F, WSP(unsigned, WS_CTL) + CW_GCNT); }
    for (int r_ = 0; r_ < REPS(7); ++r_) { if (r_) xcd_barrier(bar);
    if (IN(7)) { PHASE_ARGS(); const LAS int* pmb = (const LAS int*)(F.lds + MOE_OFF); const pg8::Gemm g{WSP(bf16_t, WS_U2), WSP(bf16_t, WS_WGU), D / 2, D / 2, (size_t)2 * FF * D / 2};
        const pg8::MoeOrder<true> S{(const LAS unsigned short*)(F.lds + CONV_OFF), pmb + 64, WSP(int, WS_LIST), 8, F.G, F.vcu, __builtin_amdgcn_readfirstlane(pmb[128]), D / 2}; const pg8::EpiGateUp E{INP(20), WSP(unsigned char, WS_ACT), (LAS float*)(F.lds + RCTL_OFF)};
        pg8::gemm_phase<pg8::EpiGateUp, pg8::MoeOrder<true>, true, true>(F.lds + RING_OFF, F.wave, g, S, E, SKEW_P7); }
    }
    SEAM(7);
    for (int r_ = 0; r_ < REPS(8); ++r_) { if (r_) xcd_barrier(bar);
    if (IN(8)) { PHASE_ARGS(); const LAS int* pmb = (const LAS int*)(F.lds + MOE_OFF); const pg8::Gemm g{WSP(bf16_t, WS_ACT), WSP(bf16_t, WS_WDN), FF / 2, FF / 2, (size_t)D * FF / 2};
        const pg8::MoeOrder<false> S{(const LAS unsigned short*)(F.lds + CONV_OFF), pmb + 64, WSP(int, WS_LIST), 4, F.G, F.vcu, __builtin_amdgcn_readfirstlane(pmb[128]), FF / 2}; const pg8::EpiDown E{INP(22), WSP(int, WS_LIST), WSP(unsigned char, WS_Y), WSP(unsigned char, WS_TRASH), (LAS unsigned*)(F.lds + LDSCTL_OFF + 8192)};
        pg8::gemm_phase<pg8::EpiDown, pg8::MoeOrder<false>, true, true>(F.lds + RING_OFF, F.wave, g, S, E, SKEW_P8); }
    }
    SEAM(8);
    for (int r_ = 0; r_ < REPS(9); ++r_) { if (r_) xcd_barrier(bar);
    if (IN(9)) { PHASE_ARGS(); p9_moe_combine(F, WSP(bf16_t, WS_H), WSP(unsigned char, WS_Y), INP(24), WSP(unsigned char, WS_UC)); }
    }
    SEAM(9);
    for (int r_ = 0; r_ < REPS(10); ++r_) { if (r_) xcd_barrier(bar);
    if (IN(10)) { PHASE_ARGS(); pg8::StaticOrder S; S.init(M, D, F.G, (int)blockIdx.x);
        const pg8::Gemm g{WSP(bf16_t, WS_UC), WSP(bf16_t, WS_WSM + 4 * MiB), UCW / 2, UCW / 2, 0}; const pg8::EpiPleF E{WSP(bf16_t, WS_E1), WSP(bf16_t, WS_H)};
        pg8::gemm_phase<pg8::EpiPleF, pg8::StaticOrder, true, true>(F.lds + RING_OFF, F.wave, g, S, E, SKEW_P10); }
    }
    SEAM(10);
    for (int r_ = 0; r_ < REPS(11); ++r_) { if (r_) xcd_barrier(bar);
    if (IN(11)) { PHASE_ARGS(); p11_final(F, WSP(bf16_t, WS_H), INP(26), ap_->out); }
    }
#undef IN
#undef SEAM
#undef PHASE_ARGS
#undef INP
#undef WSP
}

extern "C" void kernel_launch(void* const* d_in, const int* in_sizes, int n_in, void* d_out, int out_size, void* d_ws, size_t ws_size, hipStream_t stream) {
    static int grid = 0;
    if (grid == 0) {
        if (n_in != 27 || in_sizes[0] != M * D || out_size != M * D || ws_size < WS_END) { fprintf(stderr, "kernel_launch: unexpected shapes (n_in %d, in0 %d, out %d, ws %zu)\n", n_in, n_in > 0 ? in_sizes[0] : -1, out_size, ws_size); grid = -1; return; }
        int dev = 0, cus = 0, per_cu = 0;
        if (hipGetDevice(&dev) != hipSuccess || hipDeviceGetAttribute(&cus, hipDeviceAttributeMultiprocessorCount, dev) != hipSuccess) { grid = -1; return; }
        if (hipFuncSetAttribute((const void*)mega_fwd, hipFuncAttributeMaxDynamicSharedMemorySize, LDS_BYTES) != hipSuccess) { fprintf(stderr, "kernel_launch: hipFuncSetAttribute failed\n"); grid = -1; return; }
        if (hipOccupancyMaxActiveBlocksPerMultiprocessor(&per_cu, (const void*)mega_fwd, NWAVES * 64, LDS_BYTES) != hipSuccess || per_cu < 1) fprintf(stderr, "kernel_launch: occupancy query reports %d\n", per_cu);
        (void)hipGetLastError();
        grid = cus;
    }
    if (grid < 0) return;
    const float* const* in = (const float* const*)d_in;
    unsigned char* ws = (unsigned char*)d_ws; float* out = (float*)d_out;
    (void)hipMemsetAsync(ws + WS_CTL, 0, CTL_ZERO_BYTES, stream);
    Args a{};
    for (int i = 0; i < 27; ++i) a.in[i] = in[i];
    a.out = out; a.ws = ws;
#ifndef HDUP_MASK
#define HDUP_MASK 0
#endif
#if ONE_LAUNCH
    a.ph_lo = 0; a.ph_hi = NPHASE; a.li = 0;
    hipLaunchKernelGGL(mega_fwd, dim3(grid), dim3(NWAVES * 64), LDS_BYTES, stream, a);
#else
    for (int ph = 0; ph < NPHASE; ++ph) { a.ph_lo = ph; a.ph_hi = ph + 1; a.li = 3;
        const int nrep = 1 + (((HDUP_MASK) >> ph) & 1);
        for (int rep = 0; rep < nrep; ++rep) { const bool dry = rep + 1 < nrep;
            a.ws = ws + ((dry && ph == 9 && ws_size >= 1008 * MiB) ? 512 * MiB : (dry && ph == 10) ? 128 * MiB : (size_t)0);
            hipLaunchKernelGGL(mega_fwd, dim3(grid), dim3(NWAVES * 64), LDS_BYTES, stream, a);
            if (dry && ph == 6) (void)hipMemsetAsync(ws + WS_CTL + CW_GCNT * 4, 0, 128, stream); } }
#endif
}
```
